# Optimizing an MI355X kernel written in HIP

```python
import jax, jax.numpy as jnp
from jax import lax
import numpy as np

D_MODEL = 1024
BATCH = 4
SEQ = 4096
DEPTH = 2

CHUNK = 128
EPS = 1e-6
A_GROUPS = 4
A_GROUP_DIM = 128
A_WIDTH = A_GROUPS * A_GROUP_DIM
B_HEADS = 4
B_KEY_DIM = 64
B_VAL_DIM = 128
B_QK_WIDTH = B_HEADS * B_KEY_DIM
B_V_WIDTH = B_HEADS * B_VAL_DIM
B_GATE_RANK = 16
B_GATE_NORMALIZER = 16.0
EVEN_SPLITS = (A_WIDTH, A_WIDTH, B_QK_WIDTH, B_QK_WIDTH, B_GATE_RANK, B_V_WIDTH, B_V_WIDTH)
EVEN_IN = sum(EVEN_SPLITS)
EVEN_MIX_WIDTH = A_WIDTH + B_V_WIDTH
C_HEADS = 16
C_HEAD_DIM = 64
C_WIDTH = C_HEADS * C_HEAD_DIM
ODD_SPLITS = (C_WIDTH, C_WIDTH, C_WIDTH, C_WIDTH, C_HEADS)
ODD_IN = sum(ODD_SPLITS)
D_FF_DENSE = 2816
N_EXPERTS = 8
TOP_K = 2
D_FF_EXPERT = 3584
N_EVEN = (DEPTH + 1) // 2
N_ODD = DEPTH // 2

kernel_name = "hybrid_gmlp_gla_fox_moe_trunk"


def _split(z, sizes):
    idx = np.cumsum(np.array(sizes))[:-1].tolist()
    return jnp.split(z, idx, axis=-1)


def rmsnorm(x, g):
    xf = x.astype(jnp.float32)
    y = xf * lax.rsqrt(jnp.mean(xf * xf, axis=-1, keepdims=True) + EPS)
    return (y * g.astype(jnp.float32)).astype(x.dtype)


def layernorm(x, g, b):
    xf = x.astype(jnp.float32)
    mu = jnp.mean(xf, axis=-1, keepdims=True)
    xc = xf - mu
    y = xc * lax.rsqrt(jnp.mean(xc * xc, axis=-1, keepdims=True) + EPS)
    return (y * g.astype(jnp.float32) + b.astype(jnp.float32)).astype(x.dtype)


def swiglu(h, w1, w3, w2):
    return (jax.nn.silu(h @ w1) * (h @ w3)) @ w2


def chunk_spatial_gating(u, v, w_s, b_s):
    bsz, seq, _ = u.shape
    n = seq // CHUNK
    mask = jnp.tril(jnp.ones((CHUNK, CHUNK), dtype=bool))
    w = jnp.where(mask[None], w_s, jnp.zeros_like(w_s))
    v5 = v.reshape(bsz, n, CHUNK, A_GROUPS, A_GROUP_DIM)
    mixed = jnp.einsum('gts,bnsgd->bntgd', w, v5) + b_s.T[None, None, :, :, None]
    return (u.reshape(bsz, n, CHUNK, A_GROUPS, A_GROUP_DIM) * mixed).reshape(bsz, seq, A_WIDTH)


def gla_chunked(q, k, v, log_a):
    bsz, seq, nh, dk = q.shape
    dv = v.shape[-1]
    n = seq // CHUNK
    def to_chunks(t):
        return jnp.swapaxes(t.reshape(bsz, n, CHUNK, nh, t.shape[-1]), 0, 1)
    g = jnp.cumsum(log_a.astype(jnp.float32).reshape(bsz, n, CHUNK, nh, dk), axis=2)
    g = jnp.swapaxes(g, 0, 1)
    causal = jnp.tril(jnp.ones((CHUNK, CHUNK), dtype=bool))

    def step(state, inp):
        qc, kc, vc, gc = inp
        qf = qc.astype(jnp.float32)
        kf = kc.astype(jnp.float32)
        vf = vc.astype(jnp.float32)
        o_inter = jnp.einsum('bthk,bhkv->bthv', qf * jnp.exp(gc), state)
        diff = gc[:, :, None] - gc[:, None, :]
        diff = jnp.where(causal[None, :, :, None, None], diff, -jnp.inf)
        attn = jnp.einsum('bthk,bshk,btshk->btsh', qf, kf, jnp.exp(diff))
        o_intra = jnp.einsum('btsh,bshv->bthv', attn, vf)
        g_last = gc[:, -1]
        k_dec = kf * jnp.exp(g_last[:, None] - gc)
        new_state = jnp.exp(g_last)[..., None] * state + jnp.einsum('bshk,bshv->bhkv', k_dec, vf)
        return new_state, o_inter + o_intra

    state0 = jnp.zeros((bsz, nh, dk, dv), jnp.float32)
    _, out = lax.scan(step, state0, (to_chunks(q), to_chunks(k), to_chunks(v), g))
    return jnp.swapaxes(out, 0, 1).reshape(bsz, seq, nh, dv).astype(v.dtype)


def forgetting_attention(q, k, v, log_f):
    bsz, seq, nh, hd = q.shape
    n = seq // CHUNK
    scale = hd ** -0.5
    c = jnp.cumsum(log_f, axis=1)
    c_key = jnp.swapaxes(c, 1, 2)
    q_blocks = jnp.swapaxes(q.reshape(bsz, n, CHUNK, nh, hd), 0, 1)
    c_blocks = jnp.swapaxes(c.reshape(bsz, n, CHUNK, nh), 0, 1)
    s_pos = jnp.arange(seq)

    def block(args):
        qb, cb, bi = args
        logits = jnp.einsum('bthd,bshd->bhts', qb, k).astype(jnp.float32) * scale
        logits = logits + jnp.swapaxes(cb, 1, 2)[..., None] - c_key[:, :, None, :]
        t_pos = bi * CHUNK + jnp.arange(CHUNK)
        mask = s_pos[None, :] <= t_pos[:, None]
        logits = jnp.where(mask[None, None], logits, -jnp.inf)
        p = jax.nn.softmax(logits, axis=-1)
        return jnp.einsum('bhts,bshd->bthd', p.astype(v.dtype), v)

    out = lax.map(block, (q_blocks, c_blocks, jnp.arange(n)))
    return jnp.swapaxes(out, 0, 1).reshape(bsz, seq, nh * hd)


def mixer_even(h, w_in, gate_up, gate_bias, w_s, b_s, ln_g, ln_b, head_g, w_o):
    bsz, seq, _ = h.shape
    z = h @ w_in
    u, v, q, k, g_lr, vb, og = _split(z, EVEN_SPLITS)
    u = jax.nn.gelu(u)
    v = layernorm(jax.nn.gelu(v), ln_g, ln_b)
    a_out = chunk_spatial_gating(u, v, w_s, b_s)
    gate_logit = (g_lr @ gate_up + gate_bias).astype(jnp.float32)
    log_a = jax.nn.log_sigmoid(gate_logit) / B_GATE_NORMALIZER
    qh = q.reshape(bsz, seq, B_HEADS, B_KEY_DIM) * (B_KEY_DIM ** -0.5)
    kh = k.reshape(bsz, seq, B_HEADS, B_KEY_DIM)
    vh = vb.reshape(bsz, seq, B_HEADS, B_VAL_DIM)
    o = gla_chunked(qh, kh, vh, log_a.reshape(bsz, seq, B_HEADS, B_KEY_DIM))
    o = rmsnorm(o, head_g) * jax.nn.silu(og.reshape(bsz, seq, B_HEADS, B_VAL_DIM))
    b_out = o.reshape(bsz, seq, B_V_WIDTH)
    return jnp.concatenate([a_out, b_out], axis=-1) @ w_o


def mixer_odd(h, w_in, forget_bias, q_g, k_g, w_o):
    bsz, seq, _ = h.shape
    z = h @ w_in
    q, k, v, og, f = _split(z, ODD_SPLITS)
    q = rmsnorm(q.reshape(bsz, seq, C_HEADS, C_HEAD_DIM), q_g)
    k = rmsnorm(k.reshape(bsz, seq, C_HEADS, C_HEAD_DIM), k_g)
    v = v.reshape(bsz, seq, C_HEADS, C_HEAD_DIM)
    log_f = jax.nn.log_sigmoid(f.astype(jnp.float32) + forget_bias.astype(jnp.float32))
    o = forgetting_attention(q, k, v, log_f)
    o = o * jax.nn.sigmoid(og)
    return o @ w_o


def moe_swiglu(h, router, w1, w3, w2):
    logits = (h @ router).astype(jnp.float32)
    top_vals, top_idx = lax.top_k(logits, TOP_K)
    top_w = jax.nn.softmax(top_vals, axis=-1)
    gates = jnp.sum(jax.nn.one_hot(top_idx, N_EXPERTS, dtype=jnp.float32) * top_w[..., None], axis=-2)
    gates = gates.astype(h.dtype)
    out = jnp.zeros_like(h)
    for e in range(N_EXPERTS):
        out = out + gates[..., e:e + 1] * swiglu(h, w1[e], w3[e], w2[e])
    return out


def setup_inputs(seed: int = 0) -> dict:
    key = jax.random.key(seed)
    ks = iter(jax.random.split(key, 32))
    f32 = jnp.float32
    def nrm(shape, scale):
        return jax.random.normal(next(ks), shape, f32) * scale
    def gain(shape):
        return 1.0 + 0.05 * jax.random.normal(next(ks), shape, f32)
    d = D_MODEL
    return {
        "x": jax.random.normal(next(ks), (BATCH, SEQ, d), f32),
        "even_norm_mix": gain((N_EVEN, d)),
        "even_w_in": nrm((N_EVEN, d, EVEN_IN), d ** -0.5),
        "even_gate_up": nrm((N_EVEN, B_GATE_RANK, B_QK_WIDTH), B_GATE_RANK ** -0.5),
        "even_gate_bias": nrm((N_EVEN, B_QK_WIDTH), 0.1),
        "even_w_s": nrm((N_EVEN, A_GROUPS, CHUNK, CHUNK), CHUNK ** -0.5),
        "even_b_s": 1.0 + 0.1 * jax.random.normal(next(ks), (N_EVEN, A_GROUPS, CHUNK), f32),
        "even_ln_g": gain((N_EVEN, A_WIDTH)),
        "even_ln_b": nrm((N_EVEN, A_WIDTH), 0.02),
        "even_head_g": gain((N_EVEN, B_HEADS, B_VAL_DIM)),
        "even_w_o": nrm((N_EVEN, EVEN_MIX_WIDTH, d), EVEN_MIX_WIDTH ** -0.5),
        "even_norm_ffn": gain((N_EVEN, d)),
        "even_ffn_w1": nrm((N_EVEN, d, D_FF_DENSE), d ** -0.5),
        "even_ffn_w3": nrm((N_EVEN, d, D_FF_DENSE), d ** -0.5),
        "even_ffn_w2": nrm((N_EVEN, D_FF_DENSE, d), D_FF_DENSE ** -0.5),
        "odd_norm_mix": gain((N_ODD, d)),
        "odd_w_in": nrm((N_ODD, d, ODD_IN), d ** -0.5),
        "odd_forget_bias": 2.0 + 0.5 * jax.random.normal(next(ks), (N_ODD, C_HEADS), f32),
        "odd_q_g": gain((N_ODD, C_HEAD_DIM)),
        "odd_k_g": gain((N_ODD, C_HEAD_DIM)),
        "odd_w_o": nrm((N_ODD, C_WIDTH, d), C_WIDTH ** -0.5),
        "odd_norm_ffn": gain((N_ODD, d)),
        "odd_router": nrm((N_ODD, d, N_EXPERTS), d ** -0.5),
        "odd_exp_w1": nrm((N_ODD, N_EXPERTS, d, D_FF_EXPERT), d ** -0.5),
        "odd_exp_w3": nrm((N_ODD, N_EXPERTS, d, D_FF_EXPERT), d ** -0.5),
        "odd_exp_w2": nrm((N_ODD, N_EXPERTS, D_FF_EXPERT, d), D_FF_EXPERT ** -0.5),
        "final_norm": gain((d,)),
    }


def reference(x, even_norm_mix, even_w_in, even_gate_up, even_gate_bias, even_w_s, even_b_s,
              even_ln_g, even_ln_b, even_head_g, even_w_o, even_norm_ffn, even_ffn_w1,
              even_ffn_w3, even_ffn_w2, odd_norm_mix, odd_w_in, odd_forget_bias, odd_q_g,
              odd_k_g, odd_w_o, odd_norm_ffn, odd_router, odd_exp_w1, odd_exp_w3,
              odd_exp_w2, final_norm):
    for i in range(DEPTH):
        j = i // 2
        if i % 2 == 0:
            h = rmsnorm(x, even_norm_mix[j])
            x = x + mixer_even(h, even_w_in[j], even_gate_up[j], even_gate_bias[j], even_w_s[j],
                               even_b_s[j], even_ln_g[j], even_ln_b[j], even_head_g[j], even_w_o[j])
            h = rmsnorm(x, even_norm_ffn[j])
            x = x + swiglu(h, even_ffn_w1[j], even_ffn_w3[j], even_ffn_w2[j])
        else:
            h = rmsnorm(x, odd_norm_mix[j])
            x = x + mixer_odd(h, odd_w_in[j], odd_forget_bias[j], odd_q_g[j], odd_k_g[j], odd_w_o[j])
            h = rmsnorm(x, odd_norm_ffn[j])
            x = x + moe_swiglu(h, odd_router[j], odd_exp_w1[j], odd_exp_w3[j], odd_exp_w2[j])
    return rmsnorm(x, final_norm)
```

```cpp
#include <hip/hip_runtime.h>
#include <cstdio>
#include <cstdint>
#include <cmath>
namespace gold {
constexpr int M = 16384, D = 1024, S = 4096, NB = 4;
constexpr int EVEN_IN = 2576, ODD_IN = 4112, FFD = 2816, FFE = 3584, NE = 8;
constexpr size_t MiB = 1u << 20;
constexpr size_t G_X = 0, G_H = 64 * MiB, G_BIG = 128 * MiB, G_O = 388 * MiB, G_SM = 452 * MiB, G_END = 466 * MiB;
constexpr size_t G_LOGA = G_BIG + 172 * MiB;
constexpr size_t G_GLAO = G_BIG + 190 * MiB;
constexpr size_t G_C = G_SM;
constexpr size_t G_CNT = G_SM + 1 * MiB;
constexpr size_t G_LIST = G_SM + 2 * MiB;
constexpr size_t G_GATE = G_SM + 3 * MiB;

__device__ __forceinline__ float gelu_tanh(float x) { const float y = 0.7978845608028654f * (x + 0.044715f * x * x * x); return 0.5f * x * (1.f + tanhf(y)); }
__device__ __forceinline__ float sigm(float x) { return 1.f / (1.f + expf(-x)); }
__device__ __forceinline__ float silu(float x) { return x * sigm(x); }
__device__ __forceinline__ float log_sigmoid(float x) { return fminf(x, 0.f) - log1pf(expf(-fabsf(x))); }
__device__ __forceinline__ float wsum(float v) {
#pragma unroll
    for (int o = 32; o; o >>= 1) v += __shfl_xor(v, o);
    return v; }

__global__ void __launch_bounds__(256) k_rmsnorm(const float* x, const float* g, float* out, int rows, int cols) {
    const int row = blockIdx.x * 4 + (threadIdx.x >> 6), lane = threadIdx.x & 63;
    if (row >= rows) return;
    const float* xr = x + (size_t)row * cols; float s = 0.f;
    for (int c = lane; c < cols; c += 64) { const float v = xr[c]; s += v * v; }
    s = wsum(s);
    const float r = 1.0f / sqrtf(s / (float)cols + 1e-6f);
    for (int c = lane; c < cols; c += 64) out[(size_t)row * cols + c] = xr[c] * r * g[c];
}

template <int MODE>
__global__ void __launch_bounds__(256) k_sgemm(const float* A, int lda, const float* B, const float* B2, int ldb, float* C, int ldc, int Mr, int N, int K,
                                               const int* idx, const int* cntp, const float* rowscale) {
    __shared__ float As[16][68]; __shared__ float Bs[16][64]; __shared__ float Bs2[16][64];
    const int mrows = cntp ? *cntp : Mr;
    const int bm = blockIdx.y * 64, bn = blockIdx.x * 64; if (bm >= mrows) return;
    const int tx = threadIdx.x & 15, ty = threadIdx.x >> 4;
    float acc[4][4], acc2[4][4];
#pragma unroll
    for (int i = 0; i < 4; ++i)
#pragma unroll
        for (int j = 0; j < 4; ++j) { acc[i][j] = 0.f; acc2[i][j] = 0.f; }
    for (int k0 = 0; k0 < K; k0 += 16) {
#pragma unroll
        for (int i = 0; i < 4; ++i) { const int e = threadIdx.x + i * 256, r = e >> 4, c = e & 15, gr = bm + r; float v = 0.f;
            if (gr < mrows) { const int ar = (MODE == 2 && idx) ? idx[gr] : gr; v = A[(size_t)ar * lda + k0 + c]; } As[c][r] = v; }
#pragma unroll
        for (int i = 0; i < 4; ++i) { const int e = threadIdx.x + i * 256, r = e >> 6, c = e & 63, gc = bn + c;
            Bs[r][c] = gc < N ? B[(size_t)(k0 + r) * ldb + gc] : 0.f; if (MODE == 2) Bs2[r][c] = gc < N ? B2[(size_t)(k0 + r) * ldb + gc] : 0.f; }
        __syncthreads();
#pragma unroll
        for (int kk = 0; kk < 16; ++kk) { float a[4], b[4], b2[4];
#pragma unroll
            for (int i = 0; i < 4; ++i) { a[i] = As[kk][ty * 4 + i]; b[i] = Bs[kk][tx * 4 + i]; b2[i] = (MODE == 2) ? Bs2[kk][tx * 4 + i] : 0.f; }
#pragma unroll
            for (int i = 0; i < 4; ++i)
#pragma unroll
                for (int j = 0; j < 4; ++j) { acc[i][j] += a[i] * b[j]; if (MODE == 2) acc2[i][j] += a[i] * b2[j]; } }
        __syncthreads();
    }
#pragma unroll
    for (int i = 0; i < 4; ++i) { const int gr = bm + ty * 4 + i; if (gr >= mrows) continue;
#pragma unroll
        for (int j = 0; j < 4; ++j) { const int gc = bn + tx * 4 + j; if (gc >= N) continue;
            if (MODE == 0) C[(size_t)gr * ldc + gc] = acc[i][j];
            else if (MODE == 1) C[(size_t)gr * ldc + gc] += acc[i][j];
            else if (MODE == 2) C[(size_t)gr * ldc + gc] = silu(acc[i][j]) * acc2[i][j];
            else C[(size_t)idx[gr] * ldc + gc] += rowscale[gr] * acc[i][j]; } }
}

__global__ void __launch_bounds__(256) k_even_post(float* Z, const float* ln_g, const float* ln_b, const float* gate_up, const float* gate_bias, float* loga) {
    const int row = blockIdx.x * 4 + (threadIdx.x >> 6), lane = threadIdx.x & 63;
    float* z = Z + (size_t)row * EVEN_IN;
    for (int c = lane; c < 512; c += 64) z[c] = gelu_tanh(z[c]);
    float v[8]; float s = 0.f;
#pragma unroll
    for (int i = 0; i < 8; ++i) { v[i] = gelu_tanh(z[512 + lane + 64 * i]); s += v[i]; }
    const float mu = wsum(s) * (1.f / 512.f); float q = 0.f;
#pragma unroll
    for (int i = 0; i < 8; ++i) { v[i] -= mu; q += v[i] * v[i]; }
    const float rs = 1.0f / sqrtf(wsum(q) * (1.f / 512.f) + 1e-6f);
#pragma unroll
    for (int i = 0; i < 8; ++i) { const int c = lane + 64 * i; z[512 + c] = v[i] * rs * ln_g[c] + ln_b[c]; }
    for (int c = lane; c < 256; c += 64) z[1024 + c] *= 0.125f;
    for (int c = lane; c < 256; c += 64) { float a = gate_bias[c];
        for (int r = 0; r < 16; ++r) a += z[1536 + r] * gate_up[r * 256 + c];
        loga[(size_t)row * 256 + c] = log_sigmoid(a) * (1.f / 16.f); }
}
__global__ void __launch_bounds__(256) k_gmlp(const float* Z, const float* w_s, const float* b_s, float* mix) {
    const int gid = blockIdx.x * 256 + threadIdx.x; const int row = gid >> 9, col = gid & 511;
    const int t = row & 127, base = row - t, g = col >> 7;
    const float* w = w_s + ((size_t)g * 128 + t) * 128; float a = 0.f;
    for (int s = 0; s <= t; ++s) a += w[s] * Z[(size_t)(base + s) * EVEN_IN + 512 + col];
    mix[(size_t)row * D + col] = Z[(size_t)row * EVEN_IN + col] * (a + b_s[g * 128 + t]);
}
__global__ void __launch_bounds__(256) k_gla(const float* Z, const float* loga, float* glao) {
    const int w = blockIdx.x * 4 + (threadIdx.x >> 6), lane = threadIdx.x & 63;
    const int vc = w & 127, h = (w >> 7) & 3, b = w >> 9;
    float st = 0.f;
    for (int t = 0; t < S; ++t) { const size_t row = (size_t)b * S + t; const float* z = Z + row * EVEN_IN;
        const float a = expf(loga[row * 256 + h * 64 + lane]);
        st = a * st + z[1280 + h * 64 + lane] * z[1552 + h * 128 + vc];
        const float o = wsum(z[1024 + h * 64 + lane] * st);
        if (lane == 0) glao[row * 512 + h * 128 + vc] = o; }
}
__global__ void __launch_bounds__(256) k_gla_post(const float* Z, const float* glao, const float* head_g, float* mix) {
    const int w = blockIdx.x * 4 + (threadIdx.x >> 6), lane = threadIdx.x & 63; const int h = w & 3, row = w >> 2;
    const float* o = glao + (size_t)row * 512 + h * 128; const float o0 = o[lane], o1 = o[lane + 64];
    const float r = 1.0f / sqrtf(wsum(o0 * o0 + o1 * o1) * (1.f / 128.f) + 1e-6f);
    const float* og = Z + (size_t)row * EVEN_IN + 2064 + h * 128;
    mix[(size_t)row * D + 512 + h * 128 + lane] = o0 * r * head_g[h * 128 + lane] * silu(og[lane]);
    mix[(size_t)row * D + 512 + h * 128 + lane + 64] = o1 * r * head_g[h * 128 + lane + 64] * silu(og[lane + 64]);
}
__global__ void __launch_bounds__(256) k_qknorm(float* Z, const float* q_g, const float* k_g) {
    const int w = blockIdx.x * 4 + (threadIdx.x >> 6), lane = threadIdx.x & 63; const int hh = w & 31, row = w >> 5;
    float* p = Z + (size_t)row * ODD_IN + hh * 64; const float* g = (hh < 16) ? q_g : k_g;
    const float v = p[lane]; const float r = 1.0f / sqrtf(wsum(v * v) * (1.f / 64.f) + 1e-6f); p[lane] = v * r * g[lane];
}
__global__ void k_cumf(const float* Z, const float* fb, float* c) {
    const int i = threadIdx.x, b = i >> 4, h = i & 15; float a = 0.f;
    for (int t = 0; t < S; ++t) { a += log_sigmoid(Z[((size_t)b * S + t) * ODD_IN + 4096 + h] + fb[h]); c[(size_t)i * S + t] = a; }
}
__global__ void __launch_bounds__(256) k_attn(const float* Z, const float* c, float* O) {
    const int bh = blockIdx.y, b = bh >> 4, h = bh & 15, t = blockIdx.x * 256 + threadIdx.x;
    const float* zr = Z + ((size_t)b * S + t) * ODD_IN; float q[64], o[64];
#pragma unroll
    for (int d = 0; d < 64; ++d) { q[d] = zr[h * 64 + d] * 0.125f; o[d] = 0.f; }
    const float* cc = c + (size_t)bh * S; const float ct = cc[t]; float m = -INFINITY, l = 0.f;
    const int smax = blockIdx.x * 256 + 255;
    for (int s = 0; s <= smax; ++s) { const float* kr = Z + ((size_t)b * S + s) * ODD_IN + 1024 + h * 64; const float* vr = kr + 1024;
        if (s <= t) { float a = 0.f;
#pragma unroll
            for (int d = 0; d < 64; ++d) a += q[d] * kr[d];
            a += ct - cc[s];
            if (a > m) { const float f = expf(m - a); l *= f;
#pragma unroll
                for (int d = 0; d < 64; ++d) o[d] *= f;
                m = a; }
            const float p = expf(a - m); l += p;
#pragma unroll
            for (int d = 0; d < 64; ++d) o[d] += p * vr[d]; } }
    const float il = 1.f / l;
#pragma unroll
    for (int d = 0; d < 64; ++d) O[((size_t)b * S + t) * D + h * 64 + d] = o[d] * il * sigm(zr[3072 + h * 64 + d]);
}
__global__ void __launch_bounds__(256) k_route(const float* H, const float* router, int* cnt, int* list, float* gate) {
    const int tok = blockIdx.x * 4 + (threadIdx.x >> 6), lane = threadIdx.x & 63;
    float lg[8];
#pragma unroll
    for (int e = 0; e < 8; ++e) lg[e] = 0.f;
    for (int k = lane; k < D; k += 64) { const float hv = H[(size_t)tok * D + k];
#pragma unroll
        for (int e = 0; e < 8; ++e) lg[e] += hv * router[k * 8 + e]; }
#pragma unroll
    for (int e = 0; e < 8; ++e) lg[e] = wsum(lg[e]);
    if (lane == 0) { int i0 = 0; float v0 = lg[0];
#pragma unroll
        for (int e = 1; e < 8; ++e) if (lg[e] > v0) { v0 = lg[e]; i0 = e; }
        int i1 = -1; float v1 = -INFINITY;
#pragma unroll
        for (int e = 0; e < 8; ++e) if (e != i0 && lg[e] > v1) { v1 = lg[e]; i1 = e; }
        const float e1 = expf(v1 - v0), w0 = 1.f / (1.f + e1), w1 = e1 / (1.f + e1);
        int p0 = atomicAdd(&cnt[i0], 1); list[i0 * M + p0] = tok; gate[i0 * M + p0] = w0;
        int p1 = atomicAdd(&cnt[i1], 1); list[i1 * M + p1] = tok; gate[i1 * M + p1] = w1; }
}

static void run(void* const* d_in, float* out, unsigned char* ws, hipStream_t st) {
    const float* x = (const float*)d_in[0];
    auto IN = [&](int i) { return (const float*)d_in[i]; };
    float* X = (float*)(ws + G_X); float* H = (float*)(ws + G_H); float* BIG = (float*)(ws + G_BIG); float* O = (float*)(ws + G_O);
    float* LOGA = (float*)(ws + G_LOGA); float* GLAO = (float*)(ws + G_GLAO); float* C = (float*)(ws + G_C);
    int* CNT = (int*)(ws + G_CNT); int* LIST = (int*)(ws + G_LIST); float* GATE = (float*)(ws + G_GATE);
    (void)hipMemcpyAsync(X, x, (size_t)M * D * 4, hipMemcpyDeviceToDevice, st);
    k_rmsnorm<<<M / 4, 256, 0, st>>>(X, IN(1), H, M, D);
    k_sgemm<0><<<dim3((EVEN_IN + 63) / 64, M / 64), 256, 0, st>>>(H, D, IN(2), nullptr, EVEN_IN, BIG, EVEN_IN, M, EVEN_IN, D, nullptr, nullptr, nullptr);
    k_even_post<<<M / 4, 256, 0, st>>>(BIG, IN(7), IN(8), IN(3), IN(4), LOGA);
    k_gmlp<<<M * 512 / 256, 256, 0, st>>>(BIG, IN(5), IN(6), O);
    k_gla<<<NB * 4 * 128 / 4, 256, 0, st>>>(BIG, LOGA, GLAO);
    k_gla_post<<<M * 4 / 4, 256, 0, st>>>(BIG, GLAO, IN(9), O);
    k_sgemm<1><<<dim3(D / 64, M / 64), 256, 0, st>>>(O, D, IN(10), nullptr, D, X, D, M, D, D, nullptr, nullptr, nullptr);
    k_rmsnorm<<<M / 4, 256, 0, st>>>(X, IN(11), H, M, D);
    k_sgemm<2><<<dim3(FFD / 64, M / 64), 256, 0, st>>>(H, D, IN(12), IN(13), FFD, BIG, FFD, M, FFD, D, nullptr, nullptr, nullptr);
    k_sgemm<1><<<dim3(D / 64, M / 64), 256, 0, st>>>(BIG, FFD, IN(14), nullptr, D, X, D, M, D, FFD, nullptr, nullptr, nullptr);
    k_rmsnorm<<<M / 4, 256, 0, st>>>(X, IN(15), H, M, D);
    k_sgemm<0><<<dim3((ODD_IN + 63) / 64, M / 64), 256, 0, st>>>(H, D, IN(16), nullptr, ODD_IN, BIG, ODD_IN, M, ODD_IN, D, nullptr, nullptr, nullptr);
    k_qknorm<<<M * 32 / 4, 256, 0, st>>>(BIG, IN(18), IN(19));
    k_cumf<<<1, 64, 0, st>>>(BIG, IN(17), C);
    k_attn<<<dim3(S / 256, NB * 16), 256, 0, st>>>(BIG, C, O);
    k_sgemm<1><<<dim3(D / 64, M / 64), 256, 0, st>>>(O, D, IN(20), nullptr, D, X, D, M, D, D, nullptr, nullptr, nullptr);
    k_rmsnorm<<<M / 4, 256, 0, st>>>(X, IN(21), H, M, D);
    (void)hipMemsetAsync(CNT, 0, 64, st);
    k_route<<<M / 4, 256, 0, st>>>(H, IN(22), CNT, LIST, GATE);
    for (int e = 0; e < NE; ++e) {
        k_sgemm<2><<<dim3(FFE / 64, M / 64), 256, 0, st>>>(H, D, IN(23) + (size_t)e * D * FFE, IN(24) + (size_t)e * D * FFE, FFE, BIG, FFE, M, FFE, D, LIST + e * M, CNT + e, nullptr);
        k_sgemm<3><<<dim3(D / 64, M / 64), 256, 0, st>>>(BIG, FFE, IN(25) + (size_t)e * FFE * D, nullptr, D, X, D, M, D, FFE, LIST + e * M, CNT + e, GATE + e * M);
    }
    k_rmsnorm<<<M / 4, 256, 0, st>>>(X, IN(26), out, M, D);
}
}
extern "C" void kernel_launch(void* const* d_in, const int* in_sizes, int n_in, void* d_out, int out_size, void* d_ws, size_t ws_size, hipStream_t stream) {
    if (n_in != 27 || out_size != gold::M * gold::D || ws_size < gold::G_END) { fprintf(stderr, "kernel_launch: unexpected shapes n_in %d out %d ws %zu\n", n_in, out_size, ws_size); return; }
    gold::run(d_in, (float*)d_out, (unsigned char*)d_ws, stream);
}
```

```cpp
#include <hip/hip_runtime.h>
#include <cstdio>
#include <cstdint>
#include <cmath>
#define MK_WGM_MOE1 2
#define GAS __attribute__((address_space(1)))
#define LAS __attribute__((address_space(3)))
typedef unsigned short bf16;
typedef unsigned v4u __attribute__((ext_vector_type(4)));
typedef float f32x4 __attribute__((ext_vector_type(4)));
typedef short bf16x8 __attribute__((ext_vector_type(8)));
typedef GAS unsigned gu32;
typedef GAS unsigned long long gu64;
#define RLX_AGENT __ATOMIC_RELAXED, __HIP_MEMORY_SCOPE_AGENT
#define LDS_WAIT() asm volatile("s_waitcnt lgkmcnt(0)" ::: "memory")
#define VM_WAIT() asm volatile("s_waitcnt vmcnt(0)" ::: "memory")
__device__ __forceinline__ unsigned long long rt() { return __builtin_amdgcn_s_memrealtime(); }
__device__ __forceinline__ unsigned f2bf(float f) { unsigned u = __builtin_bit_cast(unsigned, f); return (u + 0x7fffu + ((u >> 16) & 1u)) >> 16; }
__device__ __forceinline__ unsigned pk2(float lo, float hi) { return f2bf(lo) | (f2bf(hi) << 16); }

#define XB_TMO      128
#define XB_XCNT(j)  (256  + 64 * (j))
#define XB_XSUB(j)  (1280 + 64 * (j))
#define XB_XGEN(j)  (2304 + 64 * (j))
#define XB_TOP      3328
#define XB_TOPGEN   3392
#define XCD_BAR_WORDS 3456
#define XB_SPIN_CAP (1u << 18)

__device__ __forceinline__ unsigned xb_ld(unsigned* p)              { return __hip_atomic_load(p, __ATOMIC_RELAXED, __HIP_MEMORY_SCOPE_AGENT); }
__device__ __forceinline__ unsigned xb_add(unsigned* p, unsigned v) { return __hip_atomic_fetch_add(p, v, __ATOMIC_RELAXED, __HIP_MEMORY_SCOPE_AGENT); }
__device__ __forceinline__ unsigned xb_xcc_id() { return (unsigned)__builtin_amdgcn_s_getreg((3 << 11) | 20) & 0xFu; }
#define XB_SPIN(cond, bar) do { unsigned _sp = 0; while (cond) { __builtin_amdgcn_s_sleep(1); \
    if ((++_sp & 255u) == 0u) { if (xb_ld(&(bar)[XB_TMO])) break; if (_sp > XB_SPIN_CAP) { atomicAdd(&(bar)[XB_TMO], 1u); break; } } } } while (0)

struct XcdBarrier {
    unsigned* bar; unsigned x;
    volatile LAS unsigned* st;
};

__device__ __forceinline__ XcdBarrier xcd_barrier_post(unsigned* bar, volatile LAS unsigned* st) {
    XcdBarrier b; b.bar = bar; b.x = xb_xcc_id(); b.st = st;
    if (threadIdx.x == 0) (void)xb_add(&bar[XB_XCNT(b.x)], 1u);
    return b;
}
__device__ __forceinline__ void xcd_barrier_complete(unsigned* bar, unsigned x, unsigned& nloc, unsigned& nx) {
    const unsigned G = gridDim.x * gridDim.y * gridDim.z;
    unsigned sum, cnt, mine, sp = 0u;
    for (;;) {
        sum = 0u; cnt = 0u; mine = 0u;
#pragma unroll
        for (unsigned j = 0; j < 16; ++j) { const unsigned c = xb_ld(&bar[XB_XCNT(j)]); sum += c; cnt += (c > 0u) ? 1u : 0u; mine = (j == x) ? c : mine; }
        if (sum == G) break;
        __builtin_amdgcn_s_sleep(1);
        if ((++sp & 255u) == 0u) { if (xb_ld(&bar[XB_TMO])) break; if (sp > XB_SPIN_CAP) { atomicAdd(&bar[XB_TMO], 1u); break; } }
    }
    nloc = mine > 0u ? mine : 1u; nx = cnt > 0u ? cnt : 1u;
}

__device__ __forceinline__ void xcd_barrier(const XcdBarrier& b) {
    asm volatile("s_waitcnt vmcnt(0)" ::: "memory");
    __syncthreads();
    if (threadIdx.x == 0) {
        unsigned* bar = b.bar;
        __builtin_amdgcn_s_waitcnt(0);
        unsigned nloc = b.st[0], nx = b.st[1];
        if (nloc == 0u) { xcd_barrier_complete(bar, b.x, nloc, nx); b.st[0] = nloc; b.st[1] = nx; }
        const unsigned old = xb_add(&bar[XB_XSUB(b.x)], 1u);
        const unsigned gen = old / nloc;
        if (old + 1u == (gen + 1u) * nloc) {
            __builtin_amdgcn_fence(__ATOMIC_RELEASE, "agent");
            asm volatile("s_waitcnt vmcnt(0)" ::: "memory");
            const unsigned og = xb_add(&bar[XB_TOP], 1u);
            const unsigned tg = og / nx;
            if (og + 1u == (tg + 1u) * nx) xb_add(&bar[XB_TOPGEN], 1u);
            else XB_SPIN(xb_ld(&bar[XB_TOPGEN]) == tg, bar);
            __builtin_amdgcn_fence(__ATOMIC_ACQUIRE, "agent");
            xb_add(&bar[XB_XGEN(b.x)], 1u);
            asm volatile("s_waitcnt vmcnt(0)" ::: "memory");
        } else {
            XB_SPIN(xb_ld(&bar[XB_XGEN(b.x)]) == gen, bar);
            __builtin_amdgcn_fence(__ATOMIC_ACQUIRE, "agent");
            asm volatile("s_waitcnt vmcnt(0)" ::: "memory");
        }
    }
    __syncthreads();
}
#ifndef MK_WGM
#define MK_WGM 4
#endif
namespace pg8 {
#define PG8_LAS __attribute__((address_space(3)))
typedef unsigned short bf16_t;
typedef short bf16x8 __attribute__((ext_vector_type(8)));
typedef float f32x4 __attribute__((ext_vector_type(4)));
typedef float f32x2 __attribute__((ext_vector_type(2)));
typedef unsigned u32x4 __attribute__((ext_vector_type(4)));
typedef unsigned u32x2 __attribute__((ext_vector_type(2)));
constexpr int BM = 256, BK = 64, HALF = 128, HTB = HALF * BK * 2  , STAGE_BYTES = 8 * HTB, NXCD = 8, WGM = MK_WGM;
constexpr float L2E = 1.4426950408889634f, LN2 = 0.6931471805599453f;

__host__ __device__ __forceinline__ int lds_byte(int r, int c) { const int st = (r >> 4) * 2 + (c >> 5), rr = r & 15, cc = c & 31, ob = rr * 64 + cc * 2; return st * 1024 + (ob ^ (((ob >> 9) & 1) << 5)); }
__host__ __device__ __forceinline__ void stage_rc(int b, int& R, int& C) { const int st = b / 1024, sb = b % 1024, swz = sb ^ (((sb >> 9) & 1) << 5); R = (st >> 1) * 16 + swz / 64; C = (st & 1) * 32 + (swz % 64) / 2; }
__host__ __device__ __forceinline__ int perm32(int rho) { const int n = rho >> 4, i = rho & 15; return 8 * (i >> 2) + 4 * n + (i & 3); }

struct Unit { int pm, pn, pe, ga, nv, nt, ks; };
__device__ __forceinline__ int unit_k0(const Unit& u) { return u.ks < 0 ? 0 : u.ks * u.nt * BK; }
struct Gemm { const bf16_t* A; const bf16_t* Bt; int K; const int* rowtok; int flags; };

struct StaticOrder {
    static constexpr bool GATHER = false;
    int nM, nN, nwg, G, c, wgm;
    __device__ __forceinline__ void init(int M, int N, int G_, int c_, int wgm_ = WGM) { nM = M / BM; nN = N / BM; nwg = nM * nN; G = G_; c = c_; wgm = wgm_; }
    __device__ __forceinline__ bool next(int i, Unit& u) const {
        const long L = (long)i * G + c; if (L >= nwg) return false;
        int wgid = (int)L; { const int q = nwg / NXCD, r = nwg % NXCD, xcd = wgid % NXCD, off = wgid / NXCD; wgid = (xcd < r ? xcd * (q + 1) : r * (q + 1) + (xcd - r) * q) + off; }
        const int nig = wgm * nN, gid = wgid / nig, fm = gid * wgm, gsz = (nM - fm) < wgm ? (nM - fm) : wgm;
        u.pm = fm + ((wgid % nig) % gsz); u.pn = (wgid % nig) / gsz; u.pe = u.pn; u.ga = 0; u.nv = BM; u.nt = 0; u.ks = -1; return true;
    }
};
template <bool GATHER_>
struct MoeOrder {
    static constexpr bool GATHER = GATHER_;
    const PG8_LAS int* tab; int nN, T, nwg, G, c, wgm;
    __device__ __forceinline__ void init(const PG8_LAS int* tab_, int nN_, int G_, int c_, int wgm_ = WGM) { tab = tab_; nN = nN_; T = tab_[8]; nwg = T * nN_; G = G_; c = c_; wgm = wgm_; }
    __device__ __forceinline__ bool next(int i, Unit& u) const {
        const long L = (long)i * G + c; if (L >= nwg) return false;
        int wgid = (int)L; { const int q = nwg / NXCD, r = nwg % NXCD, xcd = wgid % NXCD, off = wgid / NXCD; wgid = (xcd < r ? xcd * (q + 1) : r * (q + 1) + (xcd - r) * q) + off; }
        const int nig = wgm * nN, gid = wgid / nig, fm = gid * wgm, gsz = (T - fm) < wgm ? (T - fm) : wgm;
        const int ct = fm + ((wgid % nig) % gsz), pn = (wgid % nig) / gsz;
        int e = 0;
#pragma unroll
        for (int j = 1; j < 8; ++j) e += (ct >= tab[j]) ? 1 : 0;
        const int lt = ct - tab[e], rem = tab[16 + e] - lt * BM;
        u.pm = ct; u.pn = e * nN + pn; u.pe = pn; u.ga = e * 16384 + lt * BM; u.nv = rem < BM ? rem : BM; u.nt = 0; u.ks = -1; return true;
    }
};
struct Moe2Order {
    static constexpr bool GATHER = false;
    const PG8_LAS int* tab; int T, G, c;
    __device__ __forceinline__ static int split_tiles(int T) { return T > 128 ? T - 128 : 0; }
    __device__ __forceinline__ static int slices(int nsplit) { return 4 * nsplit <= 18 ? 14 : 7; }
    __device__ __forceinline__ void init(const PG8_LAS int* tab_, int G_, int c_) { tab = tab_; T = tab_[8]; G = G_; c = c_; }
    __device__ __forceinline__ bool next(int i, Unit& u) const {
        const int nsplit = split_tiles(T), s = slices(nsplit), nnorm = (T - nsplit) * 4, total = nnorm + nsplit * 4 * s;
        const long L = (long)i * G + c; if (L >= total) return false;
        int ct, pn;
        if (L < nnorm) { int wgid = (int)L; { const int q = nnorm / NXCD, r = nnorm % NXCD, xcd = wgid % NXCD, off = wgid / NXCD; wgid = (xcd < r ? xcd * (q + 1) : r * (q + 1) + (xcd - r) * q) + off; }
            const int Tn = T - nsplit, nig = WGM * 4, gid = wgid / nig, fm = gid * WGM, gsz = (Tn - fm) < WGM ? (Tn - fm) : WGM;
            ct = fm + ((wgid % nig) % gsz); pn = (wgid % nig) / gsz; u.nt = 0; u.ks = -1; }
        else { const int j = (int)L - nnorm, sl = j % s, un = j / s; ct = T - nsplit + (un >> 2); pn = un & 3; u.nt = 56 / s; u.ks = sl; }
        int e = 0;
#pragma unroll
        for (int j = 1; j < 8; ++j) e += (ct >= tab[j]) ? 1 : 0;
        u.pm = ct; u.pn = e * 4 + pn; u.pe = pn; u.ga = 0; u.nv = BM; return true;
    }
};

__device__ __forceinline__ unsigned cvt_pk_bf16(float lo, float hi) { unsigned r; asm volatile("v_cvt_pk_bf16_f32 %0, %1, %2" : "=v"(r) : "v"(lo), "v"(hi)); return r; }
__device__ __forceinline__ float bf_lo(unsigned w) { return __uint_as_float(w << 16); }
__device__ __forceinline__ float bf_hi(unsigned w) { return __uint_as_float(w & 0xffff0000u); }
__device__ __forceinline__ float fexp2(float x) { return __builtin_amdgcn_exp2f(x); }
__device__ __forceinline__ float frcp(float x) { return __builtin_amdgcn_rcpf(x); }
__device__ __forceinline__ float sigmoid_f(float x) { return frcp(1.f + fexp2(-L2E * x)); }
__device__ __forceinline__ float silu_f(float x) { return x * sigmoid_f(x); }
__device__ __forceinline__ float gelu_tanh_f(float x) { const float y = 0.7978845608028654f * (x + 0.044715f * x * x * x); return x * frcp(1.f + fexp2(-2.f * L2E * y)); }
__device__ __forceinline__ float log_sigmoid_f(float x) { return fminf(x, 0.f) - LN2 * __builtin_amdgcn_logf(1.f + fexp2(-L2E * fabsf(x))); }
__device__ __forceinline__ u32x4 pack8(const f32x4 a, const f32x4 b) { u32x4 w; w.x = cvt_pk_bf16(a[0], a[1]); w.y = cvt_pk_bf16(a[2], a[3]); w.z = cvt_pk_bf16(b[0], b[1]); w.w = cvt_pk_bf16(b[2], b[3]); return w; }
#ifndef PG8_NT
#define PG8_NT 0
#endif
__device__ __forceinline__ void st16(void* p, u32x4 v, bool ok = true) { if (!ok) { asm volatile("" :: "v"(v)); return; } if (PG8_NT) __builtin_nontemporal_store(v, (u32x4*)p); else *(u32x4*)p = v; }
__device__ __forceinline__ void st16f(void* p, f32x4 v, bool ok = true) { if (!ok) { asm volatile("" :: "v"(v)); return; } if (PG8_NT) __builtin_nontemporal_store(v, (f32x4*)p); else *(f32x4*)p = v; }
__device__ __forceinline__ float row_rstd(const float* p, int row, int ns) { float s;
    if (ns == 1) s = p[row]; else { const f32x4* q = (const f32x4*)(p + (size_t)row * 16); const f32x4 a = q[0], b = q[1], c = q[2], d = q[3];
        s = (((a[0] + a[1]) + (a[2] + a[3])) + ((b[0] + b[1]) + (b[2] + b[3]))) + (((c[0] + c[1]) + (c[2] + c[3])) + ((d[0] + d[1]) + (d[2] + d[3]))); }
    return __builtin_amdgcn_rsqf(s * (1.f / 1024.f) + 1e-6f); }

struct EpiEvenIn {
    static constexpr bool PERM = true;
    bf16_t* Z; float* loga; float* vstp; const float* ssq; const float* gate_bias; int fl;
    __device__ __forceinline__ void rload(const Unit& u, int tid, float& a, float& b) const { a = (tid < BM) ? row_rstd(ssq, u.pm * BM + tid, 1) : 0.f; b = 0.f; }
    __device__ __forceinline__ void rstore(PG8_LAS float* rs, int tid, float a, float) const { if (tid < BM) rs[tid] = a; }
    __device__ __forceinline__ void operator()(const f32x4 (&acc)[2][2][4][2], const Unit& u, int wr, int wc, int fr, int fq, const PG8_LAS float* rs) const {
        const int pn = u.pe, row0 = u.pm * BM + wr * 64 + fr, cl = wc * 32 + 8 * fq;
        if (pn == 6) {
            f32x4 gb[2][2];
#pragma unroll
            for (int bj = 0; bj < 2; ++bj)
#pragma unroll
                for (int n = 0; n < 2; ++n) gb[bj][n] = *(const f32x4*)(gate_bias + bj * HALF + cl + 4 * n);
#pragma unroll
            for (int ai = 0; ai < 2; ++ai)
#pragma unroll
                for (int m = 0; m < 4; ++m) { const int row = row0 + ai * HALF + m * 16; const float r = rs[wr * 64 + fr + ai * HALF + m * 16];
#pragma unroll
                    for (int bj = 0; bj < 2; ++bj)
#pragma unroll
                        for (int n = 0; n < 2; ++n) { f32x4 v = acc[ai][bj][m][n] * r + gb[bj][n];
#pragma unroll
                            for (int e = 0; e < 4; ++e) v[e] = log_sigmoid_f(v[e]) * (1.f / 16.f);
                            st16f(loga + (size_t)row * 256 + bj * HALF + cl + 4 * n, v, !(fl & 2)); } }
            return;
        }
        const int zc = (pn < 6 ? pn : pn - 1) * BM + cl;
        const int ty = pn < 4 ? 1 : (pn == 4 ? 2 : (pn >= 9 ? 3 : 0));
        const bool st = (pn == 2 || pn == 3);
#pragma unroll
        for (int ai = 0; ai < 2; ++ai)
#pragma unroll
            for (int m = 0; m < 4; ++m) { const int row = row0 + ai * HALF + m * 16; const float r = rs[wr * 64 + fr + ai * HALF + m * 16];
                float s1 = 0.f, s2 = 0.f;
#pragma unroll
                for (int bj = 0; bj < 2; ++bj) { f32x4 v0 = acc[ai][bj][m][0] * r, v1 = acc[ai][bj][m][1] * r;
                    if (ty == 1) {
#pragma unroll
                        for (int e = 0; e < 4; ++e) { v0[e] = gelu_tanh_f(v0[e]); v1[e] = gelu_tanh_f(v1[e]); } }
                    else if (ty == 2) { v0 = v0 * 0.125f; v1 = v1 * 0.125f; }
                    else if (ty == 3) {
#pragma unroll
                        for (int e = 0; e < 4; ++e) { v0[e] = silu_f(v0[e]); v1[e] = silu_f(v1[e]); } }
                    if (st) {
#pragma unroll
                        for (int e = 0; e < 4; ++e) { s1 += v0[e] + v1[e]; s2 += v0[e] * v0[e] + v1[e] * v1[e]; } }
                    st16(Z + (size_t)row * 2560 + zc + bj * HALF, pack8(v0, v1), !(fl & 2)); }
                if (st) { s1 += __shfl_xor(s1, 16); s1 += __shfl_xor(s1, 32); s2 += __shfl_xor(s2, 16); s2 += __shfl_xor(s2, 32);
                    if (fq == 0) { const int j = 4 * (pn - 2) + wc; vstp[(size_t)row * 16 + j] = s1; vstp[(size_t)row * 16 + 8 + j] = s2; } } }
    }
};
struct EpiResid {
    static constexpr bool PERM = true;
    const float* xin; bf16_t* xb; float* ssqp; int fl;
    __device__ __forceinline__ void rload(const Unit&, int, float& a, float& b) const { a = 0.f; b = 0.f; }
    __device__ __forceinline__ void rstore(PG8_LAS float*, int, float, float) const {}
    __device__ __forceinline__ void operator()(const f32x4 (&acc)[2][2][4][2], const Unit& u, int wr, int wc, int fr, int fq, const PG8_LAS float*) const {
        const int row0 = u.pm * BM + wr * 64 + fr, c0 = u.pe * BM + wc * 32 + 8 * fq;
#pragma unroll
        for (int ai = 0; ai < 2; ++ai)
#pragma unroll
            for (int m = 0; m < 4; ++m) { const int row = row0 + ai * HALF + m * 16; const size_t off = (size_t)row * 1024 + c0; float s = 0.f;
#pragma unroll
                for (int bj = 0; bj < 2; ++bj) { f32x4 v0, v1;
                    if (xin) { v0 = *(const f32x4*)(xin + off + bj * HALF); v1 = *(const f32x4*)(xin + off + bj * HALF + 4); }
                    else { const u32x4 o = *(const u32x4*)(xb + off + bj * HALF); v0 = (f32x4){bf_lo(o.x), bf_hi(o.x), bf_lo(o.y), bf_hi(o.y)}; v1 = (f32x4){bf_lo(o.z), bf_hi(o.z), bf_lo(o.w), bf_hi(o.w)}; }
                    v0 = v0 + acc[ai][bj][m][0]; v1 = v1 + acc[ai][bj][m][1];
                    st16(xb + off + bj * HALF, pack8(v0, v1), !(fl & 2));
#pragma unroll
                    for (int e = 0; e < 4; ++e) s += v0[e] * v0[e] + v1[e] * v1[e]; }
                if (ssqp) { s += __shfl_xor(s, 16); s += __shfl_xor(s, 32); if (fq == 0) ssqp[(size_t)row * 16 + u.pe * 4 + wc] = s; }
                if (m & 1) asm volatile("" ::: "memory"); }
    }
};
template <bool MOE>
struct EpiSwiglu {
    static constexpr bool PERM = true;
    bf16_t* O; int ldo; const float* ssq; const float* rowr; const float* roww; int fl;
    __device__ __forceinline__ void rload(const Unit& u, int tid, float& a, float& b) const { a = 0.f; b = 0.f; if (tid < BM) { if (MOE) { a = rowr[u.ga + tid]; b = roww[u.ga + tid]; } else a = row_rstd(ssq, u.pm * BM + tid, 16); } }
    __device__ __forceinline__ void rstore(PG8_LAS float* rs, int tid, float a, float b) const { if (tid < BM) { rs[tid] = a; if (MOE) rs[BM + tid] = b; } }
    __device__ __forceinline__ void operator()(const f32x4 (&acc)[2][2][4][2], const Unit& u, int wr, int wc, int fr, int fq, const PG8_LAS float* rs) const {
        const int rl0 = wr * 64 + fr, c0 = u.pe * HALF + wc * 32 + 8 * fq;
#pragma unroll
        for (int ai = 0; ai < 2; ++ai)
#pragma unroll
            for (int m = 0; m < 4; ++m) { const int rl = rl0 + ai * HALF + m * 16, row = u.pm * BM + rl; float r, w = 1.f;
                r = rs[rl]; if (MOE) w = rs[BM + rl];
                const float c = -L2E * r, rw = w * r * r;
                const f32x4 a0 = acc[ai][0][m][0], a1 = acc[ai][0][m][1];
                f32x4 t0 = a0 * c, t1 = a1 * c, o0 = (a0 * acc[ai][1][m][0]) * rw, o1 = (a1 * acc[ai][1][m][1]) * rw;
#pragma unroll
                for (int e = 0; e < 4; ++e) { t0[e] = frcp(1.f + fexp2(t0[e])); t1[e] = frcp(1.f + fexp2(t1[e])); }
                o0 = o0 * t0; o1 = o1 * t1;
                st16(O + (size_t)row * ldo + c0, pack8(o0, o1), !(fl & 2)); }
    }
};
struct EpiBf16 {
    static constexpr bool PERM = true;
    bf16_t* O; int ldo; int fl; bf16_t* OP; size_t pstride; int prow0;
    __device__ __forceinline__ void rload(const Unit&, int, float& a, float& b) const { a = 0.f; b = 0.f; }
    __device__ __forceinline__ void rstore(PG8_LAS float*, int, float, float) const {}
    __device__ __forceinline__ void operator()(const f32x4 (&acc)[2][2][4][2], const Unit& u, int wr, int wc, int fr, int fq, const PG8_LAS float*) const {
        const int row0 = u.pm * BM + wr * 64 + fr, c0 = u.pe * BM + wc * 32 + 8 * fq;
#pragma unroll
        for (int ai = 0; ai < 2; ++ai)
#pragma unroll
            for (int m = 0; m < 4; ++m) { bf16_t* rp = (u.ks < 0 ? O : OP + (size_t)u.ks * pstride - (size_t)prow0 * BM * ldo) + (size_t)(row0 + ai * HALF + m * 16) * ldo + c0;
#pragma unroll
                for (int bj = 0; bj < 2; ++bj) st16(rp + bj * HALF, pack8(acc[ai][bj][m][0], acc[ai][bj][m][1]), !(fl & 2)); }
    }
};
struct EpiOddIn {
    static constexpr bool PERM = true;
    bf16_t* QKVG; size_t tstride; const float* ssq; const float* q_g; const float* k_g; float qscale; int fl;
    __device__ __forceinline__ void rload(const Unit& u, int tid, float& a, float& b) const { a = (tid < BM) ? row_rstd(ssq, u.pm * BM + tid, 16) : 0.f; b = 0.f; }
    __device__ __forceinline__ void rstore(PG8_LAS float* rs, int tid, float a, float) const { if (tid < BM) rs[tid] = a; }
    __device__ __forceinline__ void operator()(const f32x4 (&acc)[2][2][4][2], const Unit& u, int wr, int wc, int fr, int fq, const PG8_LAS float* rs) const {
        const int which = u.pe >> 2, head = (u.pe & 3) * 4 + wc, row0 = u.pm * BM + wr * 64 + fr;
        bf16_t* base = QKVG + (size_t)which * tstride + head * 64 + 8 * fq;
        f32x4 gv[2][2];
        if (which < 2) { const float* gp = which == 0 ? q_g : k_g; const float sc = which == 0 ? qscale : 1.f;
#pragma unroll
            for (int bj = 0; bj < 2; ++bj)
#pragma unroll
                for (int n = 0; n < 2; ++n) gv[bj][n] = *(const f32x4*)(gp + 32 * bj + 8 * fq + 4 * n) * sc; }
#pragma unroll
        for (int ai = 0; ai < 2; ++ai)
#pragma unroll
            for (int m = 0; m < 4; ++m) { const int row = row0 + ai * HALF + m * 16; const float r = rs[wr * 64 + fr + ai * HALF + m * 16];
                f32x4 v[2][2];
#pragma unroll
                for (int bj = 0; bj < 2; ++bj)
#pragma unroll
                    for (int n = 0; n < 2; ++n) v[bj][n] = acc[ai][bj][m][n] * r;
                if (which < 2) { float s = 0.f;
#pragma unroll
                    for (int bj = 0; bj < 2; ++bj)
#pragma unroll
                        for (int n = 0; n < 2; ++n)
#pragma unroll
                            for (int e = 0; e < 4; ++e) s += v[bj][n][e] * v[bj][n][e];
                    s += __shfl_xor(s, 16); s += __shfl_xor(s, 32);
                    const float rh = __builtin_amdgcn_rsqf(s * (1.f / 64.f) + 1e-6f);
#pragma unroll
                    for (int bj = 0; bj < 2; ++bj)
#pragma unroll
                        for (int n = 0; n < 2; ++n) v[bj][n] = v[bj][n] * gv[bj][n] * rh; }
                else if (which == 3) {
#pragma unroll
                    for (int bj = 0; bj < 2; ++bj)
#pragma unroll
                        for (int n = 0; n < 2; ++n)
#pragma unroll
                            for (int e = 0; e < 4; ++e) v[bj][n][e] = sigmoid_f(v[bj][n][e]); }
#pragma unroll
                for (int bj = 0; bj < 2; ++bj) st16(base + (size_t)row * 1024 + 32 * bj, pack8(v[bj][0], v[bj][1]), !(fl & 2)); }
    }
};

template <class Epi, class Sched, bool ALIGN_EPI>
__device__ __forceinline__ void gemm_phase(PG8_LAS unsigned char* lds, PG8_LAS float* rs, const Gemm g, const Sched& S, const Epi& E) {
    const int tid = threadIdx.x, wid = __builtin_amdgcn_readfirstlane(tid >> 6), lane = tid & 63, wr = wid >> 2, wc = wid & 3, fr = lane & 15, fq = lane >> 4;
    const int K = g.K, nt = K / BK;
    int Ra[2], Ca[2]; unsigned voffB[2];
#pragma unroll
    for (int i = 0; i < 2; ++i) { int R, C; stage_rc(tid * 16 + i * 8192, R, C); const int Rb = Epi::PERM ? ((R & ~31) + perm32(R & 31)) : R;
        Ra[i] = R; Ca[i] = C; voffB[i] = (unsigned)(Rb * K + C) * 2u; }
    const size_t kstep = (size_t)(BK * 2);
    const size_t hstep = (size_t)HALF * K * 2;
    const size_t tstep = 2 * hstep;
    const unsigned ldsw = (unsigned)wid * 1024u;
    const int aoff = lds_byte(wr * 64 + fr, fq * 8), boff = lds_byte(wc * 32 + fr, fq * 8);
#define PG8_SA(b, h) (((b) * 2 + (h)) * HTB)
#define PG8_SB(b, h) ((4 + (b) * 2 + (h)) * HTB)
#define PG8_STAGE(bufoff, gbase, voff) do { _Pragma("unroll") for (int _i = 0; _i < 2; ++_i) \
        __builtin_amdgcn_global_load_lds((const unsigned*)((const char*)(gbase) + (voff)[_i]), (PG8_LAS unsigned*)(lds + (bufoff) + ldsw + _i * 8192), 16, 0, 0); } while (0)
#define PG8_STAGE_A(bufoff, kb, offs) do { const char* _ab = (const char*)g.A + (kb); _Pragma("unroll") for (int _i = 0; _i < 2; ++_i) \
        __builtin_amdgcn_global_load_lds((const unsigned*)(_ab + (offs)[_i]), (PG8_LAS unsigned*)(lds + (bufoff) + ldsw + _i * 8192), 16, 0, 0); } while (0)
#define PG8_ROWS(dst, uu) do { _Pragma("unroll") for (int _h = 0; _h < 2; ++_h) _Pragma("unroll") for (int _i = 0; _i < 2; ++_i) { const int _rl = _h * HALF + Ra[_i]; \
        if constexpr (Sched::GATHER) { const int _rc = _rl < (uu).nv ? _rl : (uu).nv - 1; dst[_h][_i] = (unsigned)g.rowtok[(uu).ga + _rc]; }     \
        else { dst[_h][_i] = (unsigned)((uu).pm * BM + _rl); } } } while (0)
#define PG8_FIN(dst, src, uu) do { _Pragma("unroll") for (int _h = 0; _h < 2; ++_h) _Pragma("unroll") for (int _i = 0; _i < 2; ++_i) \
        dst[_h][_i] = src[_h][_i] * (unsigned)(K * 2) + (unsigned)((Ca[_i] + unit_k0(uu)) * 2); } while (0)
#define PG8_LDA(dst, b, h) do { _Pragma("unroll") for (int m = 0; m < 4; ++m) _Pragma("unroll") for (int k = 0; k < 2; ++k) dst[m][k] = *(const PG8_LAS bf16x8*)(lds + PG8_SA(b, h) + aoff + m * 2048 + k * 1024); } while (0)
#define PG8_LDB(dst, b, h) do { _Pragma("unroll") for (int n = 0; n < 2; ++n) _Pragma("unroll") for (int k = 0; k < 2; ++k) dst[n][k] = *(const PG8_LAS bf16x8*)(lds + PG8_SB(b, h) + boff + n * 2048 + k * 1024); } while (0)
#define PG8_MMA(ai, bj, At, Bt) do { __builtin_amdgcn_s_setprio(1); _Pragma("unroll") for (int m = 0; m < 4; ++m) _Pragma("unroll") for (int n = 0; n < 2; ++n) _Pragma("unroll") for (int k = 0; k < 2; ++k) \
        acc[ai][bj][m][n] = __builtin_amdgcn_mfma_f32_16x16x32_bf16(Bt[n][k], At[m][k], acc[ai][bj][m][n], 0, 0, 0); __builtin_amdgcn_s_setprio(0); } while (0)
#define PG8_WAIT_V(n) asm volatile("s_waitcnt vmcnt(" #n ")" ::: "memory")
#define PG8_WAIT_L(n) asm volatile("s_waitcnt lgkmcnt(" #n ")" ::: "memory")
#define PG8_BAR __builtin_amdgcn_s_barrier()
#define PG8_SCHED __builtin_amdgcn_sched_barrier(0)
    Unit cur, nxt; int ui = 0;
    if (!S.next(0, cur)) return;
    bool has_next = S.next(1, nxt);
    unsigned coff[2][2], noff[2][2];
    PG8_ROWS(coff, cur); PG8_FIN(coff, coff, cur);
    if (has_next) { PG8_ROWS(noff, nxt); PG8_FIN(noff, noff, nxt); } else {
#pragma unroll
        for (int h = 0; h < 2; ++h)
#pragma unroll
            for (int i = 0; i < 2; ++i) noff[h][i] = coff[h][i]; }
    f32x4 acc[2][2][4][2];
#pragma unroll
    for (int a = 0; a < 2; ++a)
#pragma unroll
        for (int b = 0; b < 2; ++b)
#pragma unroll
            for (int m = 0; m < 4; ++m)
#pragma unroll
                for (int n = 0; n < 2; ++n) acc[a][b][m][n] = (f32x4){0.f, 0.f, 0.f, 0.f};
    bf16x8 At[4][2], B0[2][2], B1[2][2];
    const char* cB = (const char*)g.Bt + (size_t)cur.pn * tstep + (size_t)unit_k0(cur) * 2;
    PG8_STAGE(PG8_SB(0, 0), cB, voffB); PG8_STAGE(PG8_SB(0, 1), cB + hstep, voffB); PG8_STAGE_A(PG8_SA(0, 0), 0, coff[0]); PG8_STAGE_A(PG8_SA(0, 1), 0, coff[1]);
    if (wr == 1) PG8_BAR;
    PG8_WAIT_V(2); PG8_BAR;
    PG8_STAGE(PG8_SB(1, 0), cB + kstep, voffB); PG8_STAGE_A(PG8_SA(1, 0), kstep, coff[0]); PG8_STAGE(PG8_SB(1, 1), cB + hstep + kstep, voffB);
    PG8_WAIT_V(6); PG8_BAR;
    for (;;) {
        const char* nB = has_next ? (const char*)g.Bt + (size_t)nxt.pn * tstep + (size_t)unit_k0(nxt) * 2 : cB;
        const int ntc = cur.nt ? cur.nt : nt;
        float rsa, rsb; E.rload(cur, tid, rsa, rsb);
        for (int t = 0; t < ntc; t += 2) {
            const bool last = (t == ntc - 2);
            const size_t k1 = (size_t)(t + 1) * kstep;
            const size_t k2 = last ? (size_t)0 : (size_t)(t + 2) * kstep; const char* b2 = last ? nB : cB + (size_t)(t + 2) * kstep;
            const size_t k3 = k2 + kstep; const char* b3 = b2 + kstep;
            unsigned o2[2][2];
#pragma unroll
            for (int h = 0; h < 2; ++h)
#pragma unroll
                for (int i = 0; i < 2; ++i) o2[h][i] = last ? noff[h][i] : coff[h][i];
            PG8_LDB(B0, 0, 0); PG8_LDB(B1, 0, 1); PG8_SCHED; PG8_LDA(At, 0, 0); PG8_STAGE_A(PG8_SA(1, 1), k1, coff[1]);
            PG8_WAIT_V(8); PG8_WAIT_L(0); PG8_BAR; PG8_MMA(0, 0, At, B0); PG8_MMA(0, 1, At, B1); PG8_BAR; PG8_SCHED;
            PG8_LDA(At, 0, 1); PG8_STAGE(PG8_SB(0, 0), b2, voffB); PG8_STAGE(PG8_SB(0, 1), b2 + hstep, voffB); PG8_STAGE_A(PG8_SA(0, 0), k2, o2[0]);
            PG8_WAIT_V(8); PG8_WAIT_L(0); PG8_BAR; PG8_MMA(1, 0, At, B0); PG8_MMA(1, 1, At, B1); PG8_BAR; PG8_SCHED;
            PG8_LDB(B0, 1, 0); PG8_LDB(B1, 1, 1); PG8_SCHED; PG8_LDA(At, 1, 0); PG8_STAGE_A(PG8_SA(0, 1), k2, o2[1]);
            PG8_WAIT_V(8); PG8_WAIT_L(0); PG8_BAR; PG8_MMA(0, 0, At, B0); PG8_MMA(0, 1, At, B1); PG8_BAR; PG8_SCHED;
            PG8_LDA(At, 1, 1); PG8_STAGE(PG8_SB(1, 0), b3, voffB); PG8_STAGE(PG8_SB(1, 1), b3 + hstep, voffB); PG8_STAGE_A(PG8_SA(1, 0), k3, o2[0]);
            PG8_WAIT_V(8); PG8_WAIT_L(0); PG8_BAR; PG8_MMA(1, 0, At, B0); PG8_MMA(1, 1, At, B1); PG8_BAR; PG8_SCHED;
        }
        if constexpr (ALIGN_EPI) { if (wr == 0) PG8_BAR; }
        Unit nn = nxt; const bool has_nn = has_next && S.next(ui + 2, nn);
        unsigned nnoff[2][2];
        if (has_nn) { PG8_ROWS(nnoff, nn); } else {
#pragma unroll
            for (int h = 0; h < 2; ++h)
#pragma unroll
                for (int i = 0; i < 2; ++i) nnoff[h][i] = 0u; }
        { const int ln = (int)__builtin_amdgcn_mbcnt_hi(~0u, __builtin_amdgcn_mbcnt_lo(~0u, 0u));
          E.rstore(rs, wid * 64 + ln, rsa, rsb);
          if constexpr (Sched::GATHER) { asm volatile("" : "+v"(nnoff[0][0]), "+v"(nnoff[0][1]), "+v"(nnoff[1][0]), "+v"(nnoff[1][1])); }
          PG8_WAIT_L(0); PG8_BAR;
          if (!(g.flags & 1)) E(acc, cur, wr, wc, ln & 15, ln >> 4, rs); }
        if (!has_next) break;
#pragma unroll
        for (int a = 0; a < 2; ++a)
#pragma unroll
            for (int b = 0; b < 2; ++b)
#pragma unroll
                for (int m = 0; m < 4; ++m)
#pragma unroll
                    for (int n = 0; n < 2; ++n) acc[a][b][m][n] = (f32x4){0.f, 0.f, 0.f, 0.f};
        cur = nxt; cB = nB; ++ui;
#pragma unroll
        for (int h = 0; h < 2; ++h)
#pragma unroll
            for (int i = 0; i < 2; ++i) coff[h][i] = noff[h][i];
        if (has_nn) { PG8_FIN(noff, nnoff, nn); }
        nxt = nn; has_next = has_nn;
        if constexpr (ALIGN_EPI) { if (wr == 1) PG8_BAR; }
    }
    PG8_WAIT_V(0);
    if constexpr (!ALIGN_EPI) { if (wr == 0) PG8_BAR; }
    PG8_BAR;
#undef PG8_SA
#undef PG8_SB
#undef PG8_STAGE
#undef PG8_STAGE_A
#undef PG8_ROWS
#undef PG8_FIN
#undef PG8_LDA
#undef PG8_LDB
#undef PG8_MMA
#undef PG8_WAIT_V
#undef PG8_WAIT_L
#undef PG8_BAR
#undef PG8_SCHED
}
}
#include <hip/hip_bf16.h>
namespace attn_body {
using bf16=__hip_bfloat16;
using bf16x8=__attribute__((ext_vector_type(8)))short;
using s16x4=__attribute__((ext_vector_type(4)))short;
using f32x16=__attribute__((ext_vector_type(16)))float;
using u32x4=__attribute__((ext_vector_type(4)))unsigned;
using f32x4l=__attribute__((ext_vector_type(4)))float;
constexpr int BATCH=4,NHEAD=16,SEQ=4096,D=64,DM=NHEAD*D;
constexpr int NW=8,QBLK=32,QB=QBLK*NW,KVBLK=64,NQB=SEQ/QB;
constexpr int ATTN_PITCH=DM, ATTN_UNIT_ROWS=QB;
__device__ __forceinline__ int crow(int r,int hi){return (r&3)+8*(r>>2)+4*hi;}
#define SBAR() __builtin_amdgcn_sched_barrier(0)
__device__ __forceinline__ void cmask(f32x16&p0,f32x16&p1,int jb,int qrel,int hi){
  const float NEG=-INFINITY; int kb=64*jb+4*hi;
  #pragma unroll
  for(int r=0;r<16;++r){int kv=kb+(r&3)+8*(r>>2); if(kv>qrel)p0[r]=NEG; if(kv+32>qrel)p1[r]=NEG;}
}

constexpr int NSLOT=3, SLOTB=8192;
constexpr int LDS_K=0, LDS_V=NSLOT*SLOTB, LDS_WS=2*NSLOT*SLOTB, LDS_OST=LDS_WS+NW*64*4, LDS_BYTES=LDS_OST+NW*4096;
constexpr float C2=0.125f*1.4426950408889634f;
__device__ __forceinline__ void glds16(const void*gsrc,unsigned lds_dst){unsigned keep;
  asm volatile("s_mov_b32 %0, m0\n\ts_mov_b32 m0, %2\n\ts_nop 0\n\tglobal_load_lds_dwordx4 %1, off\n\ts_mov_b32 m0, %0":"=&s"(keep):"v"(gsrc),"s"(lds_dst):"memory");}
__device__ __forceinline__ float max3f(float a,float b,float c){float r;asm("v_max3_f32 %0, %1, %2, %3":"=v"(r):"v"(a),"v"(b),"v"(c));return r;}
__device__ __forceinline__ float max2f(float a,float b){float r;asm("v_max_f32_e32 %0, %1, %2":"=v"(r):"v"(a),"v"(b));return r;}
__device__ __forceinline__ float fadd_s(float a,float b){float r;asm("v_add_f32_e32 %0, %1, %2":"=v"(r):"v"(a),"v"(b));return r;}
__device__ __forceinline__ float fsub_s(float a,float b){float r;asm("v_sub_f32_e32 %0, %1, %2":"=v"(r):"v"(a),"v"(b));return r;}
typedef float f32x2_t __attribute__((ext_vector_type(2))); typedef __bf16 bf16x2_t __attribute__((ext_vector_type(2)));
__device__ __forceinline__ unsigned cvtpk_s(float lo,float hi){f32x2_t v={lo,hi};bf16x2_t b=__builtin_convertvector(v,bf16x2_t);return __builtin_bit_cast(unsigned,b);}
#define WAIT_BAR(N) asm volatile("s_waitcnt vmcnt(" #N ") lgkmcnt(0)\n\ts_barrier":::"memory")

__device__ __forceinline__ void qkt(f32x16&p0,f32x16&p1,const char*Kslot,const bf16x8*qr,int r32,int hi){
  const char*kb=Kslot+hi*1024+r32*16;
  #pragma unroll
  for(int d0=0;d0<4;++d0){
    const bf16x8 b0=*reinterpret_cast<const bf16x8*>(kb+d0*2048);
    const bf16x8 b1=*reinterpret_cast<const bf16x8*>(kb+d0*2048+512);
    {p0=__builtin_amdgcn_mfma_f32_32x32x16_bf16(b0,qr[d0],p0,0,0,0);p1=__builtin_amdgcn_mfma_f32_32x32x16_bf16(b1,qr[d0],p1,0,0,0);}}
}
typedef __attribute__((address_space(3))) const char* lds_cptr;
typedef short v4i16_t __attribute__((ext_vector_type(4)));
__device__ __forceinline__ void kload8(bf16x8*kf,lds_cptr kp){
  kf[0]=*(const __attribute__((address_space(3))) bf16x8*)(kp);      kf[1]=*(const __attribute__((address_space(3))) bf16x8*)(kp+512);
  kf[2]=*(const __attribute__((address_space(3))) bf16x8*)(kp+2048); kf[3]=*(const __attribute__((address_space(3))) bf16x8*)(kp+2560);
  kf[4]=*(const __attribute__((address_space(3))) bf16x8*)(kp+4096); kf[5]=*(const __attribute__((address_space(3))) bf16x8*)(kp+4608);
  kf[6]=*(const __attribute__((address_space(3))) bf16x8*)(kp+6144); kf[7]=*(const __attribute__((address_space(3))) bf16x8*)(kp+6656);
}
__device__ __forceinline__ void kload2(bf16x8*kf,lds_cptr kp,int j){ kf[2*j]=*(const __attribute__((address_space(3))) bf16x8*)(kp+j*2048); kf[2*j+1]=*(const __attribute__((address_space(3))) bf16x8*)(kp+j*2048+512); }
__device__ __forceinline__ s16x4 vtr(lds_cptr p){ return __builtin_bit_cast(s16x4,__builtin_amdgcn_ds_read_tr16_b64_v4i16((__attribute__((address_space(3))) v4i16_t*)p)); }
__device__ __forceinline__ float rowmax(const f32x16&p0,const f32x16&p1){
  float a=max3f(p0[0],p0[1],p1[0]),b=max3f(p0[2],p0[3],p1[1]);a=max3f(a,p1[2],p1[3]);
  #pragma unroll
  for(int r=4;r<16;r+=4){a=max3f(a,p0[r],p0[r+1]);b=max3f(b,p0[r+2],p0[r+3]);a=max3f(a,p1[r],p1[r+1]);b=max3f(b,p1[r+2],p1[r+3]);}
  const float m=max2f(a,b);
  auto rr=__builtin_amdgcn_permlane32_swap(__float_as_uint(m),__float_as_uint(m),false,false);
  return max2f(__uint_as_float(rr[0]),__uint_as_float(rr[1]));
}
__device__ __forceinline__ void pv(f32x16*o,int vb,bf16x8 pa0,bf16x8 pa1,bf16x8 pa2,bf16x8 pa3){
  #pragma unroll
  for(int d0=0;d0<2;++d0){s16x4 lo[4],hi[4];
    #pragma unroll
    for(int ks=0;ks<4;++ks){
      asm volatile("ds_read_b64_tr_b16 %0,%1 offset:%c2":"=&v"(lo[ks]):"v"(vb),"i"(d0*4096+ks*1024):"memory");
      asm volatile("ds_read_b64_tr_b16 %0,%1 offset:%c2":"=&v"(hi[ks]):"v"(vb),"i"(d0*4096+ks*1024+512):"memory");}
    asm volatile("s_waitcnt lgkmcnt(0)":::"memory");SBAR();
    #define PK(k) (bf16x8){lo[k][0],lo[k][1],lo[k][2],lo[k][3],hi[k][0],hi[k][1],hi[k][2],hi[k][3]}
    o[d0]=__builtin_amdgcn_mfma_f32_32x32x16_bf16(pa0,PK(0),o[d0],0,0,0);
    o[d0]=__builtin_amdgcn_mfma_f32_32x32x16_bf16(pa1,PK(1),o[d0],0,0,0);
    o[d0]=__builtin_amdgcn_mfma_f32_32x32x16_bf16(pa2,PK(2),o[d0],0,0,0);
    o[d0]=__builtin_amdgcn_mfma_f32_32x32x16_bf16(pa3,PK(3),o[d0],0,0,0);
    #undef PK
  }
}

#ifndef ATTN_STORE16
#define ATTN_STORE16(p,v) (*(u32x4*)(p)=(v))
#endif
typedef __attribute__((address_space(3))) const float* lds_fptr; typedef __attribute__((address_space(3))) const f32x4l* lds_f4ptr;
template<int THRL> __device__ __forceinline__ void attn_unit(int b,int h,int qb,const bf16*Q,const bf16*__restrict__ K,const bf16*__restrict__ V,bf16*O,const bf16*__restrict__ OG,lds_fptr cbl,float skipthr,char*shm){
  const int tid=threadIdx.x,lane=tid&63,r32=lane&31,hi=lane>>5; const int wid=__builtin_amdgcn_readfirstlane(tid>>6);
  const long rowbase=(long)b*SEQ; const int q0=qb*QB;
  const bf16*Qw=Q+(rowbase+q0+wid*QBLK)*DM+h*D;
  int t0; { const int NTf=(q0+QB)/KVBLK; const float need=cbl[q0]+skipthr; const bool keep=(lane<NTf)?(cbl[64*lane+63]>=need):true;
    const unsigned long long mk=__ballot(keep); int f=(int)__builtin_ctzll(mk); f&=~1; t0=f<NTf-4?f:NTf-4; t0=__builtin_amdgcn_readfirstlane(t0); }
  const bf16*Kh=K+(rowbase+(long)t0*KVBLK)*DM+h*D,*Vh=V+(rowbase+(long)t0*KVBLK)*DM+h*D;
  const unsigned lds0=(unsigned)(uintptr_t)shm;
  float*wsf=(float*)(shm+LDS_WS)+wid*64;
  const bf16*ksrc=Kh+(long)lane*DM+wid*8;
  const bf16*vsrc=Vh+(long)(16*(wid&3)+(lane>>2))*DM+(wid>>2)*32+(lane&3)*8;
  const unsigned kdst=lds0+LDS_K+wid*1024, vdst=lds0+LDS_V+wid*1024;
  #define DMA_K(t,slot) glds16(ksrc+(long)(t)*KVBLK*DM,(unsigned)__builtin_amdgcn_readfirstlane(kdst+(slot)))
  #define DMA_V(t,slot) glds16(vsrc+(long)(t)*KVBLK*DM,(unsigned)__builtin_amdgcn_readfirstlane(vdst+(slot)))
  const int vb0=(int)(lds0+LDS_V)+((lane>>4)&1)*32+(lane&3)*8+(4*hi+((lane&15)>>2))*64;
  const char*Kbase=shm+LDS_K; bf16x8 kf[8];
  const lds_cptr shm3=(lds_cptr)shm; const lds_cptr kp0=shm3+LDS_K+hi*1024+r32*16; const lds_cptr vp0=shm3+LDS_V+((lane>>4)&1)*32+(lane&3)*8+(4*hi+((lane&15)>>2))*64;
  const int NT=(q0+QB)/KVBLK-t0;
  DMA_K(0,0);DMA_V(0,0);DMA_K(1,SLOTB);
  bf16x8 qr[4];
  #pragma unroll
  for(int d0=0;d0<4;++d0)qr[d0]=*reinterpret_cast<const bf16x8*>(&Qw[(long)r32*DM+d0*16+hi*8]);
  float mhat=cbl[q0+wid*QBLK+r32],l_reg=0.f;f32x16 o[2];o[0]=f32x16{};o[1]=f32x16{};

  const lds_fptr cbh=cbl+64*t0+4*hi;
  #define CINIT(C0,C1,t) do{ const lds_fptr cb_=cbh+64*(t); _Pragma("unroll") for(int g_=0;g_<4;++g_){ const f32x4l x0_=*(lds_f4ptr)(cb_+8*g_), x1_=*(lds_f4ptr)(cb_+32+8*g_); \
      _Pragma("unroll") for(int j_=0;j_<4;++j_){ C0[4*g_+j_]=x0_[j_]-mhat; C1[4*g_+j_]=x1_[j_]-mhat; } } }while(0)
  const int qrel=wid*QBLK+r32;
  #define CMASK(P0,P1,t) do{int jb_=(t)-(NT-4); if(jb_>=0)cmask(P0,P1,jb_,qrel,hi);}while(0)
  bool resc=false;
  #define START(P0,P1) do{ resc=false; \
    _Pragma("unroll") for(int r=0;r<16;++r)P0[r]=__builtin_amdgcn_exp2f(P0[r]); }while(0)
  #define RESC() do{ if(resc){ asm volatile("s_waitcnt lgkmcnt(0)":::"memory"); \
      _Pragma("unroll") for(int d_=0;d_<2;++d_) _Pragma("unroll") for(int r=0;r<16;++r)o[d_][r]*=wsf[crow(r,hi)]; } }while(0)
  f32x16 pA0,pA1,pB0,pB1;
  int sl_prev=0,sl_cur=0,sl_next=SLOTB;
  #define ROT() do{sl_prev=sl_cur;sl_cur=sl_next;sl_next=(sl_next==(NSLOT-1)*SLOTB)?0:sl_next+SLOTB;}while(0)
  DMA_K(2,2*SLOTB);
  WAIT_BAR(3);
  CINIT(pA0,pA1,0); qkt(pA0,pA1,Kbase,qr,r32,hi);asm volatile("s_nop 15\n\ts_nop 7":"+v"(pA0),"+v"(pA1));CMASK(pA0,pA1,0);
  START(pA0,pA1);
  _Pragma("unroll") for(int r=0;r<16;++r)pA1[r]=__builtin_amdgcn_exp2f(pA1[r]);
  WAIT_BAR(0);
  DMA_K(3,0);DMA_V(1,SLOTB);
  ROT();
  kload8(kf,kp0+sl_cur);
  WAIT_BAR(2);
  s16x4 vlo[8],vhi[8]; u32x4 pw0,pw1,pw2,pw3;
  #define PKW(P,B) cvtpk_s(P[B],P[B+1])
  #define PAF(k) __builtin_bit_cast(bf16x8,pw##k)
  #define VFR(i) (bf16x8){vlo[i][0],vlo[i][1],vlo[i][2],vlo[i][3],vhi[i][0],vhi[i][1],vhi[i][2],vhi[i][3]}
  #define PIN(x) asm volatile("":"+v"(x))
  #define MX3(a,b,c) __builtin_fmaxf(__builtin_fmaxf((a),(b)),(c))
  #define GAPA(MF,A0,A1,A2,A3,W0,W1,PW) do{ MF; sacc+=A0; sacc+=A1; sacc+=A2; sacc+=A3; PIN(sacc); W0; W1; PIN(PW); SBAR(); }while(0)
  #define EX(v) __builtin_amdgcn_exp2f(v)
  #define GAPB(MF,X,B) do{ MF; X[B]=EX(X[B]); X[B+1]=EX(X[B+1]); X[B+2]=EX(X[B+2]); X[B+3]=EX(X[B+3]); PIN(X); SBAR(); }while(0)
  #define VRD(i) do{ vlo[i]=vtr(vp_+(((i)>>2)*4096+((i)&3)*1024)); vhi[i]=vtr(vp_+(((i)>>2)*4096+((i)&3)*1024+512)); }while(0)
  #define KRD(G,j) do{ if(G){ kload2(kf,kp0+sl_next,j); SBAR(); } }while(0)
  #define STEP(C0,C1,P0,P1,t,GK,GV,GL) do{ SBAR(); \
    const lds_cptr vp_=vp0+sl_prev; \
    CINIT(C0,C1,t); SBAR(); VRD(0); SBAR(); float sacc=(P0[0]+P0[1]); \
    GAPA(C0=__builtin_amdgcn_mfma_f32_32x32x16_bf16(kf[0],qr[0],C0,0,0,0), P0[2],P0[3],P0[4],P0[5],     pw0[0]=PKW(P0,0), pw0[1]=PKW(P0,2), pw0); \
    VRD(4); SBAR(); GAPA(C1=__builtin_amdgcn_mfma_f32_32x32x16_bf16(kf[1],qr[0],C1,0,0,0), P0[6],P0[7],P0[8],P0[9],     pw0[2]=PKW(P0,4), pw0[3]=PKW(P0,6), pw0); \
    VRD(1); SBAR(); GAPA(C0=__builtin_amdgcn_mfma_f32_32x32x16_bf16(kf[2],qr[1],C0,0,0,0),   P0[10],P0[11],P0[12],P0[13], pw1[0]=PKW(P0,8), pw1[1]=PKW(P0,10), pw1); \
    VRD(5); SBAR(); GAPA(C1=__builtin_amdgcn_mfma_f32_32x32x16_bf16(kf[3],qr[1],C1,0,0,0),   P0[14],P0[15],P1[0],P1[1],   pw1[2]=PKW(P0,12),pw1[3]=PKW(P0,14), pw1); \
    VRD(2); SBAR(); GAPA(C0=__builtin_amdgcn_mfma_f32_32x32x16_bf16(kf[4],qr[2],C0,0,0,0),   P1[2],P1[3],P1[4],P1[5],     pw2[0]=PKW(P1,0), pw2[1]=PKW(P1,2), pw2); \
    VRD(6); SBAR(); GAPA(C1=__builtin_amdgcn_mfma_f32_32x32x16_bf16(kf[5],qr[2],C1,0,0,0),   P1[6],P1[7],P1[8],P1[9],     pw2[2]=PKW(P1,4), pw2[3]=PKW(P1,6), pw2); \
    VRD(3); SBAR(); GAPA(C0=__builtin_amdgcn_mfma_f32_32x32x16_bf16(kf[6],qr[3],C0,0,0,0),   P1[10],P1[11],P1[12],P1[13], pw3[0]=PKW(P1,8), pw3[1]=PKW(P1,10), pw3); \
    VRD(7); SBAR(); GAPA(C1=__builtin_amdgcn_mfma_f32_32x32x16_bf16(kf[7],qr[3],C1,0,0,0),   P1[14],P1[15],0.f,0.f,       pw3[2]=PKW(P1,12),pw3[3]=PKW(P1,14), pw3); \
    l_reg+=sacc; \
    if(GK){DMA_K((t)+3,sl_cur);} if(GV){DMA_V((t)+1,sl_next);} \
    CMASK(C0,C1,t); \
    { float a=MX3(C0[0],C0[1],C1[0]),b=MX3(C0[2],C0[3],C1[1]); a=MX3(a,C1[2],C1[3]); \
      _Pragma("unroll") for(int r=4;r<16;r+=4){a=MX3(a,C0[r],C0[r+1]);b=MX3(b,C0[r+2],C0[r+3]);a=MX3(a,C1[r],C1[r+1]);b=MX3(b,C1[r+2],C1[r+3]);} \
      float rm=__builtin_fmaxf(a,b); { auto rr=__builtin_amdgcn_permlane32_swap(__float_as_uint(rm),__float_as_uint(rm),false,false); rm=__builtin_fmaxf(__uint_as_float(rr[0]),__uint_as_float(rr[1])); } \
      resc=false; \
      if(__builtin_expect(__any(rm>(float)THRL),0)){ const float dl=__builtin_fmaxf(rm,0.f); mhat+=dl; \
        _Pragma("unroll") for(int r=0;r<16;++r){C0[r]-=dl;C1[r]-=dl;} \
        const float f=__builtin_amdgcn_exp2f(-dl); l_reg*=f; if(hi==0)wsf[r32]=f; resc=true; } } \
    SBAR(); \
    GAPB(o[0]=__builtin_amdgcn_mfma_f32_32x32x16_bf16(PAF(0),VFR(0),o[0],0,0,0), C0,0); \
    GAPB(o[1]=__builtin_amdgcn_mfma_f32_32x32x16_bf16(PAF(0),VFR(4),o[1],0,0,0), C0,4); \
    KRD(GL,0); GAPB(o[0]=__builtin_amdgcn_mfma_f32_32x32x16_bf16(PAF(1),VFR(1),o[0],0,0,0), C0,8); \
    KRD(GL,1); GAPB(o[1]=__builtin_amdgcn_mfma_f32_32x32x16_bf16(PAF(1),VFR(5),o[1],0,0,0), C0,12); \
    KRD(GL,2); GAPB(o[0]=__builtin_amdgcn_mfma_f32_32x32x16_bf16(PAF(2),VFR(2),o[0],0,0,0), C1,0); \
    KRD(GL,3); GAPB(o[1]=__builtin_amdgcn_mfma_f32_32x32x16_bf16(PAF(2),VFR(6),o[1],0,0,0), C1,4); \
    GAPB(o[0]=__builtin_amdgcn_mfma_f32_32x32x16_bf16(PAF(3),VFR(3),o[0],0,0,0), C1,8); \
    GAPB(o[1]=__builtin_amdgcn_mfma_f32_32x32x16_bf16(PAF(3),VFR(7),o[1],0,0,0), C1,12); \
    }while(0)
  int t=1;
  #undef CMASK
  #define CMASK(P0,P1,t) do{}while(0)
  for(;t+5<NT;t+=2){
    STEP(pB0,pB1,pA0,pA1,t,true,true,true);     WAIT_BAR(2); RESC(); ROT();
    STEP(pA0,pA1,pB0,pB1,t+1,true,true,true);   WAIT_BAR(2); RESC(); ROT();
  }
  #undef CMASK
  #define CMASK(P0,P1,t) do{int jb_=(t)-(NT-4); if(jb_>=0)cmask(P0,P1,jb_,qrel,hi);}while(0)
  #define ENDW(tt) do{ if((tt)+3<NT){WAIT_BAR(2);} else if((tt)+2<NT){WAIT_BAR(1);} else {WAIT_BAR(0);} }while(0)
  for(;t+1<NT;t+=2){
    STEP(pB0,pB1,pA0,pA1,t,(t+3<NT),(t+1<NT),(t+1<NT));       ENDW(t);   RESC(); ROT();
    STEP(pA0,pA1,pB0,pB1,t+1,(t+4<NT),(t+2<NT),(t+2<NT));     ENDW(t+1); RESC(); ROT();
  }
  STEP(pB0,pB1,pA0,pA1,NT-1,false,false,false); RESC();
  { float sacc=pB0[0]+pB0[1]; _Pragma("unroll") for(int r=2;r<16;++r)sacc+=pB0[r]; _Pragma("unroll") for(int r=0;r<16;++r)sacc+=pB1[r]; l_reg+=sacc;
    pw0=(u32x4){PKW(pB0,0),PKW(pB0,2),PKW(pB0,4),PKW(pB0,6)};pw1=(u32x4){PKW(pB0,8),PKW(pB0,10),PKW(pB0,12),PKW(pB0,14)};pw2=(u32x4){PKW(pB1,0),PKW(pB1,2),PKW(pB1,4),PKW(pB1,6)};pw3=(u32x4){PKW(pB1,8),PKW(pB1,10),PKW(pB1,12),PKW(pB1,14)};
    SBAR(); pv(o,vb0+sl_cur,PAF(0),PAF(1),PAF(2),PAF(3)); }
  #undef PKW
  #undef PAF
  #undef VFR
  #undef PIN
  #undef MX3
  #undef GAPA
  #undef GAPB
  #undef EX
  #undef VRD
  #undef KRD
  #undef STEP
  #undef ENDW
  {auto rr=__builtin_amdgcn_permlane32_swap(__float_as_uint(l_reg),__float_as_uint(l_reg),false,false);l_reg=__uint_as_float(rr[0])+__uint_as_float(rr[1]);}
  if(hi==0)wsf[32+r32]=l_reg;asm volatile("s_waitcnt lgkmcnt(0)":::"memory");
  float rli[16];
  #pragma unroll
  for(int r=0;r<16;++r)rli[r]=__builtin_amdgcn_rcpf(wsf[32+crow(r,hi)]);
  bf16*Ow=O+(rowbase+q0+wid*QBLK)*DM+h*D; const bf16*OGw=OG+(rowbase+q0+wid*QBLK)*DM+h*D;
  { bf16*stg=(bf16*)(shm+LDS_OST)+wid*2048;
    #pragma unroll
    for(int r=0;r<16;++r){const int orow=crow(r,hi);
      #pragma unroll
      for(int d0=0;d0<2;++d0)stg[orow*64+d0*32+r32]=__float2bfloat16(o[d0][r]*rli[r]);}
    asm volatile("s_waitcnt lgkmcnt(0)":::"memory");
    #pragma unroll
    for(int i=0;i<4;++i){const int row=i*8+(lane>>3),ch=lane&7; u32x4 v=*(const u32x4*)(stg+row*64+ch*8); const u32x4 gt=*(const u32x4*)(OGw+(long)row*DM+ch*8);
      #pragma unroll
      for(int e=0;e<4;++e){ const float lo=__uint_as_float(v[e]<<16)*__uint_as_float(gt[e]<<16), hh=__uint_as_float(v[e]&0xffff0000u)*__uint_as_float(gt[e]&0xffff0000u); v[e]=cvtpk_s(lo,hh); }
      ATTN_STORE16(Ow+(long)row*DM+ch*8,v);} }
  asm volatile("s_waitcnt lgkmcnt(0)\n\ts_barrier":::"memory");
  #undef DMA_K
  #undef DMA_V
  #undef CMASK
  #undef START
  #undef RESC
  #undef ROT
  #undef CINIT
}
constexpr int ATTN_LDS_BYTES=LDS_BYTES;
struct AttnTensors { const bf16* Q; const bf16* K; const bf16* V; bf16* O; const bf16* OG; };
struct AttnUnit { int bh; int qb; };
struct StaticOrder {
  int vcu;
  __device__ __forceinline__ explicit StaticOrder(int vcu_):vcu(vcu_){}
  __device__ __forceinline__ bool next(int i,AttnUnit&u)const{ if(i>=4)return false; const int s0=2*(vcu&3); u.bh=vcu>>2; u.qb=(i==0)?15-s0:(i==1)?s0:(i==2)?14-s0:s0+1; return true; }
  __device__ __forceinline__ void a_ready(const AttnUnit&)const{}
  __device__ __forceinline__ void done(const AttnUnit&)const{}
};
template<class Sched,int THRL=8> __device__ __forceinline__ void attn_phase(char*lds,lds_fptr cbl,float skipthr,const AttnTensors&T,const Sched&S){
  AttnUnit u;
  for(int i=0;S.next(i,u);++i){ S.a_ready(u); attn_unit<THRL>(u.bh/NHEAD,u.bh%NHEAD,u.qb,T.Q,T.K,T.V,T.O,T.OG,cbl,skipthr,lds); S.done(u); }
}
#undef SBAR
#undef WAIT_BAR
}
namespace mx {
#define MLAS __attribute__((address_space(3)))
typedef unsigned short bf16_t;
typedef short bf16x8 __attribute__((ext_vector_type(8)));
typedef float f32x16 __attribute__((ext_vector_type(16)));
typedef float f32x4 __attribute__((ext_vector_type(4)));
typedef unsigned u32x4 __attribute__((ext_vector_type(4)));
typedef unsigned u32x2 __attribute__((ext_vector_type(2)));
constexpr float L2E = 1.4426950408889634f;
constexpr int ZP = 2560;
constexpr int PV = 136, PK = 72;
constexpr int GP = 65;

__device__ __forceinline__ unsigned pk2(float lo, float hi) { unsigned r; asm("v_cvt_pk_bf16_f32 %0, %1, %2" : "=v"(r) : "v"(lo), "v"(hi)); return r; }
__device__ __forceinline__ bf16_t f2bf(float f) { return (bf16_t)(pk2(f, 0.f) & 0xffffu); }
__device__ __forceinline__ float bf2f(bf16_t b) { return __uint_as_float((unsigned)b << 16); }
__device__ __forceinline__ float blo(unsigned w) { return __uint_as_float(w << 16); }
__device__ __forceinline__ float bhi(unsigned w) { return __uint_as_float(w & 0xffff0000u); }
__device__ __forceinline__ float ex(float x) { return __builtin_amdgcn_exp2f(L2E * x); }
__device__ __forceinline__ f32x16 mma32(bf16x8 a, bf16x8 b, f32x16 c) { return __builtin_amdgcn_mfma_f32_32x32x16_bf16(a, b, c, 0, 0, 0); }
__device__ __forceinline__ float wsum(float v) {
#pragma unroll
    for (int o = 32; o; o >>= 1) v += __shfl_xor(v, o);
    return v; }

template <int NF>
__device__ __forceinline__ void stage_T(MLAS bf16_t* T, int P, const bf16_t* src, int pitch, int base, int col0, int tid) {
    for (int c = tid; c < 128 * (NF / 8); c += 512) { const int s = c & 127, fc = c >> 7;
        const u32x4 w = *(const u32x4*)(src + (size_t)(base + s) * pitch + col0 + fc * 8);
#pragma unroll
        for (int e = 0; e < 4; ++e) { T[(fc * 8 + 2 * e) * P + s] = (bf16_t)(w[e] & 0xffffu); T[(fc * 8 + 2 * e + 1) * P + s] = (bf16_t)(w[e] >> 16); } }
}
template <int NF>
__device__ __forceinline__ void stage_T_ld(u32x4 (&w)[NF / 32], const bf16_t* src, int pitch, int base, int col0, int tid) {
#pragma unroll
    for (int j = 0; j < NF / 32; ++j) { const int c = tid + 512 * j, s = c & 127, fc = c >> 7; w[j] = *(const u32x4*)(src + (size_t)(base + s) * pitch + col0 + fc * 8); }
}
template <int NF>
__device__ __forceinline__ void stage_T_st(MLAS bf16_t* T, int P, const u32x4 (&w)[NF / 32], int tid) {
#pragma unroll
    for (int j = 0; j < NF / 32; ++j) { const int c = tid + 512 * j, s = c & 127, fc = c >> 7;
#pragma unroll
        for (int e = 0; e < 4; ++e) { T[(fc * 8 + 2 * e) * P + s] = (bf16_t)(w[j][e] & 0xffffu); T[(fc * 8 + 2 * e + 1) * P + s] = (bf16_t)(w[j][e] >> 16); } }
}
__device__ __forceinline__ void gla_cumsum_ld(float (&la)[16], const float* loga, int base, int h, int tid) {
    const int kk = tid & 63, seg = tid >> 6;
#pragma unroll
    for (int i = 0; i < 16; ++i) la[i] = loga[(size_t)(base + seg * 16 + i) * 256 + h * 64 + kk];
}
__device__ __forceinline__ void gla_cumsum_st(MLAS float* G, MLAS float* SEG, const float (&la)[16], int tid) {
    const int kk = tid & 63, seg = tid >> 6; float v[16]; float run = 0.f;
#pragma unroll
    for (int i = 0; i < 16; ++i) { run += la[i]; v[i] = run; }
    SEG[seg * 64 + kk] = run;
    __syncthreads();
    float pre = 0.f;
#pragma unroll
    for (int s = 0; s < 8; ++s) pre += (s < seg) ? SEG[s * 64 + kk] : 0.f;
#pragma unroll
    for (int i = 0; i < 16; ++i) G[(seg * 16 + i) * GP + kk] = v[i] + pre;
    __syncthreads();
}
__device__ __forceinline__ void gla_cumsum(MLAS float* G, MLAS float* SEG, const float* loga, int base, int h, int tid) {
    const int kk = tid & 63, seg = tid >> 6; float v[16]; float run = 0.f;
#pragma unroll
    for (int i = 0; i < 16; ++i) { run += loga[(size_t)(base + seg * 16 + i) * 256 + h * 64 + kk]; v[i] = run; }
    SEG[seg * 64 + kk] = run;
    __syncthreads();
    float pre = 0.f;
#pragma unroll
    for (int s = 0; s < 8; ++s) pre += (s < seg) ? SEG[s * 64 + kk] : 0.f;
#pragma unroll
    for (int i = 0; i < 16; ++i) G[(seg * 16 + i) * GP + kk] = v[i] + pre;
    __syncthreads();
}

__device__ __forceinline__ void gmlp_unit(MLAS unsigned char* lds, int chunk, int g, const bf16_t* Z, const float* vstp, const float* ln_g, const float* ln_b,
                                          const bf16_t* WSt, const float* b_s, bf16_t* MIX, int tid) {
    MLAS bf16_t* VT = (MLAS bf16_t*)lds;
    MLAS float* MU = (MLAS float*)(lds + 34816); MLAS float* RS = MU + 128;
    const int base = chunk * 128, lane = tid & 63, w = tid >> 6, r32 = lane & 31, hi = lane >> 5;
    bf16x8 wa[8];
    { const bf16_t* wrow = WSt + ((size_t)g * 128 + (w >> 1) * 32 + r32) * 128 + 8 * hi;
#pragma unroll
        for (int ks = 0; ks < 8; ++ks) wa[ks] = *(const bf16x8*)(wrow + 16 * ks); }
    u32x4 vw[4];
#pragma unroll
    for (int j = 0; j < 4; ++j) { const int c = tid + 512 * j, s = c & 127, dc = c >> 7; vw[j] = *(const u32x4*)(Z + (size_t)(base + s) * ZP + 512 + g * 128 + dc * 8); }
    const int it = w >> 1, jt0 = 2 * (w & 1);
    bf16_t u0[16], u1[16]; float bs[16];
    { const int d0 = jt0 * 32 + r32;
#pragma unroll
        for (int r = 0; r < 16; ++r) { const int t = it * 32 + (r & 3) + 8 * (r >> 2) + 4 * hi; const size_t zo = (size_t)(base + t) * ZP + g * 128; bs[r] = b_s[g * 128 + t]; u0[r] = Z[zo + d0]; u1[r] = Z[zo + d0 + 32]; } }
    if (tid < 128) { const f32x4* q = (const f32x4*)(vstp + (size_t)(base + tid) * 16); const f32x4 a = q[0], b = q[1], c = q[2], d = q[3];
        const float s1 = ((a[0] + a[1]) + (a[2] + a[3])) + ((b[0] + b[1]) + (b[2] + b[3])), s2 = ((c[0] + c[1]) + (c[2] + c[3])) + ((d[0] + d[1]) + (d[2] + d[3])); const float mu = s1 * (1.f / 512.f);
        const float var = fmaxf(s2 * (1.f / 512.f) - mu * mu, 0.f); MU[tid] = mu; RS[tid] = 1.0f / sqrtf(var + 1e-6f); }
    __syncthreads();
#pragma unroll
    for (int j = 0; j < 4; ++j) { const int c = tid + 512 * j, s = c & 127, dc = c >> 7;
        const u32x4 wv = vw[j];
        const float mu = MU[s], rs = RS[s];
        const f32x4 g0 = *(const f32x4*)(ln_g + g * 128 + dc * 8), g1 = *(const f32x4*)(ln_g + g * 128 + dc * 8 + 4);
        const f32x4 b0 = *(const f32x4*)(ln_b + g * 128 + dc * 8), b1 = *(const f32x4*)(ln_b + g * 128 + dc * 8 + 4);
        const float gg[8] = {g0[0], g0[1], g0[2], g0[3], g1[0], g1[1], g1[2], g1[3]}, bb[8] = {b0[0], b0[1], b0[2], b0[3], b1[0], b1[1], b1[2], b1[3]};
#pragma unroll
        for (int e = 0; e < 4; ++e) { const unsigned p = pk2((blo(wv[e]) - mu) * rs * gg[2 * e] + bb[2 * e], (bhi(wv[e]) - mu) * rs * gg[2 * e + 1] + bb[2 * e + 1]);
            VT[(dc * 8 + 2 * e) * PV + s] = (bf16_t)(p & 0xffffu); VT[(dc * 8 + 2 * e + 1) * PV + s] = (bf16_t)(p >> 16); } }
    __syncthreads();
    f32x16 acc0 = {}, acc1 = {};
    const MLAS bf16_t* v0 = VT + (jt0 * 32 + r32) * PV + 8 * hi; const MLAS bf16_t* v1 = v0 + 32 * PV;
#pragma unroll
    for (int ks = 0; ks < 8; ++ks) acc0 = mma32(wa[ks], *(const MLAS bf16x8*)(v0 + 16 * ks), acc0);
#pragma unroll
    for (int ks = 0; ks < 8; ++ks) acc1 = mma32(wa[ks], *(const MLAS bf16x8*)(v1 + 16 * ks), acc1);
    { const int d0 = jt0 * 32 + r32;
#pragma unroll
        for (int r = 0; r < 16; ++r) { const int t = it * 32 + (r & 3) + 8 * (r >> 2) + 4 * hi; const size_t mo = (size_t)(base + t) * 1024 + g * 128;
            MIX[mo + d0] = f2bf(bf2f(u0[r]) * (acc0[r] + bs[r])); MIX[mo + d0 + 32] = f2bf(bf2f(u1[r]) * (acc1[r] + bs[r])); } }
    __syncthreads();
}

__device__ __forceinline__ void gla_u_unit(MLAS unsigned char* lds, int cidx, int h, const bf16_t* Z, const float* loga, float* Ut, float* DEC, int tid) {
    MLAS float* G = (MLAS float*)lds; MLAS float* SEG = (MLAS float*)(lds + 33280);
    MLAS bf16_t* KT = (MLAS bf16_t*)(lds + 35328); MLAS bf16_t* VT = (MLAS bf16_t*)(lds + 52736);
    const int base = cidx * 128, unit = cidx * 4 + h, lane = tid & 63, w = tid >> 6, r32 = lane & 31, hi = lane >> 5;
    float la[16]; u32x4 kw[2], vw[4];
    gla_cumsum_ld(la, loga, base, h, tid);
#pragma unroll
    for (int j = 0; j < 2; ++j) { const int c = tid + 512 * j, s = c & 127, kc = c >> 7; kw[j] = *(const u32x4*)(Z + (size_t)(base + s) * ZP + 1280 + h * 64 + kc * 8); }
    stage_T_ld<128>(vw, Z, ZP, base, 1536 + h * 128, tid);
    stage_T_st<128>(VT, PV, vw, tid);
    gla_cumsum_st(G, SEG, la, tid);
#pragma unroll
    for (int j = 0; j < 2; ++j) { const int c = tid + 512 * j, s = c & 127, kc = c >> 7; const u32x4 wv = kw[j];
#pragma unroll
        for (int e = 0; e < 4; ++e) { const int k0 = kc * 8 + 2 * e;
            const unsigned p = pk2(blo(wv[e]) * ex(G[127 * GP + k0] - G[s * GP + k0]), bhi(wv[e]) * ex(G[127 * GP + k0 + 1] - G[s * GP + k0 + 1]));
            KT[k0 * PV + s] = (bf16_t)(p & 0xffffu); KT[(k0 + 1) * PV + s] = (bf16_t)(p >> 16); } }
    if (tid < 64) DEC[unit * 64 + tid] = ex(G[127 * GP + tid]);
    __syncthreads();
    const int vt = w >> 1, kt = w & 1; f32x16 acc = {};
    const MLAS bf16_t* ap = VT + (vt * 32 + r32) * PV + 8 * hi; const MLAS bf16_t* bp = KT + (kt * 32 + r32) * PV + 8 * hi;
#pragma unroll
    for (int ks = 0; ks < 8; ++ks) acc = mma32(*(const MLAS bf16x8*)(ap + 16 * ks), *(const MLAS bf16x8*)(bp + 16 * ks), acc);
#pragma unroll
    for (int r = 0; r < 16; ++r) { const int vv = vt * 32 + (r & 3) + 8 * (r >> 2) + 4 * hi; Ut[((size_t)unit * 128 + vv) * 64 + kt * 32 + r32] = acc[r]; }
    __syncthreads();
}
__device__ __forceinline__ void gla_scan(const float* Ut, const float* DEC, bf16_t* STt, int gtid, int gthreads) {
    for (int e = gtid; e < 16 * 128 * 64; e += gthreads) { const int kk = e & 63, vv = (e >> 6) & 127, bh = e >> 13, b = bh >> 2, h = bh & 3; float S = 0.f;
        float uu[32], dd[32];
#pragma unroll
        for (int n = 0; n < 32; ++n) { const int unit = (b * 32 + n) * 4 + h; uu[n] = Ut[((size_t)unit * 128 + vv) * 64 + kk]; dd[n] = DEC[unit * 64 + kk]; }
#pragma unroll
        for (int n = 0; n < 32; ++n) { const int unit = (b * 32 + n) * 4 + h; STt[((size_t)unit * 128 + vv) * 64 + kk] = f2bf(S); S = dd[n] * S + uu[n]; } }
}
__device__ __forceinline__ void gla_out_unit(MLAS unsigned char* lds, int cidx, int h, const bf16_t* Z, const float* loga, const bf16_t* STt, const float* head_g, bf16_t* MIX, int tid) {
    MLAS float* G = (MLAS float*)lds; MLAS bf16_t* AT = (MLAS bf16_t*)lds;
    MLAS float* SEG = (MLAS float*)(lds + 34816);
    MLAS bf16_t* QS = (MLAS bf16_t*)(lds + 36864); MLAS bf16_t* KS = (MLAS bf16_t*)(lds + 55296);
    MLAS bf16_t* VT = (MLAS bf16_t*)(lds + 73728);
    MLAS bf16_t* ST = (MLAS bf16_t*)(lds + 108544);
    MLAS float* RSQ = (MLAS float*)(lds + 126976);
    const int base = cidx * 128, unit = cidx * 4 + h, lane = tid & 63, w = tid >> 6, r32 = lane & 31, hi = lane >> 5;
    float la[16]; u32x4 qw[2], kw[2], vw[4], sw[2];
    gla_cumsum_ld(la, loga, base, h, tid);
#pragma unroll
    for (int j = 0; j < 2; ++j) { const int c = tid + 512 * j, s = c & 127, kc = c >> 7;
        qw[j] = *(const u32x4*)(Z + (size_t)(base + s) * ZP + 1024 + h * 64 + kc * 8); kw[j] = *(const u32x4*)(Z + (size_t)(base + s) * ZP + 1280 + h * 64 + kc * 8);
        const int c2 = tid + 512 * j, vv = c2 >> 3, kc2 = c2 & 7; sw[j] = *(const u32x4*)(STt + ((size_t)unit * 128 + vv) * 64 + kc2 * 8); }
    stage_T_ld<128>(vw, Z, ZP, base, 1536 + h * 128, tid);
    const int tt = w >> 1, t = tt * 32 + r32, vt0 = 2 * (w & 1);
    f32x4 hgv[2][4]; u32x2 sgv[2][4];
#pragma unroll
    for (int jj = 0; jj < 2; ++jj)
#pragma unroll
        for (int rq = 0; rq < 4; ++rq) { const int vv0 = (vt0 + jj) * 32 + 8 * rq + 4 * hi; hgv[jj][rq] = *(const f32x4*)(head_g + h * 128 + vv0); sgv[jj][rq] = *(const u32x2*)(Z + (size_t)(base + t) * ZP + 2048 + h * 128 + vv0); }
    stage_T_st<128>(VT, PV, vw, tid);
    gla_cumsum_st(G, SEG, la, tid);
#pragma unroll
    for (int j = 0; j < 2; ++j) { const int c = tid + 512 * j, s = c & 127, kc = c >> 7;
        const u32x4 qv = qw[j], kv = kw[j];
        u32x4 qo, ko;
#pragma unroll
        for (int e = 0; e < 4; ++e) { const int k0 = kc * 8 + 2 * e; const float d0 = G[s * GP + k0] - G[63 * GP + k0], d1 = G[s * GP + k0 + 1] - G[63 * GP + k0 + 1];
            qo[e] = pk2(blo(qv[e]) * ex(d0), bhi(qv[e]) * ex(d1)); ko[e] = pk2(blo(kv[e]) * ex(-d0), bhi(kv[e]) * ex(-d1)); }
        *(MLAS u32x4*)(QS + s * PK + kc * 8) = qo; *(MLAS u32x4*)(KS + s * PK + kc * 8) = ko; }
#pragma unroll
    for (int j = 0; j < 2; ++j) { const int c = tid + 512 * j, vv = c >> 3, kc = c & 7; const u32x4 sv = sw[j]; u32x4 so;
#pragma unroll
        for (int e = 0; e < 4; ++e) { const int k0 = kc * 8 + 2 * e; so[e] = pk2(blo(sv[e]) * ex(G[63 * GP + k0]), bhi(sv[e]) * ex(G[63 * GP + k0 + 1])); }
        *(MLAS u32x4*)(ST + vv * PK + kc * 8) = so; }
    __syncthreads();
#pragma unroll
    for (int q2 = 0; q2 < 2; ++q2) { const int st = (w & 1) + 2 * q2;
        if (st <= tt) { f32x16 acc = {}; const MLAS bf16_t* ap = KS + (st * 32 + r32) * PK + 8 * hi; const MLAS bf16_t* bp = QS + t * PK + 8 * hi;
#pragma unroll
            for (int ks = 0; ks < 4; ++ks) acc = mma32(*(const MLAS bf16x8*)(ap + 16 * ks), *(const MLAS bf16x8*)(bp + 16 * ks), acc);
#pragma unroll
            for (int rq = 0; rq < 4; ++rq) { const int s0 = st * 32 + 8 * rq + 4 * hi; float x[4];
#pragma unroll
                for (int j = 0; j < 4; ++j) x[j] = (s0 + j <= t) ? acc[4 * rq + j] : 0.f;
                u32x2 pw; pw.x = pk2(x[0], x[1]); pw.y = pk2(x[2], x[3]); *(MLAS u32x2*)(AT + t * PV + s0) = pw; } } }
    __syncthreads();
    f32x16 acc0 = {}, acc1 = {};
    { const MLAS bf16_t* bp = AT + t * PV + 8 * hi; const MLAS bf16_t* a0 = VT + (vt0 * 32 + r32) * PV + 8 * hi; const MLAS bf16_t* a1 = a0 + 32 * PV; const int nks = 2 * (tt + 1);
        for (int ks = 0; ks < nks; ++ks) { const bf16x8 b = *(const MLAS bf16x8*)(bp + 16 * ks); acc0 = mma32(*(const MLAS bf16x8*)(a0 + 16 * ks), b, acc0); acc1 = mma32(*(const MLAS bf16x8*)(a1 + 16 * ks), b, acc1); } }
    { const MLAS bf16_t* bp = QS + t * PK + 8 * hi; const MLAS bf16_t* a0 = ST + (vt0 * 32 + r32) * PK + 8 * hi; const MLAS bf16_t* a1 = a0 + 32 * PK;
#pragma unroll
        for (int ks = 0; ks < 4; ++ks) { const bf16x8 b = *(const MLAS bf16x8*)(bp + 16 * ks); acc0 = mma32(*(const MLAS bf16x8*)(a0 + 16 * ks), b, acc0); acc1 = mma32(*(const MLAS bf16x8*)(a1 + 16 * ks), b, acc1); } }
    float ss = 0.f;
#pragma unroll
    for (int r = 0; r < 16; ++r) ss += acc0[r] * acc0[r] + acc1[r] * acc1[r];
    ss += __shfl_xor(ss, 32);
    if (hi == 0) RSQ[t * 2 + (w & 1)] = ss;
    __syncthreads();
    const float rstd = __builtin_amdgcn_rsqf((RSQ[t * 2] + RSQ[t * 2 + 1]) * (1.f / 128.f) + 1e-6f);
#pragma unroll
    for (int jj = 0; jj < 2; ++jj)
#pragma unroll
        for (int rq = 0; rq < 4; ++rq) { const int vv0 = (vt0 + jj) * 32 + 8 * rq + 4 * hi;
            const f32x4 hg = hgv[jj][rq]; const u32x2 sg = sgv[jj][rq];
            float x[4];
#pragma unroll
            for (int j = 0; j < 4; ++j) x[j] = (jj == 0 ? acc0[4 * rq + j] : acc1[4 * rq + j]) * rstd * hg[j];
            u32x2 pw; pw.x = pk2(x[0] * blo(sg.x), x[1] * bhi(sg.x)); pw.y = pk2(x[2] * blo(sg.y), x[3] * bhi(sg.y));
            *(u32x2*)(MIX + (size_t)(base + t) * 1024 + 512 + h * 128 + vv0) = pw; }
    __syncthreads();
}

__device__ __forceinline__ void fgate_block(MLAS unsigned char* lds, int blk, const bf16_t* XB, const bf16_t* Wft, const float* ssq, const float* fb, float* LFC, float* BT, int tid) {
    typedef float f32x4_ __attribute__((ext_vector_type(4)));
    MLAS float* LF = (MLAS float*)lds;
    const int lane = tid & 63, w = tid >> 6, tg = w & 3, kh = w >> 2;
    { f32x4_ acc = {0.f, 0.f, 0.f, 0.f};
        const bf16_t* ap = XB + (size_t)(64 * blk + 16 * tg + (lane & 15)) * 1024 + 512 * kh + 8 * (lane >> 4); const bf16_t* bp = Wft + (size_t)(lane & 15) * 1024 + 512 * kh + 8 * (lane >> 4);
        bf16x8 av[16], bv[16];
#pragma unroll
        for (int ks = 0; ks < 16; ++ks) { av[ks] = *(const bf16x8*)(ap + 32 * ks); bv[ks] = *(const bf16x8*)(bp + 32 * ks); }
#pragma unroll
        for (int ks = 0; ks < 16; ++ks) acc = __builtin_amdgcn_mfma_f32_16x16x32_bf16(av[ks], bv[ks], acc, 0, 0, 0);
#pragma unroll
        for (int r = 0; r < 4; ++r) LF[kh * 1024 + (16 * tg + 4 * (lane >> 4) + r) * 16 + (lane & 15)] = acc[r]; }
    __syncthreads();
    for (int i = tid; i < 1024; i += 512) { const int tok = i >> 4, hh = i & 15; LF[i] = pg8::log_sigmoid_f((LF[i] + LF[1024 + i]) * pg8::row_rstd(ssq, 64 * blk + tok, 16) + fb[hh]); }
    __syncthreads();
    if (tid < 16) { const int b = blk >> 6, bl = blk & 63; float c = 0.f; float* dst = LFC + (size_t)(b * 16 + tid) * 4096 + bl * 64;
        for (int t = 0; t < 64; ++t) { c += LF[t * 16 + tid]; dst[t] = c; }
        BT[(b * 16 + tid) * 64 + bl] = c; }
    __syncthreads();
}
__device__ __forceinline__ void attn_bias(MLAS float* CB, MLAS float* OFF, int bh, const float* LFC, const float* BT, int tid) {
    if (tid < 64) { const float v = BT[bh * 64 + tid]; float x = v;
#pragma unroll
        for (int o = 1; o < 64; o <<= 1) { const float y = __shfl_up(x, o); if (tid >= o) x += y; }
        OFF[tid] = x - v; }
    __syncthreads();
    for (int s = tid; s < 4096; s += 512) CB[s] = -(LFC[(size_t)bh * 4096 + s] + OFF[s >> 6]) * L2E;
    __syncthreads();
}
}
typedef unsigned v2u __attribute__((ext_vector_type(2)));
#ifndef MK_WGM_IN0
#define MK_WGM_IN0 4
#endif
#ifndef MK_WGM_FFN1
#define MK_WGM_FFN1 4
#endif
#ifndef MK_WGM_IN1
#define MK_WGM_IN1 4
#endif
#ifndef MK_WGM_MOE1
#define MK_WGM_MOE1 4
#endif
#ifndef MK_ALIGN1
#define MK_ALIGN1 true
#endif
#ifndef MK_ALIGN
#define MK_ALIGN true
#endif
constexpr int NWAVES = 8;
constexpr int M = 16384, D = 1024, SEQ = 4096;
constexpr size_t MiB = 1u << 20, KiB = 1u << 10;
constexpr size_t WS_CTL = 0, CTL_ZERO_BYTES = 64 * KiB;
constexpr size_t WS_WE13 = 2 * MiB;
constexpr size_t WS_Y = 2 * MiB, WS_YP = 72 * MiB;
constexpr size_t WS_WE2 = 114 * MiB;
constexpr size_t WS_W0IN = 170 * MiB, WS_W0O = 176 * MiB, WS_W0F13 = 178 * MiB, WS_W0F2 = 189 * MiB, WS_W1IN = 195 * MiB, WS_W1O = 203 * MiB;
constexpr size_t WS_ACTE = 170 * MiB;
constexpr size_t WS_Z0 = 205 * MiB, WS_LOGA = 285 * MiB, WS_UT = 301 * MiB, WS_STT = 317 * MiB, WS_MIX = 325 * MiB;
constexpr size_t WS_SSQP1 = 360 * MiB, WS_SSQP2 = 361 * MiB, WS_VSTP = 362 * MiB;
constexpr size_t WS_ACT0 = 205 * MiB;
constexpr size_t WS_Q = 205 * MiB, WS_TSTRIDE = 32 * MiB;
constexpr size_t WS_TAB = 408 * MiB;
constexpr size_t TB_SSQ0 = WS_TAB, TB_DEC = WS_TAB + 64 * KiB, TB_LFC = WS_TAB + 256 * KiB, TB_BT = WS_TAB + 1280 * KiB, TB_ROWTOK = WS_TAB + 1536 * KiB, TB_ROWR = WS_TAB + 2048 * KiB,
                 TB_ROWW = WS_TAB + 2560 * KiB, TB_TOKINFO = WS_TAB + 3072 * KiB, TB_WST = WS_TAB + 3328 * KiB, TB_WFT = WS_TAB + 3456 * KiB, TB_GRH = WS_TAB + 3488 * KiB;
constexpr size_t WS_XB = 434 * MiB, WS_END = 466 * MiB;
constexpr size_t CT_BAR = 16 * KiB, CT_CNT = 48 * KiB, CT_QCTR = 52 * KiB;
constexpr int RING_BYTES = 131072, LDSCTL_OFF = RING_BYTES, MISC_OFF = LDSCTL_OFF + 320, TAB_OFF = LDSCTL_OFF + 512;
constexpr int LDS_BYTES = 147456;
constexpr int ATT_CB_OFF = 86016, ATT_OFF_OFF = 102400;

enum { IN_X = 0, IN_E_NMIX, IN_E_WIN, IN_E_GUP, IN_E_GBIAS, IN_E_WS, IN_E_BS, IN_E_LNG, IN_E_LNB, IN_E_HG, IN_E_WO, IN_E_NFFN, IN_E_W1, IN_E_W3, IN_E_W2,
       IN_O_NMIX, IN_O_WIN, IN_O_FB, IN_O_QG, IN_O_KG, IN_O_WO, IN_O_NFFN, IN_O_ROUTER, IN_O_W1, IN_O_W3, IN_O_W2, IN_FINAL, N_IN };

__device__ __forceinline__ float wave_sum(float v) {
#pragma unroll
    for (int o = 1; o < 64; o <<= 1) v += __shfl_xor(v, o);
    return v; }
template <int NB>
__device__ __forceinline__ void tr_item(const float* W, int ldw, int c0, int K, const float* gain, bf16* WT, int drow0, LAS float* scr, int kb, int lane) {
    const int k0 = 64 * kb;
    const float* wp = W + (size_t)(k0 + (lane >> 5)) * ldw + c0 + (lane & 31);
#pragma unroll
    for (int b = 0; b < 32 / NB; ++b) { float v[NB];
#pragma unroll
        for (int i = 0; i < NB; ++i) v[i] = __builtin_nontemporal_load(wp + (size_t)(2 * (b * NB + i)) * ldw);
        if (gain) {
#pragma unroll
            for (int i = 0; i < NB; ++i) v[i] *= gain[k0 + 2 * (b * NB + i) + (lane >> 5)]; }
#pragma unroll
        for (int i = 0; i < NB; ++i) scr[(2 * (b * NB + i) + (lane >> 5)) * 33 + (lane & 31)] = v[i];
        if (NB < 32) asm volatile("" ::: "memory"); }
    LDS_WAIT(); asm volatile("" ::: "memory");
    const int c = lane & 7;
#pragma unroll
    for (int j = 0; j < 4; ++j) { const int n = (lane >> 3) + 8 * j; const LAS float* s = scr + (8 * c) * 33 + n;
        v4u o; o.x = pk2(s[0 * 33], s[1 * 33]); o.y = pk2(s[2 * 33], s[3 * 33]); o.z = pk2(s[4 * 33], s[5 * 33]); o.w = pk2(s[6 * 33], s[7 * 33]);
        *(GAS v4u*)(WT + (size_t)(drow0 + n) * K + k0 + 8 * c) = o; }
    LDS_WAIT(); asm volatile("" ::: "memory");
}
enum { MAP_PLAIN = 0, MAP_GLU = 1, MAP_HEAD = 2 };
template <int MAP, int NB = 32>
__device__ __forceinline__ void tr_job(const float* W, int ldw, int c0, int ncols, int K, const float* gain, bf16* WT, int dbase, LAS float* scr, int r, int lane) {
    const int nblk = ncols / 32, kb = r / nblk, n0 = 32 * (r % nblk); int drow;
    if (MAP == MAP_PLAIN) drow = dbase + n0;
    else if (MAP == MAP_GLU) drow = dbase + (n0 >> 7) * 256 + (n0 & 127);
    else { const int head = n0 >> 6, d = n0 & 63; drow = dbase + 256 * (head >> 2) + 128 * (d >> 5) + 32 * (head & 3) + (d & 31); }
    tr_item<NB>(W, ldw, c0 + n0, K, gain, WT, drow, scr, kb, lane);
}

constexpr int MOE_IE = 1792, MOE_A_ITEMS = 8 * 2 * MOE_IE, MOE_B_ITEMS = 8 * MOE_IE;
#ifndef MK_QB0
#define MK_QB0 0
#endif
constexpr int MOE_QB0 = MK_QB0;
#ifndef MK_IDLE_ITEMS
#define MK_IDLE_ITEMS 10
#endif
constexpr int MOE_IDLE_ITEMS = MK_IDLE_ITEMS, MOE_Q_IN0 = 64 * 8 * MOE_IDLE_ITEMS, MOE_Q_FFN1 = 128 * 8 * MOE_IDLE_ITEMS;
template <int NB = 32>
__device__ __forceinline__ void moe_item_a(int r, const float* w1, const float* w3, const float* g3, bf16* WE13, LAS float* scr, int lane) {
    const int e = r / (2 * MOE_IE), q = r % (2 * MOE_IE);
    if (q < MOE_IE) tr_job<MAP_GLU, NB>(w1 + (size_t)e * 1024 * 3584, 3584, 0, 3584, 1024, g3, WE13 + (size_t)e * 7168 * 1024, 0, scr, q, lane);
    else tr_job<MAP_GLU, NB>(w3 + (size_t)e * 1024 * 3584, 3584, 0, 3584, 1024, g3, WE13 + (size_t)e * 7168 * 1024, 128, scr, q - MOE_IE, lane);
}
__device__ __forceinline__ void moe_item_b(int r, const float* w2, bf16* WE2, LAS float* scr, int lane) {
    const int e = r / MOE_IE, q = r % MOE_IE;
    tr_job<MAP_PLAIN>(w2 + (size_t)e * 3584 * 1024, 1024, 0, 1024, 3584, nullptr, WE2 + (size_t)e * 1024 * 3584, 0, scr, q, lane);
}
__device__ __forceinline__ void moe_queue_drain_b(unsigned* qctr, const float* w2, bf16* WE2, LAS float* scr, int lane) {
    for (;;) { unsigned q = 0; if (lane == 0) q = __hip_atomic_fetch_add(qctr, 4u, RLX_AGENT); q = (unsigned)__builtin_amdgcn_readfirstlane((int)q) + (unsigned)MOE_QB0;
        if ((int)q >= MOE_B_ITEMS) break;
#pragma unroll 1
        for (int j = 0; j < 4; ++j) moe_item_b((int)q + j, w2, WE2, scr, lane); }
}
#ifndef MK_ARRIVE_SYNC
#define MK_ARRIVE_SYNC 1
#endif
struct XbTicket { unsigned lead, gen, last; };
__device__ __forceinline__ void xcd_census(unsigned* bar, unsigned x, unsigned& nloc, unsigned& nx, unsigned& mask) {
    const unsigned G = gridDim.x * gridDim.y * gridDim.z;
    unsigned sum, cnt, mine, mk, sp = 0u;
    for (;;) {
        sum = 0u; cnt = 0u; mine = 0u; mk = 0u;
#pragma unroll
        for (unsigned j = 0; j < 16; ++j) { const unsigned c = xb_ld(&bar[XB_XCNT(j)]); sum += c; cnt += (c > 0u) ? 1u : 0u; mk |= (c > 0u) ? (1u << j) : 0u; mine = (j == x) ? c : mine; }
        if (sum == G) break;
        __builtin_amdgcn_s_sleep(1);
        if ((++sp & 255u) == 0u) { if (xb_ld(&bar[XB_TMO])) break; if (sp > XB_SPIN_CAP) { atomicAdd(&bar[XB_TMO], 1u); break; } }
    }
    nloc = mine > 0u ? mine : 1u; nx = cnt > 0u ? cnt : 1u; mask = mk | (1u << x);
}
__device__ __forceinline__ XbTicket xcd_barrier_arrive(const XcdBarrier& b) {
    asm volatile("s_waitcnt vmcnt(0)" ::: "memory");
    __syncthreads();
    XbTicket t; t.lead = 0u; t.gen = 0u; t.last = 0u;
    if (threadIdx.x == 0) {
        unsigned* bar = b.bar;
        __builtin_amdgcn_s_waitcnt(0);
        unsigned nloc = b.st[0], nx = b.st[1];
        if (nloc == 0u) { unsigned mk; xcd_census(bar, b.x, nloc, nx, mk); b.st[0] = nloc; b.st[1] = nx; b.st[2] = mk; }
        const unsigned old = xb_add(&bar[XB_XSUB(b.x)], 1u);
        t.gen = old / nloc;
        if (old + 1u == (t.gen + 1u) * nloc) {
            t.lead = 1u;
            __builtin_amdgcn_fence(__ATOMIC_RELEASE, "agent");
            asm volatile("s_waitcnt vmcnt(0)" ::: "memory");
            const unsigned og = xb_add(&bar[XB_TOP], 1u);
            const unsigned tg = og / nx;
            if (og + 1u == (tg + 1u) * nx) {
                t.last = 1u; const unsigned mk = b.st[2];
#pragma unroll
                for (unsigned j = 0; j < 16; ++j) if ((mk >> j) & 1u) xb_add(&bar[XB_XGEN(j)], 1u);
            }
        }
    }
    if (MK_ARRIVE_SYNC) __syncthreads();
    return t;
}
__device__ __forceinline__ void xcd_barrier_wait(const XcdBarrier& b, const XbTicket& t) {
    if (threadIdx.x == 0) {
        unsigned* bar = b.bar;
        if (!(t.lead && t.last)) XB_SPIN(xb_ld(&bar[XB_XGEN(b.x)]) == t.gen, bar);
        __builtin_amdgcn_fence(__ATOMIC_ACQUIRE, "agent");
        asm volatile("s_waitcnt vmcnt(0)" ::: "memory");
    }
    __syncthreads();
}
struct Args { const float* in[N_IN]; float* out; unsigned char* ws; int ph_lo, ph_hi, flags, pad; };
enum { PH_PRO = 0, PH_IN0, PH_MIXA, PH_SCAN, PH_GLAO, PH_OUT0, PH_FFN1, PH_FFN2, PH_IN1, PH_ATTN, PH_OUT1, PH_ROUTE, PH_MOE1, PH_MOE2, PH_FINAL, N_PHASES };

__global__ void __launch_bounds__(NWAVES * 64, 2) mk_fwd(Args args) {
    extern __shared__ __attribute__((aligned(16))) unsigned char lds_raw[];
    LAS unsigned char* lds = (LAS unsigned char*)lds_raw;
    volatile LAS unsigned* MISC = (volatile LAS unsigned*)(lds + MISC_OFF);
    LAS int* TAB = (LAS int*)(lds + TAB_OFF); LAS float* RSB = (LAS float*)(lds + LDSCTL_OFF + 1024);
    const int tid = threadIdx.x, lane = tid & 63, wave = __builtin_amdgcn_readfirstlane(tid >> 6);
    const int G = gridDim.x, bx = blockIdx.x, vcu = (G % 8 == 0) ? (bx % 8) * (G / 8) + bx / 8 : bx;
    unsigned char* ws = args.ws;
    gu32* ctl = (gu32*)(ws + WS_CTL);
    for (int u = tid; u < (LDS_BYTES - LDSCTL_OFF) / 4; u += NWAVES * 64) ((LAS unsigned*)(lds + LDSCTL_OFF))[u] = 0u;
    __syncthreads();
    XcdBarrier bar = xcd_barrier_post((unsigned*)(ws + CT_BAR), MISC + 8);
    const int lo = args.ph_lo, hi = args.ph_hi;
#define IN(k) (lo <= (k) && (k) < hi)
#ifndef MK_SEAM_REP
#define MK_SEAM_REP 1
#endif
#ifndef MK_SHADOW_NB
#define MK_SHADOW_NB 16
#endif
#ifndef MK_SHADOW
#define MK_SHADOW 1
#endif
#define SEAM(k) do { if (IN(k) && IN((k) + 1)) { for (int sr_ = 0; sr_ < MK_SEAM_REP; ++sr_) { const XbTicket tk_ = xcd_barrier_arrive(bar); \
        if (SHADOWS_ON && ((k) == PH_MIXA || (k) == PH_SCAN)) {     \
            const int u_ = vcu + 256 * ((k) - PH_MIXA); mx::gmlp_unit(lds, u_ >> 2, u_ & 3, Z0, VSTAT, args.in[IN_E_LNG], args.in[IN_E_LNB], WST, args.in[IN_E_BS], MIX, tid); } \
        else if (SHADOWS_ON && (k) <= 10 && wave >= 8 - MK_SHADOW_W) { const int it_ = NPRO + ((k) < PH_MIXA ? (k) : (k) - 2) * SHADOW_WAVES + vcu * MK_SHADOW_W + (wave - (8 - MK_SHADOW_W)); if (it_ < NITEMS) { CONV_ITEM(it_, MK_SHADOW_NB); } } \
        xcd_barrier_wait(bar, tk_); } } } while (0)
#ifndef MK_REP
#define MK_REP 0
#endif
#define REPS(k) for (int rep_ = 0; rep_ <= ((MK_REP >> (k)) & 1); ++rep_)
#ifdef MK_EXPERIMENT
#define FL(k) ((((args.flags >> 8) == 0) || (((args.flags >> 8) >> (k)) & 1)) ? (args.flags & 0xff) : 0)
#else
#define FL(k) 0
#endif
    bf16* WE13 = (bf16*)(ws + WS_WE13); bf16* WE2 = (bf16*)(ws + WS_WE2); bf16* W0IN = (bf16*)(ws + WS_W0IN); bf16* W0O = (bf16*)(ws + WS_W0O); bf16* W0F13 = (bf16*)(ws + WS_W0F13);
    bf16* W0F2 = (bf16*)(ws + WS_W0F2); bf16* W1IN = (bf16*)(ws + WS_W1IN); bf16* W1O = (bf16*)(ws + WS_W1O); bf16* WST = (bf16*)(ws + TB_WST); bf16* WFT = (bf16*)(ws + TB_WFT); bf16* GRH = (bf16*)(ws + TB_GRH);
    bf16* XB = (bf16*)(ws + WS_XB); bf16* Z0 = (bf16*)(ws + WS_Z0); float* LOGA = (float*)(ws + WS_LOGA); float* UT = (float*)(ws + WS_UT); bf16* STT = (bf16*)(ws + WS_STT);
    bf16* MIX = (bf16*)(ws + WS_MIX); bf16* ACT0 = (bf16*)(ws + WS_ACT0); bf16* QB = (bf16*)(ws + WS_Q); bf16* ACTE = (bf16*)(ws + WS_ACTE); bf16* YB = (bf16*)(ws + WS_Y); bf16* YP = (bf16*)(ws + WS_YP);
    float* SSQ0 = (float*)(ws + TB_SSQ0); float* SSQ1 = (float*)(ws + WS_SSQP1); float* SSQ2 = (float*)(ws + WS_SSQP2); float* VSTAT = (float*)(ws + WS_VSTP); float* DEC = (float*)(ws + TB_DEC);
    float* LFC = (float*)(ws + TB_LFC); float* BT = (float*)(ws + TB_BT); int* ROWTOK = (int*)(ws + TB_ROWTOK); float* ROWR = (float*)(ws + TB_ROWR); float* ROWW = (float*)(ws + TB_ROWW);
    int* TOKINFO = (int*)(ws + TB_TOKINFO); int* CNT = (int*)(ws + CT_CNT);
    float* X = args.out;
    const int gw = vcu * NWAVES + wave, NGW = G * NWAVES;
    LAS float* scr = (LAS float*)(lds + wave * 16384);
    const float* g0 = args.in[IN_E_NMIX]; const float* g1 = args.in[IN_E_NFFN]; const float* g2 = args.in[IN_O_NMIX]; const float* g3 = args.in[IN_O_NFFN];
    constexpr int I0 = 768, I1 = 256, I2 = 256, I3 = 512, I4 = 1408, I5 = 1408, I6 = 1408, I7 = 2048, I8 = 512, IE = 1792;
    constexpr int NSMALL = I0 + I1 + I2 + I3 + I4 + I5 + I6 + I7 + I8; static_assert(IE == MOE_IE, "");
    const int NA = (G == 256 ? MOE_A_ITEMS - MOE_Q_IN0 - MOE_Q_FFN1 : MOE_A_ITEMS); const int NITEMS = NSMALL + NA + MOE_QB0;
#ifndef MK_NSHADOW
#define MK_NSHADOW 9
#endif
#ifndef MK_SHADOW_W
#define MK_SHADOW_W 8
#endif
    constexpr int SHADOW_WAVES = MK_SHADOW_W * 256, NPRO = NSMALL + (MOE_A_ITEMS - MOE_Q_IN0 - MOE_Q_FFN1) + MOE_QB0 - MK_NSHADOW * SHADOW_WAVES;
    static_assert(NPRO >= I0 + I1 + I2 && MK_NSHADOW == 9 && (NPRO <= I0 + I1 + I2 + I3 + I4 + I5 || NPRO >= NSMALL), "shadow plan: W0IN and W0O stay in the prologue; the deferred list starts inside W0F13 (first use: phase 6, converted in shadows 0-1)");
    const bool SHADOWS_ON = MK_SHADOW && G == 256;
#define CONV_ITEM(it__, NB_) do { int r = (it__); \
        if (r < I0) { tr_job<MAP_PLAIN, NB_>(args.in[IN_E_WIN], 2576, 0, 1536, 1024, g0, W0IN, 0, scr, r, lane); break; } r -= I0; \
        if (r < I1) { tr_job<MAP_PLAIN, NB_>(args.in[IN_E_WIN], 2576, 1552, 512, 1024, g0, W0IN, 1792, scr, r, lane); break; } r -= I1; \
        if (r < I2) { tr_job<MAP_PLAIN, NB_>(args.in[IN_E_WIN], 2576, 2064, 512, 1024, g0, W0IN, 2304, scr, r, lane); break; } r -= I2; \
        if (r < I3) { tr_job<MAP_PLAIN, NB_>(args.in[IN_E_WO], 1024, 0, 1024, 1024, nullptr, W0O, 0, scr, r, lane); break; } r -= I3; \
        if (r < I4) { tr_job<MAP_GLU, NB_>(args.in[IN_E_W1], 2816, 0, 2816, 1024, g1, W0F13, 0, scr, r, lane); break; } r -= I4; \
        if (r < I5) { tr_job<MAP_GLU, NB_>(args.in[IN_E_W3], 2816, 0, 2816, 1024, g1, W0F13, 128, scr, r, lane); break; } r -= I5; \
        if (r < I6) { tr_job<MAP_PLAIN, NB_>(args.in[IN_E_W2], 1024, 0, 1024, 2816, nullptr, W0F2, 0, scr, r, lane); break; } r -= I6; \
        if (r < I7) { const int wh = r >> 9; tr_job<MAP_HEAD, NB_>(args.in[IN_O_WIN], 4112, 1024 * wh, 1024, 1024, g2, W1IN, 1024 * wh, scr, r & 511, lane); break; } r -= I7; \
        if (r < I8) { tr_job<MAP_PLAIN, NB_>(args.in[IN_O_WO], 1024, 0, 1024, 1024, nullptr, W1O, 0, scr, r, lane); break; } r -= I8; \
        if (r < NA) moe_item_a<NB_>(r, args.in[IN_O_W1], args.in[IN_O_W3], g3, WE13, scr, lane); else moe_item_b(r - NA, args.in[IN_O_W2], WE2, scr, lane); } while (0)

    if (IN(PH_PRO)) REPS(PH_PRO) {
        for (int it = gw; it < (SHADOWS_ON ? NPRO : NITEMS); it += NGW) { CONV_ITEM(it, 32); }
        const int gt = vcu * (NWAVES * 64) + tid, NGT = G * NWAVES * 64;
        for (int i = gt; i < 256 * 128; i += NGT) { const int c = i >> 7, k0 = (i & 127) * 8; float gu[16];
#pragma unroll
            for (int r = 0; r < 16; ++r) gu[r] = args.in[IN_E_GUP][r * 256 + c];
            float o[8];
#pragma unroll
            for (int kk = 0; kk < 8; ++kk) { const float* wr_ = args.in[IN_E_WIN] + (size_t)(k0 + kk) * 2576 + 1536; float a = 0.f;
#pragma unroll
                for (int r = 0; r < 16; ++r) a += wr_[r] * gu[r];
                o[kk] = a * g0[k0 + kk]; }
            v4u w; w.x = pk2(o[0], o[1]); w.y = pk2(o[2], o[3]); w.z = pk2(o[4], o[5]); w.w = pk2(o[6], o[7]);
            *(GAS v4u*)(W0IN + (size_t)(1536 + c) * 1024 + k0) = w; }
        for (int i = gt; i < 16 * 1024; i += NGT) { const int h = i >> 10, k = i & 1023; WFT[i] = (bf16)f2bf(g2[k] * args.in[IN_O_WIN][(size_t)k * 4112 + 4096 + h]); }
        for (int i = gt; i < 8 * 1024; i += NGT) { const int e = i >> 10, k = i & 1023; const float w = g3[k] * args.in[IN_O_ROUTER][k * 8 + e]; const unsigned hi = f2bf(w);
            GRH[e * 1024 + k] = (bf16)hi; GRH[(8 + e) * 1024 + k] = (bf16)f2bf(w - __uint_as_float(hi << 16)); }
        for (int i = gt; i < 4 * 128 * 128; i += NGT) { const int t = (i >> 7) & 127, s = i & 127; WST[i] = (bf16)f2bf(s <= t ? args.in[IN_E_WS][i] : 0.f); }
        for (int m = gw; m < M; m += NGW) { const GAS f32x4* xr = (const GAS f32x4*)(args.in[IN_X] + (size_t)m * D) + lane; f32x4 v[4]; float s = 0.f;
#pragma unroll
            for (int j = 0; j < 4; ++j) { v[j] = xr[64 * j]; s += (v[j].x * v[j].x + v[j].y * v[j].y) + (v[j].z * v[j].z + v[j].w * v[j].w); }
            s = wave_sum(s); if (lane == 0) SSQ0[m] = s;
            GAS unsigned long long* o8 = (GAS unsigned long long*)(XB + (size_t)m * D) + lane;
#pragma unroll
            for (int j = 0; j < 4; ++j) o8[64 * j] = (unsigned long long)pk2(v[j].x, v[j].y) | ((unsigned long long)pk2(v[j].z, v[j].w) << 32); }
    }
    SEAM(PH_PRO);
    if (IN(PH_IN0)) REPS(PH_IN0) {
        pg8::Gemm g{XB, W0IN, 1024, nullptr, FL(PH_IN0)}; pg8::StaticOrder S; S.init(M, 2816, G, bx, MK_WGM_IN0);
        pg8::EpiEvenIn E{Z0, LOGA, VSTAT, SSQ0, args.in[IN_E_GBIAS], FL(PH_IN0)};
        pg8::gemm_phase<pg8::EpiEvenIn, pg8::StaticOrder, MK_ALIGN>(lds, RSB, g, S, E);
        if (G == 256 && bx >= 192) {
            LAS float* scr = (LAS float*)(lds + wave * 16384); const int q0 = MOE_A_ITEMS - MOE_Q_IN0 - MOE_Q_FFN1 + ((bx - 192) * NWAVES + wave) * MOE_IDLE_ITEMS;
            for (int j = 0; j < MOE_IDLE_ITEMS; ++j) moe_item_a(q0 + j, args.in[IN_O_W1], args.in[IN_O_W3], args.in[IN_O_NFFN], WE13, scr, lane); }
    }
    SEAM(PH_IN0);
    if (IN(PH_MIXA)) REPS(PH_MIXA) {
        for (int u = vcu + (SHADOWS_ON ? 512 : 0); u < 1024; u += G) {
            if (u < 512) mx::gmlp_unit(lds, u >> 2, u & 3, Z0, VSTAT, args.in[IN_E_LNG], args.in[IN_E_LNB], WST, args.in[IN_E_BS], MIX, tid);
            else mx::gla_u_unit(lds, (u - 512) >> 2, u & 3, Z0, LOGA, UT, DEC, tid);
        }
    }
    SEAM(PH_MIXA);
    if (IN(PH_SCAN)) REPS(PH_SCAN) mx::gla_scan(UT, DEC, STT, vcu * (NWAVES * 64) + tid, G * NWAVES * 64);
    SEAM(PH_SCAN);
    if (IN(PH_GLAO)) REPS(PH_GLAO) { for (int u = vcu; u < 512; u += G) mx::gla_out_unit(lds, u >> 2, u & 3, Z0, LOGA, STT, args.in[IN_E_HG], MIX, tid); }
    SEAM(PH_GLAO);
    if (IN(PH_OUT0)) REPS(PH_OUT0) {
        pg8::Gemm g{MIX, W0O, 1024, nullptr, FL(PH_OUT0)}; pg8::StaticOrder S; S.init(M, 1024, G, bx);
        pg8::EpiResid E{args.in[IN_X], XB, SSQ1, FL(PH_OUT0)};
        pg8::gemm_phase<pg8::EpiResid, pg8::StaticOrder, MK_ALIGN1>(lds, RSB, g, S, E);
    }
    SEAM(PH_OUT0);
    if (IN(PH_FFN1)) REPS(PH_FFN1) {
        pg8::Gemm g{XB, W0F13, 1024, nullptr, FL(PH_FFN1)}; pg8::StaticOrder S; S.init(M, 5632, G, bx, MK_WGM_FFN1);
        pg8::EpiSwiglu<false> E{ACT0, 2816, SSQ1, nullptr, nullptr, FL(PH_FFN1)};
        pg8::gemm_phase<pg8::EpiSwiglu<false>, pg8::StaticOrder, MK_ALIGN>(lds, RSB, g, S, E);
        if (G == 256 && bx >= 128) {
            LAS float* scr = (LAS float*)(lds + wave * 16384); const int q0 = MOE_A_ITEMS - MOE_Q_FFN1 + ((bx - 128) * NWAVES + wave) * MOE_IDLE_ITEMS;
            for (int j = 0; j < MOE_IDLE_ITEMS; ++j) moe_item_a(q0 + j, args.in[IN_O_W1], args.in[IN_O_W3], args.in[IN_O_NFFN], WE13, scr, lane); }
    }
    SEAM(PH_FFN1);
    if (IN(PH_FFN2)) {
        pg8::Gemm g{ACT0, W0F2, 2816, nullptr, FL(PH_FFN2)}; pg8::StaticOrder S; S.init(M, 1024, G, bx);
        pg8::EpiResid E{nullptr, XB, SSQ2, FL(PH_FFN2)};
        pg8::gemm_phase<pg8::EpiResid, pg8::StaticOrder, MK_ALIGN1>(lds, RSB, g, S, E);
    }
    SEAM(PH_FFN2);
    if (IN(PH_IN1)) REPS(PH_IN1) {
        for (int blk = vcu; blk < 256; blk += G) mx::fgate_block(lds, blk, XB, WFT, SSQ2, args.in[IN_O_FB], LFC, BT, tid);
        pg8::Gemm g{XB, W1IN, 1024, nullptr, FL(PH_IN1)}; pg8::StaticOrder S; S.init(M, 4096, G, bx, MK_WGM_IN1);
        pg8::EpiOddIn E{QB, (size_t)WS_TSTRIDE / 2, SSQ2, args.in[IN_O_QG], args.in[IN_O_KG], attn_body::C2, FL(PH_IN1)};
        pg8::gemm_phase<pg8::EpiOddIn, pg8::StaticOrder, MK_ALIGN>(lds, RSB, g, S, E);
    }
    SEAM(PH_IN1);
    if (IN(PH_ATTN)) REPS(PH_ATTN) {
        static_assert(attn_body::ATTN_LDS_BYTES <= ATT_CB_OFF && ATT_OFF_OFF + 256 <= RING_BYTES, "attention LDS map");
        LAS float* CB = (LAS float*)(lds + ATT_CB_OFF); LAS float* OFF = (LAS float*)(lds + ATT_OFF_OFF);
        if (G == 256) {
            mx::attn_bias(CB, OFF, vcu >> 2, LFC, BT, tid);
            const attn_body::AttnTensors AT{(const attn_body::bf16*)QB, (const attn_body::bf16*)(QB + WS_TSTRIDE / 2), (const attn_body::bf16*)(QB + WS_TSTRIDE), (attn_body::bf16*)QB,
                                            (const attn_body::bf16*)(QB + 3 * (WS_TSTRIDE / 2))};
            const attn_body::StaticOrder S(vcu);
            float gq = fabsf(args.in[IN_O_QG][lane]), gk = fabsf(args.in[IN_O_KG][lane]);
#pragma unroll
            for (int o = 1; o < 64; o <<= 1) { gq = fmaxf(gq, __shfl_xor(gq, o)); gk = fmaxf(gk, __shfl_xor(gk, o)); }
            const float Bq = 1.02f * 64.f * attn_body::C2 * gq * gk;
#ifndef MK_ATTN_SKIP
#define MK_ATTN_SKIP 40.f
#endif
            attn_body::attn_phase<attn_body::StaticOrder>((char*)lds_raw, (attn_body::lds_fptr)CB, -(MK_ATTN_SKIP) - 2.f * Bq, AT, S);
        }
    }
    SEAM(PH_ATTN);
    if (IN(PH_OUT1)) {
        pg8::Gemm g{QB, W1O, 1024, nullptr, FL(PH_OUT1)}; pg8::StaticOrder S; S.init(M, 1024, G, bx);
        pg8::EpiResid E{nullptr, XB, SSQ1, FL(PH_OUT1)};
        pg8::gemm_phase<pg8::EpiResid, pg8::StaticOrder, MK_ALIGN1>(lds, RSB, g, S, E);
    }
    SEAM(PH_OUT1);
    if (IN(PH_ROUTE)) {
        typedef float f32x4r __attribute__((ext_vector_type(4)));
        LAS float* LG = (LAS float*)lds;
        LAS int* TI = (LAS int*)(lds + 32768);
        LAS float* TF = (LAS float*)(lds + 32768);
        for (int blk = vcu; blk < M / 64; blk += G) {
            if (tid < 8) TI[448 + tid] = 0;
            { const int tg = wave & 3, kh = wave >> 2; f32x4r acc = {0.f, 0.f, 0.f, 0.f};
                const bf16* ap = XB + (size_t)(64 * blk + 16 * tg + (lane & 15)) * 1024 + 512 * kh + 8 * (lane >> 4); const bf16* bp = GRH + (size_t)(lane & 15) * 1024 + 512 * kh + 8 * (lane >> 4);
                bf16x8 av[16], bv[16];
#pragma unroll
                for (int ks = 0; ks < 16; ++ks) { av[ks] = *(const bf16x8*)(ap + 32 * ks); bv[ks] = *(const bf16x8*)(bp + 32 * ks); }
#pragma unroll
                for (int ks = 0; ks < 16; ++ks) acc = __builtin_amdgcn_mfma_f32_16x16x32_bf16(av[ks], bv[ks], acc, 0, 0, 0);
#pragma unroll
                for (int r = 0; r < 4; ++r) LG[kh * 1024 + (16 * tg + 4 * (lane >> 4) + r) * 16 + (lane & 15)] = acc[r]; }
            __syncthreads();
            if (tid < 64) { const int slot = tid, tok = 64 * blk + slot; float lg[8];
#pragma unroll
                for (int e = 0; e < 8; ++e) lg[e] = (LG[slot * 16 + e] + LG[1024 + slot * 16 + e]) + (LG[slot * 16 + 8 + e] + LG[1024 + slot * 16 + 8 + e]);
                const float r = pg8::row_rstd(SSQ1, tok, 16);
                int i0 = 0; float v0 = lg[0];
#pragma unroll
                for (int e = 1; e < 8; ++e) if (lg[e] > v0) { v0 = lg[e]; i0 = e; }
                int i1 = -1; float v1 = -INFINITY;
#pragma unroll
                for (int e = 0; e < 8; ++e) if (e != i0 && lg[e] > v1) { v1 = lg[e]; i1 = e; }
                const float e1 = expf((v1 - v0) * r), w0 = 1.f / (1.f + e1), w1 = e1 / (1.f + e1);
                TI[slot] = i0; TI[64 + slot] = i1;
                TI[128 + slot] = (int)__hip_atomic_fetch_add((LAS unsigned*)TI + 448 + i0, 1u, __ATOMIC_RELAXED, __HIP_MEMORY_SCOPE_WORKGROUP);
                TI[192 + slot] = (int)__hip_atomic_fetch_add((LAS unsigned*)TI + 448 + i1, 1u, __ATOMIC_RELAXED, __HIP_MEMORY_SCOPE_WORKGROUP);
                TF[256 + slot] = w0; TF[320 + slot] = w1; TF[384 + slot] = r; }
            __syncthreads();
            if (tid < 8) TI[456 + tid] = (int)__hip_atomic_fetch_add((unsigned*)CNT + 64 * tid, (unsigned)TI[448 + tid], RLX_AGENT);
            __syncthreads();
            if (tid < 64) { const int tok = 64 * blk + tid, i0 = TI[tid], i1 = TI[64 + tid], p0 = TI[456 + i0] + TI[128 + tid], p1 = TI[456 + i1] + TI[192 + tid]; const float r = TF[384 + tid];
                ROWTOK[i0 * M + p0] = tok; ROWR[i0 * M + p0] = r; ROWW[i0 * M + p0] = TF[256 + tid];
                ROWTOK[i1 * M + p1] = tok; ROWR[i1 * M + p1] = r; ROWW[i1 * M + p1] = TF[320 + tid];
                *(int4*)(TOKINFO + 4 * (size_t)tok) = make_int4(i0, p0, i1, p1); }
            __syncthreads();
        }
    }
    SEAM(PH_ROUTE);
    if (IN(PH_MOE1) || IN(PH_MOE2) || IN(PH_FINAL)) {
        if (tid == 0) { int off = 0;
#pragma unroll
            for (int e = 0; e < 8; ++e) { const int c = (int)__hip_atomic_load((unsigned*)CNT + 64 * e, RLX_AGENT); TAB[e] = off; TAB[16 + e] = c; off += (c + 255) >> 8; }
            TAB[8] = off; }
        __syncthreads();
    }
    if (IN(PH_MOE1)) REPS(PH_MOE1) {
        const int nun = 28 * TAB[8], R = (nun + G - 1) / G, Ge = R > 0 ? (nun + R - 1) / R : G;
        pg8::Gemm g{XB, WE13, 1024, ROWTOK, FL(PH_MOE1)}; pg8::MoeOrder<true> S; S.init(TAB, 28, Ge, bx, MK_WGM_MOE1);
        pg8::EpiSwiglu<true> E{ACTE, 3584, nullptr, ROWR, ROWW, FL(PH_MOE1)};
        if (bx < Ge) pg8::gemm_phase<pg8::EpiSwiglu<true>, pg8::MoeOrder<true>, MK_ALIGN>(lds, RSB, g, S, E);
        moe_queue_drain_b((unsigned*)(ws + CT_QCTR), args.in[IN_O_W2], WE2, (LAS float*)(lds + wave * 16384), lane);
    }
    SEAM(PH_MOE1);
    if (IN(PH_MOE2)) REPS(PH_MOE2) {
        pg8::Gemm g{ACTE, WE2, 3584, nullptr, FL(PH_MOE2)}; pg8::Moe2Order S; S.init(TAB, G, bx);
        const int nsp2 = pg8::Moe2Order::split_tiles(S.T); pg8::EpiBf16 E{YB, 1024, args.flags, YP, (size_t)nsp2 * 256 * 1024, S.T - nsp2};
        pg8::gemm_phase<pg8::EpiBf16, pg8::Moe2Order, MK_ALIGN>(lds, RSB, g, S, E);
    }
    SEAM(PH_MOE2);
    if (IN(PH_FINAL)) {
        for (int tok = gw; tok < M; tok += NGW) {
            const int4 ti = *(const int4*)(TOKINFO + 4 * (size_t)tok);
            const size_t r0 = (size_t)TAB[ti.x] * 256 + ti.y, r1 = (size_t)TAB[ti.z] * 256 + ti.w;
            const int nsp = pg8::Moe2Order::split_tiles(TAB[8]), nsl = pg8::Moe2Order::slices(nsp); const size_t rsplit = (size_t)(TAB[8] - nsp) * 256, pstr = (size_t)nsp * 256 * 1024;
            GAS f32x4* xr = (GAS f32x4*)(X + (size_t)tok * D) + lane; const GAS v2u* xbr = (const GAS v2u*)(XB + (size_t)tok * D) + lane; const GAS v2u* y0 = (const GAS v2u*)(YB + r0 * D) + lane; const GAS v2u* y1 = (const GAS v2u*)(YB + r1 * D) + lane;
            f32x4 v[4]; float ss = 0.f;
#pragma unroll
            for (int j = 0; j < 4; ++j) { const v2u xw = xbr[64 * j]; v[j] = (f32x4){__uint_as_float(xw.x << 16), __uint_as_float(xw.x & 0xffff0000u), __uint_as_float(xw.y << 16), __uint_as_float(xw.y & 0xffff0000u)};
                v2u a = {0u, 0u}, b = {0u, 0u}; if (r0 < rsplit) a = y0[64 * j]; if (r1 < rsplit) b = y1[64 * j];
                v[j].x += __uint_as_float(a.x << 16) + __uint_as_float(b.x << 16); v[j].y += __uint_as_float(a.x & 0xffff0000u) + __uint_as_float(b.x & 0xffff0000u);
                v[j].z += __uint_as_float(a.y << 16) + __uint_as_float(b.y << 16); v[j].w += __uint_as_float(a.y & 0xffff0000u) + __uint_as_float(b.y & 0xffff0000u);
                }
            if (r0 >= rsplit || r1 >= rsplit) {
                for (int k = 0; k < nsl; ++k) {
#pragma unroll
                    for (int j = 0; j < 4; ++j) { v2u a = {0u, 0u}, b = {0u, 0u};
                        if (r0 >= rsplit) a = ((const GAS v2u*)(YP + (size_t)k * pstr + (r0 - rsplit) * D) + lane)[64 * j];
                        if (r1 >= rsplit) b = ((const GAS v2u*)(YP + (size_t)k * pstr + (r1 - rsplit) * D) + lane)[64 * j];
                        v[j].x += __uint_as_float(a.x << 16) + __uint_as_float(b.x << 16); v[j].y += __uint_as_float(a.x & 0xffff0000u) + __uint_as_float(b.x & 0xffff0000u);
                        v[j].z += __uint_as_float(a.y << 16) + __uint_as_float(b.y << 16); v[j].w += __uint_as_float(a.y & 0xffff0000u) + __uint_as_float(b.y & 0xffff0000u); } } }
#pragma unroll
            for (int j = 0; j < 4; ++j) ss += (v[j].x * v[j].x + v[j].y * v[j].y) + (v[j].z * v[j].z + v[j].w * v[j].w);
            ss = wave_sum(ss); const float r = 1.0f / sqrtf(ss * (1.f / 1024.f) + 1e-6f);
#pragma unroll
            for (int j = 0; j < 4; ++j) { const f32x4 gf = *((const GAS f32x4*)args.in[IN_FINAL] + lane + 64 * j); xr[64 * j] = v[j] * r * gf; }
        }
    }
#undef IN
#undef SEAM
}
#ifndef MK_PER_PHASE
#define MK_PER_PHASE 0
#endif
#ifndef MK_PH_END
#define MK_PH_END N_PHASES
#endif
static int mk_setup() {
    static int grid = 0;
    if (grid == 0) {
        int dev = 0, cus = 0, per_cu = 0;
        if (hipGetDevice(&dev) != hipSuccess || hipDeviceGetAttribute(&cus, hipDeviceAttributeMultiprocessorCount, dev) != hipSuccess) { fprintf(stderr, "kernel_launch: device query failed\n"); grid = -1; return grid; }
        if (hipFuncSetAttribute((const void*)mk_fwd, hipFuncAttributeMaxDynamicSharedMemorySize, LDS_BYTES) != hipSuccess) { fprintf(stderr, "kernel_launch: hipFuncSetAttribute failed\n"); grid = -1; return grid; }
        if (hipOccupancyMaxActiveBlocksPerMultiprocessor(&per_cu, (const void*)mk_fwd, NWAVES * 64, LDS_BYTES) != hipSuccess || per_cu < 1) { fprintf(stderr, "kernel_launch: occupancy query says %d blocks/CU\n", per_cu); }
        (void)hipGetLastError();
        grid = cus;
        if (grid != 256) fprintf(stderr, "kernel_launch: %d CUs; this kernel is built for 256\n", grid);
    }
    return grid;
}
static void mk_run(void* const* d_in, float* out, unsigned char* ws, hipStream_t stream, int ph_end, int flags = 0) {
    const int grid = mk_setup(); if (grid <= 0) return;
    (void)hipMemsetAsync(ws + WS_CTL, 0, CTL_ZERO_BYTES, stream);
    Args a{};
    for (int i = 0; i < N_IN; ++i) a.in[i] = (const float*)d_in[i];
    a.out = out; a.ws = ws; a.flags = flags;
#if MK_PER_PHASE
    for (int p = 0; p < ph_end; ++p) { a.ph_lo = p; a.ph_hi = p + 1; hipLaunchKernelGGL(mk_fwd, dim3(grid), dim3(NWAVES * 64), LDS_BYTES, stream, a); }
#else
    a.ph_lo = 0; a.ph_hi = ph_end; hipLaunchKernelGGL(mk_fwd, dim3(grid), dim3(NWAVES * 64), LDS_BYTES, stream, a);
#endif
}
#ifndef MK_DEBUG
extern "C" void kernel_launch(void* const* d_in, const int* in_sizes, int n_in, void* d_out, int out_size, void* d_ws, size_t ws_size, hipStream_t stream) {
    if (n_in != N_IN || out_size != M * D || ws_size < WS_END) { fprintf(stderr, "kernel_launch: unexpected shapes n_in %d out %d ws %zu\n", n_in, out_size, ws_size); return; }
#ifdef MK_PREFIX
#ifndef MK_PREFIX_FLAGS
#define MK_PREFIX_FLAGS 0
#endif
    mk_run(d_in, (float*)d_out, (unsigned char*)d_ws, stream, MK_PREFIX + 1, MK_PREFIX_FLAGS);
#endif
    mk_run(d_in, (float*)d_out, (unsigned char*)d_ws, stream, N_PHASES);
}
#endif
```

```cpp
#include <hip/hip_runtime.h>
#include <cstdio>
#include <cstdint>
#include <cmath>
#define GAS __attribute__((address_space(1)))
#define LAS __attribute__((address_space(3)))
typedef unsigned short bf16;
typedef unsigned v4u __attribute__((ext_vector_type(4)));
typedef float f32x4 __attribute__((ext_vector_type(4)));
typedef short bf16x8 __attribute__((ext_vector_type(8)));
typedef GAS unsigned gu32;
typedef GAS unsigned long long gu64;
#define RLX_AGENT __ATOMIC_RELAXED, __HIP_MEMORY_SCOPE_AGENT
#define LDS_WAIT() asm volatile("s_waitcnt lgkmcnt(0)" ::: "memory")
#define VM_WAIT() asm volatile("s_waitcnt vmcnt(0)" ::: "memory")
__device__ __forceinline__ unsigned long long rt() { return __builtin_amdgcn_s_memrealtime(); }
__device__ __forceinline__ unsigned f2bf(float f) { unsigned u = __builtin_bit_cast(unsigned, f); return (u + 0x7fffu + ((u >> 16) & 1u)) >> 16; }
__device__ __forceinline__ unsigned pk2(float lo, float hi) { return f2bf(lo) | (f2bf(hi) << 16); }

#define XB_TMO      128
#define XB_XCNT(j)  (256  + 64 * (j))
#define XB_XSUB(j)  (1280 + 64 * (j))
#define XB_XGEN(j)  (2304 + 64 * (j))
#define XB_TOP      3328
#define XB_TOPGEN   3392
#define XCD_BAR_WORDS 3456
#define XB_SPIN_CAP (1u << 18)

__device__ __forceinline__ unsigned xb_ld(unsigned* p)              { return __hip_atomic_load(p, __ATOMIC_RELAXED, __HIP_MEMORY_SCOPE_AGENT); }
__device__ __forceinline__ unsigned xb_add(unsigned* p, unsigned v) { return __hip_atomic_fetch_add(p, v, __ATOMIC_RELAXED, __HIP_MEMORY_SCOPE_AGENT); }
__device__ __forceinline__ unsigned xb_xcc_id() { return (unsigned)__builtin_amdgcn_s_getreg((3 << 11) | 20) & 0xFu; }
#define XB_SPIN(cond, bar) do { unsigned _sp = 0; while (cond) { __builtin_amdgcn_s_sleep(1); \
    if ((++_sp & 255u) == 0u) { if (xb_ld(&(bar)[XB_TMO])) break; if (_sp > XB_SPIN_CAP) { atomicAdd(&(bar)[XB_TMO], 1u); break; } } } } while (0)

struct XcdBarrier {
    unsigned* bar; unsigned x;
    volatile LAS unsigned* st;
};

__device__ __forceinline__ XcdBarrier xcd_barrier_post(unsigned* bar, volatile LAS unsigned* st) {
    XcdBarrier b; b.bar = bar; b.x = xb_xcc_id(); b.st = st;
    if (threadIdx.x == 0) (void)xb_add(&bar[XB_XCNT(b.x)], 1u);
    return b;
}
__device__ __forceinline__ void xcd_barrier_complete(unsigned* bar, unsigned x, unsigned& nloc, unsigned& nx) {
    const unsigned G = gridDim.x * gridDim.y * gridDim.z;
    unsigned sum, cnt, mine, sp = 0u;
    for (;;) {
        sum = 0u; cnt = 0u; mine = 0u;
#pragma unroll
        for (unsigned j = 0; j < 16; ++j) { const unsigned c = xb_ld(&bar[XB_XCNT(j)]); sum += c; cnt += (c > 0u) ? 1u : 0u; mine = (j == x) ? c : mine; }
        if (sum == G) break;
        __builtin_amdgcn_s_sleep(1);
        if ((++sp & 255u) == 0u) { if (xb_ld(&bar[XB_TMO])) break; if (sp > XB_SPIN_CAP) { atomicAdd(&bar[XB_TMO], 1u); break; } }
    }
    nloc = mine > 0u ? mine : 1u; nx = cnt > 0u ? cnt : 1u;
}

__device__ __forceinline__ void xcd_barrier(const XcdBarrier& b) {
    asm volatile("s_waitcnt vmcnt(0)" ::: "memory");
    __syncthreads();
    if (threadIdx.x == 0) {
        unsigned* bar = b.bar;
        __builtin_amdgcn_s_waitcnt(0);
        unsigned nloc = b.st[0], nx = b.st[1];
        if (nloc == 0u) { xcd_barrier_complete(bar, b.x, nloc, nx); b.st[0] = nloc; b.st[1] = nx; }
        const unsigned old = xb_add(&bar[XB_XSUB(b.x)], 1u);
        const unsigned gen = old / nloc;
        if (old + 1u == (gen + 1u) * nloc) {
            __builtin_amdgcn_fence(__ATOMIC_RELEASE, "agent");
            asm volatile("s_waitcnt vmcnt(0)" ::: "memory");
            const unsigned og = xb_add(&bar[XB_TOP], 1u);
            const unsigned tg = og / nx;
            if (og + 1u == (tg + 1u) * nx) xb_add(&bar[XB_TOPGEN], 1u);
            else XB_SPIN(xb_ld(&bar[XB_TOPGEN]) == tg, bar);
            __builtin_amdgcn_fence(__ATOMIC_ACQUIRE, "agent");
            xb_add(&bar[XB_XGEN(b.x)], 1u);
            asm volatile("s_waitcnt vmcnt(0)" ::: "memory");
        } else {
            XB_SPIN(xb_ld(&bar[XB_XGEN(b.x)]) == gen, bar);
            __builtin_amdgcn_fence(__ATOMIC_ACQUIRE, "agent");
            asm volatile("s_waitcnt vmcnt(0)" ::: "memory");
        }
    }
    __syncthreads();
}
#ifndef MK_WGM
#define MK_WGM 4
#endif
namespace pg8 {
#define PG8_LAS __attribute__((address_space(3)))
typedef unsigned short bf16_t;
typedef short bf16x8 __attribute__((ext_vector_type(8)));
typedef float f32x4 __attribute__((ext_vector_type(4)));
typedef float f32x2 __attribute__((ext_vector_type(2)));
typedef unsigned u32x4 __attribute__((ext_vector_type(4)));
typedef unsigned u32x2 __attribute__((ext_vector_type(2)));
constexpr int BM = 256, BK = 64, HALF = 128, HTB = HALF * BK * 2  , STAGE_BYTES = 8 * HTB, NXCD = 8, WGM = MK_WGM;
constexpr float L2E = 1.4426950408889634f, LN2 = 0.6931471805599453f;

__host__ __device__ __forceinline__ int lds_byte(int r, int c) { const int st = (r >> 4) * 2 + (c >> 5), rr = r & 15, cc = c & 31, ob = rr * 64 + cc * 2; return st * 1024 + (ob ^ (((ob >> 9) & 1) << 5)); }
__host__ __device__ __forceinline__ void stage_rc(int b, int& R, int& C) { const int st = b / 1024, sb = b % 1024, swz = sb ^ (((sb >> 9) & 1) << 5); R = (st >> 1) * 16 + swz / 64; C = (st & 1) * 32 + (swz % 64) / 2; }
__host__ __device__ __forceinline__ int perm32(int rho) { const int n = rho >> 4, i = rho & 15; return 8 * (i >> 2) + 4 * n + (i & 3); }

struct Unit { int pm, pn, pe, ga, nv, nt, ks; };
__device__ __forceinline__ int unit_k0(const Unit& u) { return u.ks < 0 ? 0 : u.ks * u.nt * BK; }
struct Gemm { const bf16_t* A; const bf16_t* Bt; int K; const int* rowtok; int flags; };

struct StaticOrder {
    static constexpr bool GATHER = false;
    int nM, nN, nwg, G, c, wgm;
    __device__ __forceinline__ void init(int M, int N, int G_, int c_, int wgm_ = WGM) { nM = M / BM; nN = N / BM; nwg = nM * nN; G = G_; c = c_; wgm = wgm_; }
    __device__ __forceinline__ bool next(int i, Unit& u) const {
        const long L = (long)i * G + c; if (L >= nwg) return false;
        int wgid = (int)L; { const int q = nwg / NXCD, r = nwg % NXCD, xcd = wgid % NXCD, off = wgid / NXCD; wgid = (xcd < r ? xcd * (q + 1) : r * (q + 1) + (xcd - r) * q) + off; }
        const int nig = wgm * nN, gid = wgid / nig, fm = gid * wgm, gsz = (nM - fm) < wgm ? (nM - fm) : wgm;
        u.pm = fm + ((wgid % nig) % gsz); u.pn = (wgid % nig) / gsz; u.pe = u.pn; u.ga = 0; u.nv = BM; u.nt = 0; u.ks = -1; return true;
    }
};
template <bool GATHER_>
struct MoeOrder {
    static constexpr bool GATHER = GATHER_;
    const PG8_LAS int* tab; int nN, T, nwg, G, c, wgm;
    __device__ __forceinline__ void init(const PG8_LAS int* tab_, int nN_, int G_, int c_, int wgm_ = WGM) { tab = tab_; nN = nN_; T = tab_[8]; nwg = T * nN_; G = G_; c = c_; wgm = wgm_; }
    __device__ __forceinline__ bool next(int i, Unit& u) const {
        const long L = (long)i * G + c; if (L >= nwg) return false;
        int wgid = (int)L; { const int q = nwg / NXCD, r = nwg % NXCD, xcd = wgid % NXCD, off = wgid / NXCD; wgid = (xcd < r ? xcd * (q + 1) : r * (q + 1) + (xcd - r) * q) + off; }
        const int nig = wgm * nN, gid = wgid / nig, fm = gid * wgm, gsz = (T - fm) < wgm ? (T - fm) : wgm;
        const int ct = fm + ((wgid % nig) % gsz), pn = (wgid % nig) / gsz;
        int e = 0;
#pragma unroll
        for (int j = 1; j < 8; ++j) e += (ct >= tab[j]) ? 1 : 0;
        const int lt = ct - tab[e], rem = tab[16 + e] - lt * BM;
        u.pm = ct; u.pn = e * nN + pn; u.pe = pn; u.ga = e * 16384 + lt * BM; u.nv = rem < BM ? rem : BM; u.nt = 0; u.ks = -1; return true;
    }
};
struct Moe2Order {
    static constexpr bool GATHER = false;
    const PG8_LAS int* tab; int T, G, c;
    __device__ __forceinline__ static int split_tiles(int T) { return T > 128 ? T - 128 : 0; }
    __device__ __forceinline__ static int slices(int nsplit) { return 4 * nsplit <= 18 ? 14 : 7; }
    __device__ __forceinline__ void init(const PG8_LAS int* tab_, int G_, int c_) { tab = tab_; T = tab_[8]; G = G_; c = c_; }
    __device__ __forceinline__ bool next(int i, Unit& u) const {
        const int nsplit = split_tiles(T), s = slices(nsplit), nnorm = (T - nsplit) * 4, total = nnorm + nsplit * 4 * s;
        const long L = (long)i * G + c; if (L >= total) return false;
        int ct, pn;
        if (L < nnorm) { int wgid = (int)L; { const int q = nnorm / NXCD, r = nnorm % NXCD, xcd = wgid % NXCD, off = wgid / NXCD; wgid = (xcd < r ? xcd * (q + 1) : r * (q + 1) + (xcd - r) * q) + off; }
            const int Tn = T - nsplit, nig = WGM * 4, gid = wgid / nig, fm = gid * WGM, gsz = (Tn - fm) < WGM ? (Tn - fm) : WGM;
            ct = fm + ((wgid % nig) % gsz); pn = (wgid % nig) / gsz; u.nt = 0; u.ks = -1; }
        else { const int j = (int)L - nnorm, sl = j % s, un = j / s; ct = T - nsplit + (un >> 2); pn = un & 3; u.nt = 56 / s; u.ks = sl; }
        int e = 0;
#pragma unroll
        for (int j = 1; j < 8; ++j) e += (ct >= tab[j]) ? 1 : 0;
        u.pm = ct; u.pn = e * 4 + pn; u.pe = pn; u.ga = 0; u.nv = BM; return true;
    }
};

__device__ __forceinline__ unsigned cvt_pk_bf16(float lo, float hi) { unsigned r; asm volatile("v_cvt_pk_bf16_f32 %0, %1, %2" : "=v"(r) : "v"(lo), "v"(hi)); return r; }
__device__ __forceinline__ float bf_lo(unsigned w) { return __uint_as_float(w << 16); }
__device__ __forceinline__ float bf_hi(unsigned w) { return __uint_as_float(w & 0xffff0000u); }
__device__ __forceinline__ float fexp2(float x) { return __builtin_amdgcn_exp2f(x); }
__device__ __forceinline__ float frcp(float x) { return __builtin_amdgcn_rcpf(x); }
__device__ __forceinline__ float sigmoid_f(float x) { return frcp(1.f + fexp2(-L2E * x)); }
__device__ __forceinline__ float silu_f(float x) { return x * sigmoid_f(x); }
__device__ __forceinline__ float gelu_tanh_f(float x) { const float y = 0.7978845608028654f * (x + 0.044715f * x * x * x); return x * frcp(1.f + fexp2(-2.f * L2E * y)); }
__device__ __forceinline__ float log_sigmoid_f(float x) { return fminf(x, 0.f) - LN2 * __builtin_amdgcn_logf(1.f + fexp2(-L2E * fabsf(x))); }
__device__ __forceinline__ u32x4 pack8(const f32x4 a, const f32x4 b) { u32x4 w; w.x = cvt_pk_bf16(a[0], a[1]); w.y = cvt_pk_bf16(a[2], a[3]); w.z = cvt_pk_bf16(b[0], b[1]); w.w = cvt_pk_bf16(b[2], b[3]); return w; }
#ifndef PG8_NT
#define PG8_NT 0
#endif
__device__ __forceinline__ void st16(void* p, u32x4 v, bool ok = true) { if (!ok) { asm volatile("" :: "v"(v)); return; } if (PG8_NT) __builtin_nontemporal_store(v, (u32x4*)p); else *(u32x4*)p = v; }
__device__ __forceinline__ void st16f(void* p, f32x4 v, bool ok = true) { if (!ok) { asm volatile("" :: "v"(v)); return; } if (PG8_NT) __builtin_nontemporal_store(v, (f32x4*)p); else *(f32x4*)p = v; }
__device__ __forceinline__ float row_rstd(const float* p, int row, int ns) { float s;
    if (ns == 1) s = p[row]; else { const f32x4* q = (const f32x4*)(p + (size_t)row * 16); const f32x4 a = q[0], b = q[1], c = q[2], d = q[3];
        s = (((a[0] + a[1]) + (a[2] + a[3])) + ((b[0] + b[1]) + (b[2] + b[3]))) + (((c[0] + c[1]) + (c[2] + c[3])) + ((d[0] + d[1]) + (d[2] + d[3]))); }
    return __builtin_amdgcn_rsqf(s * (1.f / 1024.f) + 1e-6f); }

struct EpiEvenIn {
    static constexpr bool PERM = true;
    bf16_t* Z; float* loga; float* vstp; const float* ssq; const float* gate_bias; int fl;
    __device__ __forceinline__ void rload(const Unit& u, int tid, float& a, float& b) const { a = (tid < BM) ? row_rstd(ssq, u.pm * BM + tid, 1) : 0.f; b = 0.f; }
    __device__ __forceinline__ void rstore(PG8_LAS float* rs, int tid, float a, float) const { if (tid < BM) rs[tid] = a; }
    __device__ __forceinline__ void operator()(const f32x4 (&acc)[2][2][4][2], const Unit& u, int wr, int wc, int fr, int fq, const PG8_LAS float* rs) const {
        const int pn = u.pe, row0 = u.pm * BM + wr * 64 + fr, cl = wc * 32 + 8 * fq;
        if (pn == 6) {
            f32x4 gb[2][2];
#pragma unroll
            for (int bj = 0; bj < 2; ++bj)
#pragma unroll
                for (int n = 0; n < 2; ++n) gb[bj][n] = *(const f32x4*)(gate_bias + bj * HALF + cl + 4 * n);
#pragma unroll
            for (int ai = 0; ai < 2; ++ai)
#pragma unroll
                for (int m = 0; m < 4; ++m) { const int row = row0 + ai * HALF + m * 16; const float r = rs[wr * 64 + fr + ai * HALF + m * 16];
#pragma unroll
                    for (int bj = 0; bj < 2; ++bj)
#pragma unroll
                        for (int n = 0; n < 2; ++n) { f32x4 v = acc[ai][bj][m][n] * r + gb[bj][n];
#pragma unroll
                            for (int e = 0; e < 4; ++e) v[e] = log_sigmoid_f(v[e]) * (1.f / 16.f);
                            st16f(loga + (size_t)row * 256 + bj * HALF + cl + 4 * n, v, !(fl & 2)); } }
            return;
        }
        const int zc = (pn < 6 ? pn : pn - 1) * BM + cl;
        const int ty = pn < 4 ? 1 : (pn == 4 ? 2 : (pn >= 9 ? 3 : 0));
        const bool st = (pn == 2 || pn == 3);
#pragma unroll
        for (int ai = 0; ai < 2; ++ai)
#pragma unroll
            for (int m = 0; m < 4; ++m) { const int row = row0 + ai * HALF + m * 16; const float r = rs[wr * 64 + fr + ai * HALF + m * 16];
                float s1 = 0.f, s2 = 0.f;
#pragma unroll
                for (int bj = 0; bj < 2; ++bj) { f32x4 v0 = acc[ai][bj][m][0] * r, v1 = acc[ai][bj][m][1] * r;
                    if (ty == 1) {
#pragma unroll
                        for (int e = 0; e < 4; ++e) { v0[e] = gelu_tanh_f(v0[e]); v1[e] = gelu_tanh_f(v1[e]); } }
                    else if (ty == 2) { v0 = v0 * 0.125f; v1 = v1 * 0.125f; }
                    else if (ty == 3) {
#pragma unroll
                        for (int e = 0; e < 4; ++e) { v0[e] = silu_f(v0[e]); v1[e] = silu_f(v1[e]); } }
                    if (st) {
#pragma unroll
                        for (int e = 0; e < 4; ++e) { s1 += v0[e] + v1[e]; s2 += v0[e] * v0[e] + v1[e] * v1[e]; } }
                    st16(Z + (size_t)row * 2560 + zc + bj * HALF, pack8(v0, v1), !(fl & 2)); }
                if (st) { s1 += __shfl_xor(s1, 16); s1 += __shfl_xor(s1, 32); s2 += __shfl_xor(s2, 16); s2 += __shfl_xor(s2, 32);
                    if (fq == 0) { const int j = 4 * (pn - 2) + wc; vstp[(size_t)row * 16 + j] = s1; vstp[(size_t)row * 16 + 8 + j] = s2; } } }
    }
};
struct EpiResid {
    static constexpr bool PERM = true;
    const float* xin; bf16_t* xb; float* ssqp; int fl;
    __device__ __forceinline__ void rload(const Unit&, int, float& a, float& b) const { a = 0.f; b = 0.f; }
    __device__ __forceinline__ void rstore(PG8_LAS float*, int, float, float) const {}
    __device__ __forceinline__ void operator()(const f32x4 (&acc)[2][2][4][2], const Unit& u, int wr, int wc, int fr, int fq, const PG8_LAS float*) const {
        const int row0 = u.pm * BM + wr * 64 + fr, c0 = u.pe * BM + wc * 32 + 8 * fq;
#pragma unroll
        for (int ai = 0; ai < 2; ++ai)
#pragma unroll
            for (int m = 0; m < 4; ++m) { const int row = row0 + ai * HALF + m * 16; const size_t off = (size_t)row * 1024 + c0; float s = 0.f;
#pragma unroll
                for (int bj = 0; bj < 2; ++bj) { f32x4 v0, v1;
                    if (xin) { v0 = *(const f32x4*)(xin + off + bj * HALF); v1 = *(const f32x4*)(xin + off + bj * HALF + 4); }
                    else { const u32x4 o = *(const u32x4*)(xb + off + bj * HALF); v0 = (f32x4){bf_lo(o.x), bf_hi(o.x), bf_lo(o.y), bf_hi(o.y)}; v1 = (f32x4){bf_lo(o.z), bf_hi(o.z), bf_lo(o.w), bf_hi(o.w)}; }
                    v0 = v0 + acc[ai][bj][m][0]; v1 = v1 + acc[ai][bj][m][1];
                    st16(xb + off + bj * HALF, pack8(v0, v1), !(fl & 2));
#pragma unroll
                    for (int e = 0; e < 4; ++e) s += v0[e] * v0[e] + v1[e] * v1[e]; }
                if (ssqp) { s += __shfl_xor(s, 16); s += __shfl_xor(s, 32); if (fq == 0) ssqp[(size_t)row * 16 + u.pe * 4 + wc] = s; }
                if (m & 1) asm volatile("" ::: "memory"); }
    }
};
template <bool MOE>
struct EpiSwiglu {
    static constexpr bool PERM = true;
    bf16_t* O; int ldo; const float* ssq; const float* rowr; const float* roww; int fl;
    __device__ __forceinline__ void rload(const Unit& u, int tid, float& a, float& b) const { a = 0.f; b = 0.f; if (tid < BM) { if (MOE) { a = rowr[u.ga + tid]; b = roww[u.ga + tid]; } else a = row_rstd(ssq, u.pm * BM + tid, 16); } }
    __device__ __forceinline__ void rstore(PG8_LAS float* rs, int tid, float a, float b) const { if (tid < BM) { rs[tid] = a; if (MOE) rs[BM + tid] = b; } }
    __device__ __forceinline__ void operator()(const f32x4 (&acc)[2][2][4][2], const Unit& u, int wr, int wc, int fr, int fq, const PG8_LAS float* rs) const {
        const int rl0 = wr * 64 + fr, c0 = u.pe * HALF + wc * 32 + 8 * fq;
#pragma unroll
        for (int ai = 0; ai < 2; ++ai)
#pragma unroll
            for (int m = 0; m < 4; ++m) { const int rl = rl0 + ai * HALF + m * 16, row = u.pm * BM + rl; float r, w = 1.f;
                r = rs[rl]; if (MOE) w = rs[BM + rl];
                const float c = -L2E * r, rw = w * r * r;
                const f32x4 a0 = acc[ai][0][m][0], a1 = acc[ai][0][m][1];
                f32x4 t0 = a0 * c, t1 = a1 * c, o0 = (a0 * acc[ai][1][m][0]) * rw, o1 = (a1 * acc[ai][1][m][1]) * rw;
#pragma unroll
                for (int e = 0; e < 4; ++e) { t0[e] = frcp(1.f + fexp2(t0[e])); t1[e] = frcp(1.f + fexp2(t1[e])); }
                o0 = o0 * t0; o1 = o1 * t1;
                st16(O + (size_t)row * ldo + c0, pack8(o0, o1), !(fl & 2)); }
    }
};
struct EpiBf16 {
    static constexpr bool PERM = true;
    bf16_t* O; int ldo; int fl; bf16_t* OP; size_t pstride; int prow0;
    __device__ __forceinline__ void rload(const Unit&, int, float& a, float& b) const { a = 0.f; b = 0.f; }
    __device__ __forceinline__ void rstore(PG8_LAS float*, int, float, float) const {}
    __device__ __forceinline__ void operator()(const f32x4 (&acc)[2][2][4][2], const Unit& u, int wr, int wc, int fr, int fq, const PG8_LAS float*) const {
        const int row0 = u.pm * BM + wr * 64 + fr, c0 = u.pe * BM + wc * 32 + 8 * fq;
#pragma unroll
        for (int ai = 0; ai < 2; ++ai)
#pragma unroll
            for (int m = 0; m < 4; ++m) { bf16_t* rp = (u.ks < 0 ? O : OP + (size_t)u.ks * pstride - (size_t)prow0 * BM * ldo) + (size_t)(row0 + ai * HALF + m * 16) * ldo + c0;
#pragma unroll
                for (int bj = 0; bj < 2; ++bj) st16(rp + bj * HALF, pack8(acc[ai][bj][m][0], acc[ai][bj][m][1]), !(fl & 2)); }
    }
};
struct EpiOddIn {
    static constexpr bool PERM = true;
    bf16_t* QKVG; size_t tstride; const float* ssq; const float* q_g; const float* k_g; float qscale; int fl;
    __device__ __forceinline__ void rload(const Unit& u, int tid, float& a, float& b) const { a = (tid < BM) ? row_rstd(ssq, u.pm * BM + tid, 16) : 0.f; b = 0.f; }
    __device__ __forceinline__ void rstore(PG8_LAS float* rs, int tid, float a, float) const { if (tid < BM) rs[tid] = a; }
    __device__ __forceinline__ void operator()(const f32x4 (&acc)[2][2][4][2], const Unit& u, int wr, int wc, int fr, int fq, const PG8_LAS float* rs) const {
        const int which = u.pe >> 2, head = (u.pe & 3) * 4 + wc, row0 = u.pm * BM + wr * 64 + fr;
        bf16_t* base = QKVG + (size_t)which * tstride + head * 64 + 8 * fq;
        f32x4 gv[2][2];
        if (which < 2) { const float* gp = which == 0 ? q_g : k_g; const float sc = which == 0 ? qscale : 1.f;
#pragma unroll
            for (int bj = 0; bj < 2; ++bj)
#pragma unroll
                for (int n = 0; n < 2; ++n) gv[bj][n] = *(const f32x4*)(gp + 32 * bj + 8 * fq + 4 * n) * sc; }
#pragma unroll
        for (int ai = 0; ai < 2; ++ai)
#pragma unroll
            for (int m = 0; m < 4; ++m) { const int row = row0 + ai * HALF + m * 16; const float r = rs[wr * 64 + fr + ai * HALF + m * 16];
                f32x4 v[2][2];
#pragma unroll
                for (int bj = 0; bj < 2; ++bj)
#pragma unroll
                    for (int n = 0; n < 2; ++n) v[bj][n] = acc[ai][bj][m][n] * r;
                if (which < 2) { float s = 0.f;
#pragma unroll
                    for (int bj = 0; bj < 2; ++bj)
#pragma unroll
                        for (int n = 0; n < 2; ++n)
#pragma unroll
                            for (int e = 0; e < 4; ++e) s += v[bj][n][e] * v[bj][n][e];
                    s += __shfl_xor(s, 16); s += __shfl_xor(s, 32);
                    const float rh = __builtin_amdgcn_rsqf(s * (1.f / 64.f) + 1e-6f);
#pragma unroll
                    for (int bj = 0; bj < 2; ++bj)
#pragma unroll
                        for (int n = 0; n < 2; ++n) v[bj][n] = v[bj][n] * gv[bj][n] * rh; }
                else if (which == 3) {
#pragma unroll
                    for (int bj = 0; bj < 2; ++bj)
#pragma unroll
                        for (int n = 0; n < 2; ++n)
#pragma unroll
                            for (int e = 0; e < 4; ++e) v[bj][n][e] = sigmoid_f(v[bj][n][e]); }
#pragma unroll
                for (int bj = 0; bj < 2; ++bj) st16(base + (size_t)row * 1024 + 32 * bj, pack8(v[bj][0], v[bj][1]), !(fl & 2)); }
    }
};

template <class Epi, class Sched, bool ALIGN_EPI>
__device__ __forceinline__ void gemm_phase(PG8_LAS unsigned char* lds, PG8_LAS float* rs, const Gemm g, const Sched& S, const Epi& E) {
    const int tid = threadIdx.x, wid = __builtin_amdgcn_readfirstlane(tid >> 6), lane = tid & 63, wr = wid >> 2, wc = wid & 3, fr = lane & 15, fq = lane >> 4;
    const int K = g.K, nt = K / BK;
    int Ra[2], Ca[2]; unsigned voffB[2];
#pragma unroll
    for (int i = 0; i < 2; ++i) { int R, C; stage_rc(tid * 16 + i * 8192, R, C); const int Rb = Epi::PERM ? ((R & ~31) + perm32(R & 31)) : R;
        Ra[i] = R; Ca[i] = C; voffB[i] = (unsigned)(Rb * K + C) * 2u; }
    const size_t kstep = (size_t)(BK * 2);
    const size_t hstep = (size_t)HALF * K * 2;
    const size_t tstep = 2 * hstep;
    const unsigned ldsw = (unsigned)wid * 1024u;
    const int aoff = lds_byte(wr * 64 + fr, fq * 8), boff = lds_byte(wc * 32 + fr, fq * 8);
#define PG8_SA(b, h) (((b) * 2 + (h)) * HTB)
#define PG8_SB(b, h) ((4 + (b) * 2 + (h)) * HTB)
#define PG8_STAGE(bufoff, gbase, voff) do { _Pragma("unroll") for (int _i = 0; _i < 2; ++_i) \
        __builtin_amdgcn_global_load_lds((const unsigned*)((const char*)(gbase) + (voff)[_i]), (PG8_LAS unsigned*)(lds + (bufoff) + ldsw + _i * 8192), 16, 0, 0); } while (0)
#define PG8_STAGE_A(bufoff, kb, offs) do { const char* _ab = (const char*)g.A + (kb); _Pragma("unroll") for (int _i = 0; _i < 2; ++_i) \
        __builtin_amdgcn_global_load_lds((const unsigned*)(_ab + (offs)[_i]), (PG8_LAS unsigned*)(lds + (bufoff) + ldsw + _i * 8192), 16, 0, 0); } while (0)
#define PG8_ROWS(dst, uu) do { _Pragma("unroll") for (int _h = 0; _h < 2; ++_h) _Pragma("unroll") for (int _i = 0; _i < 2; ++_i) { const int _rl = _h * HALF + Ra[_i]; \
        if constexpr (Sched::GATHER) { const int _rc = _rl < (uu).nv ? _rl : (uu).nv - 1; dst[_h][_i] = (unsigned)g.rowtok[(uu).ga + _rc]; }     \
        else { dst[_h][_i] = (unsigned)((uu).pm * BM + _rl); } } } while (0)
#define PG8_FIN(dst, src, uu) do { _Pragma("unroll") for (int _h = 0; _h < 2; ++_h) _Pragma("unroll") for (int _i = 0; _i < 2; ++_i) \
        dst[_h][_i] = src[_h][_i] * (unsigned)(K * 2) + (unsigned)((Ca[_i] + unit_k0(uu)) * 2); } while (0)
#define PG8_LDA(dst, b, h) do { _Pragma("unroll") for (int m = 0; m < 4; ++m) _Pragma("unroll") for (int k = 0; k < 2; ++k) dst[m][k] = *(const PG8_LAS bf16x8*)(lds + PG8_SA(b, h) + aoff + m * 2048 + k * 1024); } while (0)
#define PG8_LDB(dst, b, h) do { _Pragma("unroll") for (int n = 0; n < 2; ++n) _Pragma("unroll") for (int k = 0; k < 2; ++k) dst[n][k] = *(const PG8_LAS bf16x8*)(lds + PG8_SB(b, h) + boff + n * 2048 + k * 1024); } while (0)
#define PG8_MMA(ai, bj, At, Bt) do { __builtin_amdgcn_s_setprio(1); _Pragma("unroll") for (int m = 0; m < 4; ++m) _Pragma("unroll") for (int n = 0; n < 2; ++n) _Pragma("unroll") for (int k = 0; k < 2; ++k) \
        acc[ai][bj][m][n] = __builtin_amdgcn_mfma_f32_16x16x32_bf16(Bt[n][k], At[m][k], acc[ai][bj][m][n], 0, 0, 0); __builtin_amdgcn_s_setprio(0); } while (0)
#define PG8_WAIT_V(n) asm volatile("s_waitcnt vmcnt(" #n ")" ::: "memory")
#define PG8_WAIT_L(n) asm volatile("s_waitcnt lgkmcnt(" #n ")" ::: "memory")
#define PG8_BAR __builtin_amdgcn_s_barrier()
#define PG8_SCHED __builtin_amdgcn_sched_barrier(0)
    Unit cur, nxt; int ui = 0;
    if (!S.next(0, cur)) return;
    bool has_next = S.next(1, nxt);
    unsigned coff[2][2], noff[2][2];
    PG8_ROWS(coff, cur); PG8_FIN(coff, coff, cur);
    if (has_next) { PG8_ROWS(noff, nxt); PG8_FIN(noff, noff, nxt); } else {
#pragma unroll
        for (int h = 0; h < 2; ++h)
#pragma unroll
            for (int i = 0; i < 2; ++i) noff[h][i] = coff[h][i]; }
    f32x4 acc[2][2][4][2];
#pragma unroll
    for (int a = 0; a < 2; ++a)
#pragma unroll
        for (int b = 0; b < 2; ++b)
#pragma unroll
            for (int m = 0; m < 4; ++m)
#pragma unroll
                for (int n = 0; n < 2; ++n) acc[a][b][m][n] = (f32x4){0.f, 0.f, 0.f, 0.f};
    bf16x8 At[4][2], B0[2][2], B1[2][2];
    const char* cB = (const char*)g.Bt + (size_t)cur.pn * tstep + (size_t)unit_k0(cur) * 2;
    PG8_STAGE(PG8_SB(0, 0), cB, voffB); PG8_STAGE(PG8_SB(0, 1), cB + hstep, voffB); PG8_STAGE_A(PG8_SA(0, 0), 0, coff[0]); PG8_STAGE_A(PG8_SA(0, 1), 0, coff[1]);
    if (wr == 1) PG8_BAR;
    PG8_WAIT_V(2); PG8_BAR;
    PG8_STAGE(PG8_SB(1, 0), cB + kstep, voffB); PG8_STAGE_A(PG8_SA(1, 0), kstep, coff[0]); PG8_STAGE(PG8_SB(1, 1), cB + hstep + kstep, voffB);
    PG8_WAIT_V(6); PG8_BAR;
    for (;;) {
        const char* nB = has_next ? (const char*)g.Bt + (size_t)nxt.pn * tstep + (size_t)unit_k0(nxt) * 2 : cB;
        const int ntc = cur.nt ? cur.nt : nt;
        float rsa, rsb; E.rload(cur, tid, rsa, rsb);
        for (int t = 0; t < ntc; t += 2) {
            const bool last = (t == ntc - 2);
            const size_t k1 = (size_t)(t + 1) * kstep;
            const size_t k2 = last ? (size_t)0 : (size_t)(t + 2) * kstep; const char* b2 = last ? nB : cB + (size_t)(t + 2) * kstep;
            const size_t k3 = k2 + kstep; const char* b3 = b2 + kstep;
            unsigned o2[2][2];
#pragma unroll
            for (int h = 0; h < 2; ++h)
#pragma unroll
                for (int i = 0; i < 2; ++i) o2[h][i] = last ? noff[h][i] : coff[h][i];
            PG8_LDB(B0, 0, 0); PG8_LDB(B1, 0, 1); PG8_SCHED; PG8_LDA(At, 0, 0); PG8_STAGE_A(PG8_SA(1, 1), k1, coff[1]);
            PG8_WAIT_V(8); PG8_WAIT_L(0); PG8_BAR; PG8_MMA(0, 0, At, B0); PG8_MMA(0, 1, At, B1); PG8_BAR; PG8_SCHED;
            PG8_LDA(At, 0, 1); PG8_STAGE(PG8_SB(0, 0), b2, voffB); PG8_STAGE(PG8_SB(0, 1), b2 + hstep, voffB); PG8_STAGE_A(PG8_SA(0, 0), k2, o2[0]);
            PG8_WAIT_V(8); PG8_WAIT_L(0); PG8_BAR; PG8_MMA(1, 0, At, B0); PG8_MMA(1, 1, At, B1); PG8_BAR; PG8_SCHED;
            PG8_LDB(B0, 1, 0); PG8_LDB(B1, 1, 1); PG8_SCHED; PG8_LDA(At, 1, 0); PG8_STAGE_A(PG8_SA(0, 1), k2, o2[1]);
            PG8_WAIT_V(8); PG8_WAIT_L(0); PG8_BAR; PG8_MMA(0, 0, At, B0); PG8_MMA(0, 1, At, B1); PG8_BAR; PG8_SCHED;
            PG8_LDA(At, 1, 1); PG8_STAGE(PG8_SB(1, 0), b3, voffB); PG8_STAGE(PG8_SB(1, 1), b3 + hstep, voffB); PG8_STAGE_A(PG8_SA(1, 0), k3, o2[0]);
            PG8_WAIT_V(8); PG8_WAIT_L(0); PG8_BAR; PG8_MMA(1, 0, At, B0); PG8_MMA(1, 1, At, B1); PG8_BAR; PG8_SCHED;
        }
        if constexpr (ALIGN_EPI) { if (wr == 0) PG8_BAR; }
        Unit nn = nxt; const bool has_nn = has_next && S.next(ui + 2, nn);
        unsigned nnoff[2][2];
        if (has_nn) { PG8_ROWS(nnoff, nn); } else {
#pragma unroll
            for (int h = 0; h < 2; ++h)
#pragma unroll
                for (int i = 0; i < 2; ++i) nnoff[h][i] = 0u; }
        { const int ln = (int)__builtin_amdgcn_mbcnt_hi(~0u, __builtin_amdgcn_mbcnt_lo(~0u, 0u));
          E.rstore(rs, wid * 64 + ln, rsa, rsb);
          if constexpr (Sched::GATHER) { asm volatile("" : "+v"(nnoff[0][0]), "+v"(nnoff[0][1]), "+v"(nnoff[1][0]), "+v"(nnoff[1][1])); }
          PG8_WAIT_L(0); PG8_BAR;
          if (!(g.flags & 1)) E(acc, cur, wr, wc, ln & 15, ln >> 4, rs); }
        if (!has_next) break;
#pragma unroll
        for (int a = 0; a < 2; ++a)
#pragma unroll
            for (int b = 0; b < 2; ++b)
#pragma unroll
                for (int m = 0; m < 4; ++m)
#pragma unroll
                    for (int n = 0; n < 2; ++n) acc[a][b][m][n] = (f32x4){0.f, 0.f, 0.f, 0.f};
        cur = nxt; cB = nB; ++ui;
#pragma unroll
        for (int h = 0; h < 2; ++h)
#pragma unroll
            for (int i = 0; i < 2; ++i) coff[h][i] = noff[h][i];
        if (has_nn) { PG8_FIN(noff, nnoff, nn); }
        nxt = nn; has_next = has_nn;
        if constexpr (ALIGN_EPI) { if (wr == 1) PG8_BAR; }
    }
    PG8_WAIT_V(0);
    if constexpr (!ALIGN_EPI) { if (wr == 0) PG8_BAR; }
    PG8_BAR;
#undef PG8_SA
#undef PG8_SB
#undef PG8_STAGE
#undef PG8_STAGE_A
#undef PG8_ROWS
#undef PG8_FIN
#undef PG8_LDA
#undef PG8_LDB
#undef PG8_MMA
#undef PG8_WAIT_V
#undef PG8_WAIT_L
#undef PG8_BAR
#undef PG8_SCHED
}
}
#include <hip/hip_bf16.h>
namespace attn_body {
using bf16=__hip_bfloat16;
using bf16x8=__attribute__((ext_vector_type(8)))short;
using s16x4=__attribute__((ext_vector_type(4)))short;
using f32x16=__attribute__((ext_vector_type(16)))float;
using u32x4=__attribute__((ext_vector_type(4)))unsigned;
using f32x4l=__attribute__((ext_vector_type(4)))float;
constexpr int BATCH=4,NHEAD=16,SEQ=4096,D=64,DM=NHEAD*D;
constexpr int NW=8,QBLK=32,QB=QBLK*NW,KVBLK=64,NQB=SEQ/QB;
constexpr int ATTN_PITCH=DM, ATTN_UNIT_ROWS=QB;
__device__ __forceinline__ int crow(int r,int hi){return (r&3)+8*(r>>2)+4*hi;}
#define SBAR() __builtin_amdgcn_sched_barrier(0)
__device__ __forceinline__ void cmask(f32x16&p0,f32x16&p1,int jb,int qrel,int hi){
  const float NEG=-INFINITY; int kb=64*jb+4*hi;
  #pragma unroll
  for(int r=0;r<16;++r){int kv=kb+(r&3)+8*(r>>2); if(kv>qrel)p0[r]=NEG; if(kv+32>qrel)p1[r]=NEG;}
}

constexpr int NSLOT=3, SLOTB=8192;
constexpr int LDS_K=0, LDS_V=NSLOT*SLOTB, LDS_WS=2*NSLOT*SLOTB, LDS_OST=LDS_WS+NW*64*4, LDS_BYTES=LDS_OST+NW*4096;
constexpr float C2=0.125f*1.4426950408889634f;
__device__ __forceinline__ void glds16(const void*gsrc,unsigned lds_dst){unsigned keep;
  asm volatile("s_mov_b32 %0, m0\n\ts_mov_b32 m0, %2\n\ts_nop 0\n\tglobal_load_lds_dwordx4 %1, off\n\ts_mov_b32 m0, %0":"=&s"(keep):"v"(gsrc),"s"(lds_dst):"memory");}
__device__ __forceinline__ float max3f(float a,float b,float c){float r;asm("v_max3_f32 %0, %1, %2, %3":"=v"(r):"v"(a),"v"(b),"v"(c));return r;}
__device__ __forceinline__ float max2f(float a,float b){float r;asm("v_max_f32_e32 %0, %1, %2":"=v"(r):"v"(a),"v"(b));return r;}
__device__ __forceinline__ float fadd_s(float a,float b){float r;asm("v_add_f32_e32 %0, %1, %2":"=v"(r):"v"(a),"v"(b));return r;}
__device__ __forceinline__ float fsub_s(float a,float b){float r;asm("v_sub_f32_e32 %0, %1, %2":"=v"(r):"v"(a),"v"(b));return r;}
typedef float f32x2_t __attribute__((ext_vector_type(2))); typedef __bf16 bf16x2_t __attribute__((ext_vector_type(2)));
__device__ __forceinline__ unsigned cvtpk_s(float lo,float hi){f32x2_t v={lo,hi};bf16x2_t b=__builtin_convertvector(v,bf16x2_t);return __builtin_bit_cast(unsigned,b);}
#define WAIT_BAR(N) asm volatile("s_waitcnt vmcnt(" #N ") lgkmcnt(0)\n\ts_barrier":::"memory")

__device__ __forceinline__ void qkt(f32x16&p0,f32x16&p1,const char*Kslot,const bf16x8*qr,int r32,int hi){
  const char*kb=Kslot+hi*1024+r32*16;
  #pragma unroll
  for(int d0=0;d0<4;++d0){
    const bf16x8 b0=*reinterpret_cast<const bf16x8*>(kb+d0*2048);
    const bf16x8 b1=*reinterpret_cast<const bf16x8*>(kb+d0*2048+512);
    {p0=__builtin_amdgcn_mfma_f32_32x32x16_bf16(b0,qr[d0],p0,0,0,0);p1=__builtin_amdgcn_mfma_f32_32x32x16_bf16(b1,qr[d0],p1,0,0,0);}}
}
typedef __attribute__((address_space(3))) const char* lds_cptr;
typedef short v4i16_t __attribute__((ext_vector_type(4)));
__device__ __forceinline__ void kload8(bf16x8*kf,lds_cptr kp){
  kf[0]=*(const __attribute__((address_space(3))) bf16x8*)(kp);      kf[1]=*(const __attribute__((address_space(3))) bf16x8*)(kp+512);
  kf[2]=*(const __attribute__((address_space(3))) bf16x8*)(kp+2048); kf[3]=*(const __attribute__((address_space(3))) bf16x8*)(kp+2560);
  kf[4]=*(const __attribute__((address_space(3))) bf16x8*)(kp+4096); kf[5]=*(const __attribute__((address_space(3))) bf16x8*)(kp+4608);
  kf[6]=*(const __attribute__((address_space(3))) bf16x8*)(kp+6144); kf[7]=*(const __attribute__((address_space(3))) bf16x8*)(kp+6656);
}
__device__ __forceinline__ void kload2(bf16x8*kf,lds_cptr kp,int j){ kf[2*j]=*(const __attribute__((address_space(3))) bf16x8*)(kp+j*2048); kf[2*j+1]=*(const __attribute__((address_space(3))) bf16x8*)(kp+j*2048+512); }
__device__ __forceinline__ s16x4 vtr(lds_cptr p){ return __builtin_bit_cast(s16x4,__builtin_amdgcn_ds_read_tr16_b64_v4i16((__attribute__((address_space(3))) v4i16_t*)p)); }
__device__ __forceinline__ float rowmax(const f32x16&p0,const f32x16&p1){
  float a=max3f(p0[0],p0[1],p1[0]),b=max3f(p0[2],p0[3],p1[1]);a=max3f(a,p1[2],p1[3]);
  #pragma unroll
  for(int r=4;r<16;r+=4){a=max3f(a,p0[r],p0[r+1]);b=max3f(b,p0[r+2],p0[r+3]);a=max3f(a,p1[r],p1[r+1]);b=max3f(b,p1[r+2],p1[r+3]);}
  const float m=max2f(a,b);
  auto rr=__builtin_amdgcn_permlane32_swap(__float_as_uint(m),__float_as_uint(m),false,false);
  return max2f(__uint_as_float(rr[0]),__uint_as_float(rr[1]));
}
__device__ __forceinline__ void pv(f32x16*o,int vb,bf16x8 pa0,bf16x8 pa1,bf16x8 pa2,bf16x8 pa3){
  #pragma unroll
  for(int d0=0;d0<2;++d0){s16x4 lo[4],hi[4];
    #pragma unroll
    for(int ks=0;ks<4;++ks){
      asm volatile("ds_read_b64_tr_b16 %0,%1 offset:%c2":"=&v"(lo[ks]):"v"(vb),"i"(d0*4096+ks*1024):"memory");
      asm volatile("ds_read_b64_tr_b16 %0,%1 offset:%c2":"=&v"(hi[ks]):"v"(vb),"i"(d0*4096+ks*1024+512):"memory");}
    asm volatile("s_waitcnt lgkmcnt(0)":::"memory");SBAR();
    #define PK(k) (bf16x8){lo[k][0],lo[k][1],lo[k][2],lo[k][3],hi[k][0],hi[k][1],hi[k][2],hi[k][3]}
    o[d0]=__builtin_amdgcn_mfma_f32_32x32x16_bf16(pa0,PK(0),o[d0],0,0,0);
    o[d0]=__builtin_amdgcn_mfma_f32_32x32x16_bf16(pa1,PK(1),o[d0],0,0,0);
    o[d0]=__builtin_amdgcn_mfma_f32_32x32x16_bf16(pa2,PK(2),o[d0],0,0,0);
    o[d0]=__builtin_amdgcn_mfma_f32_32x32x16_bf16(pa3,PK(3),o[d0],0,0,0);
    #undef PK
  }
}

#ifndef ATTN_STORE16
#define ATTN_STORE16(p,v) (*(u32x4*)(p)=(v))
#endif
typedef __attribute__((address_space(3))) const float* lds_fptr; typedef __attribute__((address_space(3))) const f32x4l* lds_f4ptr;
template<int THRL> __device__ __forceinline__ void attn_unit(int b,int h,int qb,const bf16*Q,const bf16*__restrict__ K,const bf16*__restrict__ V,bf16*O,const bf16*__restrict__ OG,lds_fptr cbl,float skipthr,char*shm){
  const int tid=threadIdx.x,lane=tid&63,r32=lane&31,hi=lane>>5; const int wid=__builtin_amdgcn_readfirstlane(tid>>6);
  const long rowbase=(long)b*SEQ; const int q0=qb*QB;
  const bf16*Qw=Q+(rowbase+q0+wid*QBLK)*DM+h*D;
  int t0; { const int NTf=(q0+QB)/KVBLK; const float need=cbl[q0]+skipthr; const bool keep=(lane<NTf)?(cbl[64*lane+63]>=need):true;
    const unsigned long long mk=__ballot(keep); int f=(int)__builtin_ctzll(mk); f&=~1; t0=f<NTf-4?f:NTf-4; t0=__builtin_amdgcn_readfirstlane(t0); }
  const bf16*Kh=K+(rowbase+(long)t0*KVBLK)*DM+h*D,*Vh=V+(rowbase+(long)t0*KVBLK)*DM+h*D;
  const unsigned lds0=(unsigned)(uintptr_t)shm;
  float*wsf=(float*)(shm+LDS_WS)+wid*64;
  const bf16*ksrc=Kh+(long)lane*DM+wid*8;
  const bf16*vsrc=Vh+(long)(16*(wid&3)+(lane>>2))*DM+(wid>>2)*32+(lane&3)*8;
  const unsigned kdst=lds0+LDS_K+wid*1024, vdst=lds0+LDS_V+wid*1024;
  #define DMA_K(t,slot) glds16(ksrc+(long)(t)*KVBLK*DM,(unsigned)__builtin_amdgcn_readfirstlane(kdst+(slot)))
  #define DMA_V(t,slot) glds16(vsrc+(long)(t)*KVBLK*DM,(unsigned)__builtin_amdgcn_readfirstlane(vdst+(slot)))
  const int vb0=(int)(lds0+LDS_V)+((lane>>4)&1)*32+(lane&3)*8+(4*hi+((lane&15)>>2))*64;
  const char*Kbase=shm+LDS_K; bf16x8 kf[8];
  const lds_cptr shm3=(lds_cptr)shm; const lds_cptr kp0=shm3+LDS_K+hi*1024+r32*16; const lds_cptr vp0=shm3+LDS_V+((lane>>4)&1)*32+(lane&3)*8+(4*hi+((lane&15)>>2))*64;
  const int NT=(q0+QB)/KVBLK-t0;
  DMA_K(0,0);DMA_V(0,0);DMA_K(1,SLOTB);
  bf16x8 qr[4];
  #pragma unroll
  for(int d0=0;d0<4;++d0)qr[d0]=*reinterpret_cast<const bf16x8*>(&Qw[(long)r32*DM+d0*16+hi*8]);
  float mhat=cbl[q0+wid*QBLK+r32],l_reg=0.f;f32x16 o[2];o[0]=f32x16{};o[1]=f32x16{};

  const lds_fptr cbh=cbl+64*t0+4*hi;
  #define CINIT(C0,C1,t) do{ const lds_fptr cb_=cbh+64*(t); _Pragma("unroll") for(int g_=0;g_<4;++g_){ const f32x4l x0_=*(lds_f4ptr)(cb_+8*g_), x1_=*(lds_f4ptr)(cb_+32+8*g_); \
      _Pragma("unroll") for(int j_=0;j_<4;++j_){ C0[4*g_+j_]=x0_[j_]-mhat; C1[4*g_+j_]=x1_[j_]-mhat; } } }while(0)
  const int qrel=wid*QBLK+r32;
  #define CMASK(P0,P1,t) do{int jb_=(t)-(NT-4); if(jb_>=0)cmask(P0,P1,jb_,qrel,hi);}while(0)
  bool resc=false;
  #define START(P0,P1) do{ resc=false; \
    _Pragma("unroll") for(int r=0;r<16;++r)P0[r]=__builtin_amdgcn_exp2f(P0[r]); }while(0)
  #define RESC() do{ if(resc){ asm volatile("s_waitcnt lgkmcnt(0)":::"memory"); \
      _Pragma("unroll") for(int d_=0;d_<2;++d_) _Pragma("unroll") for(int r=0;r<16;++r)o[d_][r]*=wsf[crow(r,hi)]; } }while(0)
  f32x16 pA0,pA1,pB0,pB1;
  int sl_prev=0,sl_cur=0,sl_next=SLOTB;
  #define ROT() do{sl_prev=sl_cur;sl_cur=sl_next;sl_next=(sl_next==(NSLOT-1)*SLOTB)?0:sl_next+SLOTB;}while(0)
  DMA_K(2,2*SLOTB);
  WAIT_BAR(3);
  CINIT(pA0,pA1,0); qkt(pA0,pA1,Kbase,qr,r32,hi);asm volatile("s_nop 15\n\ts_nop 7":"+v"(pA0),"+v"(pA1));CMASK(pA0,pA1,0);
  START(pA0,pA1);
  _Pragma("unroll") for(int r=0;r<16;++r)pA1[r]=__builtin_amdgcn_exp2f(pA1[r]);
  WAIT_BAR(0);
  DMA_K(3,0);DMA_V(1,SLOTB);
  ROT();
  kload8(kf,kp0+sl_cur);
  WAIT_BAR(2);
  s16x4 vlo[8],vhi[8]; u32x4 pw0,pw1,pw2,pw3;
  #define PKW(P,B) cvtpk_s(P[B],P[B+1])
  #define PAF(k) __builtin_bit_cast(bf16x8,pw##k)
  #define VFR(i) (bf16x8){vlo[i][0],vlo[i][1],vlo[i][2],vlo[i][3],vhi[i][0],vhi[i][1],vhi[i][2],vhi[i][3]}
  #define PIN(x) asm volatile("":"+v"(x))
  #define MX3(a,b,c) __builtin_fmaxf(__builtin_fmaxf((a),(b)),(c))
  #define GAPA(MF,A0,A1,A2,A3,W0,W1,PW) do{ MF; sacc+=A0; sacc+=A1; sacc+=A2; sacc+=A3; PIN(sacc); W0; W1; PIN(PW); SBAR(); }while(0)
  #define EX(v) __builtin_amdgcn_exp2f(v)
  #define GAPB(MF,X,B) do{ MF; X[B]=EX(X[B]); X[B+1]=EX(X[B+1]); X[B+2]=EX(X[B+2]); X[B+3]=EX(X[B+3]); PIN(X); SBAR(); }while(0)
  #define VRD(i) do{ vlo[i]=vtr(vp_+(((i)>>2)*4096+((i)&3)*1024)); vhi[i]=vtr(vp_+(((i)>>2)*4096+((i)&3)*1024+512)); }while(0)
  #define KRD(G,j) do{ if(G){ kload2(kf,kp0+sl_next,j); SBAR(); } }while(0)
  #define STEP(C0,C1,P0,P1,t,GK,GV,GL) do{ SBAR(); \
    const lds_cptr vp_=vp0+sl_prev; \
    CINIT(C0,C1,t); SBAR(); VRD(0); SBAR(); float sacc=(P0[0]+P0[1]); \
    GAPA(C0=__builtin_amdgcn_mfma_f32_32x32x16_bf16(kf[0],qr[0],C0,0,0,0), P0[2],P0[3],P0[4],P0[5],     pw0[0]=PKW(P0,0), pw0[1]=PKW(P0,2), pw0); \
    VRD(4); SBAR(); GAPA(C1=__builtin_amdgcn_mfma_f32_32x32x16_bf16(kf[1],qr[0],C1,0,0,0), P0[6],P0[7],P0[8],P0[9],     pw0[2]=PKW(P0,4), pw0[3]=PKW(P0,6), pw0); \
    VRD(1); SBAR(); GAPA(C0=__builtin_amdgcn_mfma_f32_32x32x16_bf16(kf[2],qr[1],C0,0,0,0),   P0[10],P0[11],P0[12],P0[13], pw1[0]=PKW(P0,8), pw1[1]=PKW(P0,10), pw1); \
    VRD(5); SBAR(); GAPA(C1=__builtin_amdgcn_mfma_f32_32x32x16_bf16(kf[3],qr[1],C1,0,0,0),   P0[14],P0[15],P1[0],P1[1],   pw1[2]=PKW(P0,12),pw1[3]=PKW(P0,14), pw1); \
    VRD(2); SBAR(); GAPA(C0=__builtin_amdgcn_mfma_f32_32x32x16_bf16(kf[4],qr[2],C0,0,0,0),   P1[2],P1[3],P1[4],P1[5],     pw2[0]=PKW(P1,0), pw2[1]=PKW(P1,2), pw2); \
    VRD(6); SBAR(); GAPA(C1=__builtin_amdgcn_mfma_f32_32x32x16_bf16(kf[5],qr[2],C1,0,0,0),   P1[6],P1[7],P1[8],P1[9],     pw2[2]=PKW(P1,4), pw2[3]=PKW(P1,6), pw2); \
    VRD(3); SBAR(); GAPA(C0=__builtin_amdgcn_mfma_f32_32x32x16_bf16(kf[6],qr[3],C0,0,0,0),   P1[10],P1[11],P1[12],P1[13], pw3[0]=PKW(P1,8), pw3[1]=PKW(P1,10), pw3); \
    VRD(7); SBAR(); GAPA(C1=__builtin_amdgcn_mfma_f32_32x32x16_bf16(kf[7],qr[3],C1,0,0,0),   P1[14],P1[15],0.f,0.f,       pw3[2]=PKW(P1,12),pw3[3]=PKW(P1,14), pw3); \
    l_reg+=sacc; \
    if(GK){DMA_K((t)+3,sl_cur);} if(GV){DMA_V((t)+1,sl_next);} \
    CMASK(C0,C1,t); \
    { float a=MX3(C0[0],C0[1],C1[0]),b=MX3(C0[2],C0[3],C1[1]); a=MX3(a,C1[2],C1[3]); \
      _Pragma("unroll") for(int r=4;r<16;r+=4){a=MX3(a,C0[r],C0[r+1]);b=MX3(b,C0[r+2],C0[r+3]);a=MX3(a,C1[r],C1[r+1]);b=MX3(b,C1[r+2],C1[r+3]);} \
      float rm=__builtin_fmaxf(a,b); { auto rr=__builtin_amdgcn_permlane32_swap(__float_as_uint(rm),__float_as_uint(rm),false,false); rm=__builtin_fmaxf(__uint_as_float(rr[0]),__uint_as_float(rr[1])); } \
      resc=false; \
      if(__builtin_expect(__any(rm>(float)THRL),0)){ const float dl=__builtin_fmaxf(rm,0.f); mhat+=dl; \
        _Pragma("unroll") for(int r=0;r<16;++r){C0[r]-=dl;C1[r]-=dl;} \
        const float f=__builtin_amdgcn_exp2f(-dl); l_reg*=f; if(hi==0)wsf[r32]=f; resc=true; } } \
    SBAR(); \
    GAPB(o[0]=__builtin_amdgcn_mfma_f32_32x32x16_bf16(PAF(0),VFR(0),o[0],0,0,0), C0,0); \
    GAPB(o[1]=__builtin_amdgcn_mfma_f32_32x32x16_bf16(PAF(0),VFR(4),o[1],0,0,0), C0,4); \
    KRD(GL,0); GAPB(o[0]=__builtin_amdgcn_mfma_f32_32x32x16_bf16(PAF(1),VFR(1),o[0],0,0,0), C0,8); \
    KRD(GL,1); GAPB(o[1]=__builtin_amdgcn_mfma_f32_32x32x16_bf16(PAF(1),VFR(5),o[1],0,0,0), C0,12); \
    KRD(GL,2); GAPB(o[0]=__builtin_amdgcn_mfma_f32_32x32x16_bf16(PAF(2),VFR(2),o[0],0,0,0), C1,0); \
    KRD(GL,3); GAPB(o[1]=__builtin_amdgcn_mfma_f32_32x32x16_bf16(PAF(2),VFR(6),o[1],0,0,0), C1,4); \
    GAPB(o[0]=__builtin_amdgcn_mfma_f32_32x32x16_bf16(PAF(3),VFR(3),o[0],0,0,0), C1,8); \
    GAPB(o[1]=__builtin_amdgcn_mfma_f32_32x32x16_bf16(PAF(3),VFR(7),o[1],0,0,0), C1,12); \
    }while(0)
  int t=1;
  #undef CMASK
  #define CMASK(P0,P1,t) do{}while(0)
  for(;t+5<NT;t+=2){
    STEP(pB0,pB1,pA0,pA1,t,true,true,true);     WAIT_BAR(2); RESC(); ROT();
    STEP(pA0,pA1,pB0,pB1,t+1,true,true,true);   WAIT_BAR(2); RESC(); ROT();
  }
  #undef CMASK
  #define CMASK(P0,P1,t) do{int jb_=(t)-(NT-4); if(jb_>=0)cmask(P0,P1,jb_,qrel,hi);}while(0)
  #define ENDW(tt) do{ if((tt)+3<NT){WAIT_BAR(2);} else if((tt)+2<NT){WAIT_BAR(1);} else {WAIT_BAR(0);} }while(0)
  for(;t+1<NT;t+=2){
    STEP(pB0,pB1,pA0,pA1,t,(t+3<NT),(t+1<NT),(t+1<NT));       ENDW(t);   RESC(); ROT();
    STEP(pA0,pA1,pB0,pB1,t+1,(t+4<NT),(t+2<NT),(t+2<NT));     ENDW(t+1); RESC(); ROT();
  }
  STEP(pB0,pB1,pA0,pA1,NT-1,false,false,false); RESC();
  { float sacc=pB0[0]+pB0[1]; _Pragma("unroll") for(int r=2;r<16;++r)sacc+=pB0[r]; _Pragma("unroll") for(int r=0;r<16;++r)sacc+=pB1[r]; l_reg+=sacc;
    pw0=(u32x4){PKW(pB0,0),PKW(pB0,2),PKW(pB0,4),PKW(pB0,6)};pw1=(u32x4){PKW(pB0,8),PKW(pB0,10),PKW(pB0,12),PKW(pB0,14)};pw2=(u32x4){PKW(pB1,0),PKW(pB1,2),PKW(pB1,4),PKW(pB1,6)};pw3=(u32x4){PKW(pB1,8),PKW(pB1,10),PKW(pB1,12),PKW(pB1,14)};
    SBAR(); pv(o,vb0+sl_cur,PAF(0),PAF(1),PAF(2),PAF(3)); }
  #undef PKW
  #undef PAF
  #undef VFR
  #undef PIN
  #undef MX3
  #undef GAPA
  #undef GAPB
  #undef EX
  #undef VRD
  #undef KRD
  #undef STEP
  #undef ENDW
  {auto rr=__builtin_amdgcn_permlane32_swap(__float_as_uint(l_reg),__float_as_uint(l_reg),false,false);l_reg=__uint_as_float(rr[0])+__uint_as_float(rr[1]);}
  if(hi==0)wsf[32+r32]=l_reg;asm volatile("s_waitcnt lgkmcnt(0)":::"memory");
  float rli[16];
  #pragma unroll
  for(int r=0;r<16;++r)rli[r]=__builtin_amdgcn_rcpf(wsf[32+crow(r,hi)]);
  bf16*Ow=O+(rowbase+q0+wid*QBLK)*DM+h*D; const bf16*OGw=OG+(rowbase+q0+wid*QBLK)*DM+h*D;
  { bf16*stg=(bf16*)(shm+LDS_OST)+wid*2048;
    #pragma unroll
    for(int r=0;r<16;++r){const int orow=crow(r,hi);
      #pragma unroll
      for(int d0=0;d0<2;++d0)stg[orow*64+d0*32+r32]=__float2bfloat16(o[d0][r]*rli[r]);}
    asm volatile("s_waitcnt lgkmcnt(0)":::"memory");
    #pragma unroll
    for(int i=0;i<4;++i){const int row=i*8+(lane>>3),ch=lane&7; u32x4 v=*(const u32x4*)(stg+row*64+ch*8); const u32x4 gt=*(const u32x4*)(OGw+(long)row*DM+ch*8);
      #pragma unroll
      for(int e=0;e<4;++e){ const float lo=__uint_as_float(v[e]<<16)*__uint_as_float(gt[e]<<16), hh=__uint_as_float(v[e]&0xffff0000u)*__uint_as_float(gt[e]&0xffff0000u); v[e]=cvtpk_s(lo,hh); }
      ATTN_STORE16(Ow+(long)row*DM+ch*8,v);} }
  asm volatile("s_waitcnt lgkmcnt(0)\n\ts_barrier":::"memory");
  #undef DMA_K
  #undef DMA_V
  #undef CMASK
  #undef START
  #undef RESC
  #undef ROT
  #undef CINIT
}
constexpr int ATTN_LDS_BYTES=LDS_BYTES;
struct AttnTensors { const bf16* Q; const bf16* K; const bf16* V; bf16* O; const bf16* OG; };
struct AttnUnit { int bh; int qb; };
struct StaticOrder {
  int vcu;
  __device__ __forceinline__ explicit StaticOrder(int vcu_):vcu(vcu_){}
  __device__ __forceinline__ bool next(int i,AttnUnit&u)const{ if(i>=4)return false; const int s0=2*(vcu&3); u.bh=vcu>>2; u.qb=(i==0)?15-s0:(i==1)?s0:(i==2)?14-s0:s0+1; return true; }
  __device__ __forceinline__ void a_ready(const AttnUnit&)const{}
  __device__ __forceinline__ void done(const AttnUnit&)const{}
};
template<class Sched,int THRL=8> __device__ __forceinline__ void attn_phase(char*lds,lds_fptr cbl,float skipthr,const AttnTensors&T,const Sched&S){
  AttnUnit u;
  for(int i=0;S.next(i,u);++i){ S.a_ready(u); attn_unit<THRL>(u.bh/NHEAD,u.bh%NHEAD,u.qb,T.Q,T.K,T.V,T.O,T.OG,cbl,skipthr,lds); S.done(u); }
}
#undef SBAR
#undef WAIT_BAR
}
namespace mx {
#define MLAS __attribute__((address_space(3)))
typedef unsigned short bf16_t;
typedef short bf16x8 __attribute__((ext_vector_type(8)));
typedef float f32x16 __attribute__((ext_vector_type(16)));
typedef float f32x4 __attribute__((ext_vector_type(4)));
typedef unsigned u32x4 __attribute__((ext_vector_type(4)));
typedef unsigned u32x2 __attribute__((ext_vector_type(2)));
constexpr float L2E = 1.4426950408889634f;
constexpr int ZP = 2560;
constexpr int PV = 136, PK = 72;
constexpr int GP = 65;

__device__ __forceinline__ unsigned pk2(float lo, float hi) { unsigned r; asm("v_cvt_pk_bf16_f32 %0, %1, %2" : "=v"(r) : "v"(lo), "v"(hi)); return r; }
__device__ __forceinline__ bf16_t f2bf(float f) { return (bf16_t)(pk2(f, 0.f) & 0xffffu); }
__device__ __forceinline__ float bf2f(bf16_t b) { return __uint_as_float((unsigned)b << 16); }
__device__ __forceinline__ float blo(unsigned w) { return __uint_as_float(w << 16); }
__device__ __forceinline__ float bhi(unsigned w) { return __uint_as_float(w & 0xffff0000u); }
__device__ __forceinline__ float ex(float x) { return __builtin_amdgcn_exp2f(L2E * x); }
__device__ __forceinline__ f32x16 mma32(bf16x8 a, bf16x8 b, f32x16 c) { return __builtin_amdgcn_mfma_f32_32x32x16_bf16(a, b, c, 0, 0, 0); }
__device__ __forceinline__ float wsum(float v) {
#pragma unroll
    for (int o = 32; o; o >>= 1) v += __shfl_xor(v, o);
    return v; }

template <int NF>
__device__ __forceinline__ void stage_T(MLAS bf16_t* T, int P, const bf16_t* src, int pitch, int base, int col0, int tid) {
    for (int c = tid; c < 128 * (NF / 8); c += 512) { const int s = c & 127, fc = c >> 7;
        const u32x4 w = *(const u32x4*)(src + (size_t)(base + s) * pitch + col0 + fc * 8);
#pragma unroll
        for (int e = 0; e < 4; ++e) { T[(fc * 8 + 2 * e) * P + s] = (bf16_t)(w[e] & 0xffffu); T[(fc * 8 + 2 * e + 1) * P + s] = (bf16_t)(w[e] >> 16); } }
}
template <int NF>
__device__ __forceinline__ void stage_T_ld(u32x4 (&w)[NF / 32], const bf16_t* src, int pitch, int base, int col0, int tid) {
#pragma unroll
    for (int j = 0; j < NF / 32; ++j) { const int c = tid + 512 * j, s = c & 127, fc = c >> 7; w[j] = *(const u32x4*)(src + (size_t)(base + s) * pitch + col0 + fc * 8); }
}
template <int NF>
__device__ __forceinline__ void stage_T_st(MLAS bf16_t* T, int P, const u32x4 (&w)[NF / 32], int tid) {
#pragma unroll
    for (int j = 0; j < NF / 32; ++j) { const int c = tid + 512 * j, s = c & 127, fc = c >> 7;
#pragma unroll
        for (int e = 0; e < 4; ++e) { T[(fc * 8 + 2 * e) * P + s] = (bf16_t)(w[j][e] & 0xffffu); T[(fc * 8 + 2 * e + 1) * P + s] = (bf16_t)(w[j][e] >> 16); } }
}
__device__ __forceinline__ void gla_cumsum_ld(float (&la)[16], const float* loga, int base, int h, int tid) {
    const int kk = tid & 63, seg = tid >> 6;
#pragma unroll
    for (int i = 0; i < 16; ++i) la[i] = loga[(size_t)(base + seg * 16 + i) * 256 + h * 64 + kk];
}
__device__ __forceinline__ void gla_cumsum_st(MLAS float* G, MLAS float* SEG, const float (&la)[16], int tid) {
    const int kk = tid & 63, seg = tid >> 6; float v[16]; float run = 0.f;
#pragma unroll
    for (int i = 0; i < 16; ++i) { run += la[i]; v[i] = run; }
    SEG[seg * 64 + kk] = run;
    __syncthreads();
    float pre = 0.f;
#pragma unroll
    for (int s = 0; s < 8; ++s) pre += (s < seg) ? SEG[s * 64 + kk] : 0.f;
#pragma unroll
    for (int i = 0; i < 16; ++i) G[(seg * 16 + i) * GP + kk] = v[i] + pre;
    __syncthreads();
}
__device__ __forceinline__ void gla_cumsum(MLAS float* G, MLAS float* SEG, const float* loga, int base, int h, int tid) {
    const int kk = tid & 63, seg = tid >> 6; float v[16]; float run = 0.f;
#pragma unroll
    for (int i = 0; i < 16; ++i) { run += loga[(size_t)(base + seg * 16 + i) * 256 + h * 64 + kk]; v[i] = run; }
    SEG[seg * 64 + kk] = run;
    __syncthreads();
    float pre = 0.f;
#pragma unroll
    for (int s = 0; s < 8; ++s) pre += (s < seg) ? SEG[s * 64 + kk] : 0.f;
#pragma unroll
    for (int i = 0; i < 16; ++i) G[(seg * 16 + i) * GP + kk] = v[i] + pre;
    __syncthreads();
}

__device__ __forceinline__ void gmlp_unit(MLAS unsigned char* lds, int chunk, int g, const bf16_t* Z, const float* vstp, const float* ln_g, const float* ln_b,
                                          const bf16_t* WSt, const float* b_s, bf16_t* MIX, int tid) {
    MLAS bf16_t* VT = (MLAS bf16_t*)lds;
    MLAS float* MU = (MLAS float*)(lds + 34816); MLAS float* RS = MU + 128;
    const int base = chunk * 128, lane = tid & 63, w = tid >> 6, r32 = lane & 31, hi = lane >> 5;
    bf16x8 wa[8];
    { const bf16_t* wrow = WSt + ((size_t)g * 128 + (w >> 1) * 32 + r32) * 128 + 8 * hi;
#pragma unroll
        for (int ks = 0; ks < 8; ++ks) wa[ks] = *(const bf16x8*)(wrow + 16 * ks); }
    u32x4 vw[4];
#pragma unroll
    for (int j = 0; j < 4; ++j) { const int c = tid + 512 * j, s = c & 127, dc = c >> 7; vw[j] = *(const u32x4*)(Z + (size_t)(base + s) * ZP + 512 + g * 128 + dc * 8); }
    const int it = w >> 1, jt0 = 2 * (w & 1);
    bf16_t u0[16], u1[16]; float bs[16];
    { const int d0 = jt0 * 32 + r32;
#pragma unroll
        for (int r = 0; r < 16; ++r) { const int t = it * 32 + (r & 3) + 8 * (r >> 2) + 4 * hi; const size_t zo = (size_t)(base + t) * ZP + g * 128; bs[r] = b_s[g * 128 + t]; u0[r] = Z[zo + d0]; u1[r] = Z[zo + d0 + 32]; } }
    if (tid < 128) { const f32x4* q = (const f32x4*)(vstp + (size_t)(base + tid) * 16); const f32x4 a = q[0], b = q[1], c = q[2], d = q[3];
        const float s1 = ((a[0] + a[1]) + (a[2] + a[3])) + ((b[0] + b[1]) + (b[2] + b[3])), s2 = ((c[0] + c[1]) + (c[2] + c[3])) + ((d[0] + d[1]) + (d[2] + d[3])); const float mu = s1 * (1.f / 512.f);
        const float var = fmaxf(s2 * (1.f / 512.f) - mu * mu, 0.f); MU[tid] = mu; RS[tid] = 1.0f / sqrtf(var + 1e-6f); }
    __syncthreads();
#pragma unroll
    for (int j = 0; j < 4; ++j) { const int c = tid + 512 * j, s = c & 127, dc = c >> 7;
        const u32x4 wv = vw[j];
        const float mu = MU[s], rs = RS[s];
        const f32x4 g0 = *(const f32x4*)(ln_g + g * 128 + dc * 8), g1 = *(const f32x4*)(ln_g + g * 128 + dc * 8 + 4);
        const f32x4 b0 = *(const f32x4*)(ln_b + g * 128 + dc * 8), b1 = *(const f32x4*)(ln_b + g * 128 + dc * 8 + 4);
        const float gg[8] = {g0[0], g0[1], g0[2], g0[3], g1[0], g1[1], g1[2], g1[3]}, bb[8] = {b0[0], b0[1], b0[2], b0[3], b1[0], b1[1], b1[2], b1[3]};
#pragma unroll
        for (int e = 0; e < 4; ++e) { const unsigned p = pk2((blo(wv[e]) - mu) * rs * gg[2 * e] + bb[2 * e], (bhi(wv[e]) - mu) * rs * gg[2 * e + 1] + bb[2 * e + 1]);
            VT[(dc * 8 + 2 * e) * PV + s] = (bf16_t)(p & 0xffffu); VT[(dc * 8 + 2 * e + 1) * PV + s] = (bf16_t)(p >> 16); } }
    __syncthreads();
    f32x16 acc0 = {}, acc1 = {};
    const MLAS bf16_t* v0 = VT + (jt0 * 32 + r32) * PV + 8 * hi; const MLAS bf16_t* v1 = v0 + 32 * PV;
#pragma unroll
    for (int ks = 0; ks < 8; ++ks) acc0 = mma32(wa[ks], *(const MLAS bf16x8*)(v0 + 16 * ks), acc0);
#pragma unroll
    for (int ks = 0; ks < 8; ++ks) acc1 = mma32(wa[ks], *(const MLAS bf16x8*)(v1 + 16 * ks), acc1);
    { const int d0 = jt0 * 32 + r32;
#pragma unroll
        for (int r = 0; r < 16; ++r) { const int t = it * 32 + (r & 3) + 8 * (r >> 2) + 4 * hi; const size_t mo = (size_t)(base + t) * 1024 + g * 128;
            MIX[mo + d0] = f2bf(bf2f(u0[r]) * (acc0[r] + bs[r])); MIX[mo + d0 + 32] = f2bf(bf2f(u1[r]) * (acc1[r] + bs[r])); } }
    __syncthreads();
}

__device__ __forceinline__ void gla_u_unit(MLAS unsigned char* lds, int cidx, int h, const bf16_t* Z, const float* loga, float* Ut, float* DEC, int tid) {
    MLAS float* G = (MLAS float*)lds; MLAS float* SEG = (MLAS float*)(lds + 33280);
    MLAS bf16_t* KT = (MLAS bf16_t*)(lds + 35328); MLAS bf16_t* VT = (MLAS bf16_t*)(lds + 52736);
    const int base = cidx * 128, unit = cidx * 4 + h, lane = tid & 63, w = tid >> 6, r32 = lane & 31, hi = lane >> 5;
    float la[16]; u32x4 kw[2], vw[4];
    gla_cumsum_ld(la, loga, base, h, tid);
#pragma unroll
    for (int j = 0; j < 2; ++j) { const int c = tid + 512 * j, s = c & 127, kc = c >> 7; kw[j] = *(const u32x4*)(Z + (size_t)(base + s) * ZP + 1280 + h * 64 + kc * 8); }
    stage_T_ld<128>(vw, Z, ZP, base, 1536 + h * 128, tid);
    stage_T_st<128>(VT, PV, vw, tid);
    gla_cumsum_st(G, SEG, la, tid);
#pragma unroll
    for (int j = 0; j < 2; ++j) { const int c = tid + 512 * j, s = c & 127, kc = c >> 7; const u32x4 wv = kw[j];
#pragma unroll
        for (int e = 0; e < 4; ++e) { const int k0 = kc * 8 + 2 * e;
            const unsigned p = pk2(blo(wv[e]) * ex(G[127 * GP + k0] - G[s * GP + k0]), bhi(wv[e]) * ex(G[127 * GP + k0 + 1] - G[s * GP + k0 + 1]));
            KT[k0 * PV + s] = (bf16_t)(p & 0xffffu); KT[(k0 + 1) * PV + s] = (bf16_t)(p >> 16); } }
    if (tid < 64) DEC[unit * 64 + tid] = ex(G[127 * GP + tid]);
    __syncthreads();
    const int vt = w >> 1, kt = w & 1; f32x16 acc = {};
    const MLAS bf16_t* ap = VT + (vt * 32 + r32) * PV + 8 * hi; const MLAS bf16_t* bp = KT + (kt * 32 + r32) * PV + 8 * hi;
#pragma unroll
    for (int ks = 0; ks < 8; ++ks) acc = mma32(*(const MLAS bf16x8*)(ap + 16 * ks), *(const MLAS bf16x8*)(bp + 16 * ks), acc);
#pragma unroll
    for (int r = 0; r < 16; ++r) { const int vv = vt * 32 + (r & 3) + 8 * (r >> 2) + 4 * hi; Ut[((size_t)unit * 128 + vv) * 64 + kt * 32 + r32] = acc[r]; }
    __syncthreads();
}
__device__ __forceinline__ void gla_scan(const float* Ut, const float* DEC, bf16_t* STt, int gtid, int gthreads) {
    for (int e = gtid; e < 16 * 128 * 64; e += gthreads) { const int kk = e & 63, vv = (e >> 6) & 127, bh = e >> 13, b = bh >> 2, h = bh & 3; float S = 0.f;
        float uu[32], dd[32];
#pragma unroll
        for (int n = 0; n < 32; ++n) { const int unit = (b * 32 + n) * 4 + h; uu[n] = Ut[((size_t)unit * 128 + vv) * 64 + kk]; dd[n] = DEC[unit * 64 + kk]; }
#pragma unroll
        for (int n = 0; n < 32; ++n) { const int unit = (b * 32 + n) * 4 + h; STt[((size_t)unit * 128 + vv) * 64 + kk] = f2bf(S); S = dd[n] * S + uu[n]; } }
}
__device__ __forceinline__ void gla_out_unit(MLAS unsigned char* lds, int cidx, int h, const bf16_t* Z, const float* loga, const bf16_t* STt, const float* head_g, bf16_t* MIX, int tid) {
    MLAS float* G = (MLAS float*)lds; MLAS bf16_t* AT = (MLAS bf16_t*)lds;
    MLAS float* SEG = (MLAS float*)(lds + 34816);
    MLAS bf16_t* QS = (MLAS bf16_t*)(lds + 36864); MLAS bf16_t* KS = (MLAS bf16_t*)(lds + 55296);
    MLAS bf16_t* VT = (MLAS bf16_t*)(lds + 73728);
    MLAS bf16_t* ST = (MLAS bf16_t*)(lds + 108544);
    MLAS float* RSQ = (MLAS float*)(lds + 126976);
    const int base = cidx * 128, unit = cidx * 4 + h, lane = tid & 63, w = tid >> 6, r32 = lane & 31, hi = lane >> 5;
    float la[16]; u32x4 qw[2], kw[2], vw[4], sw[2];
    gla_cumsum_ld(la, loga, base, h, tid);
#pragma unroll
    for (int j = 0; j < 2; ++j) { const int c = tid + 512 * j, s = c & 127, kc = c >> 7;
        qw[j] = *(const u32x4*)(Z + (size_t)(base + s) * ZP + 1024 + h * 64 + kc * 8); kw[j] = *(const u32x4*)(Z + (size_t)(base + s) * ZP + 1280 + h * 64 + kc * 8);
        const int c2 = tid + 512 * j, vv = c2 >> 3, kc2 = c2 & 7; sw[j] = *(const u32x4*)(STt + ((size_t)unit * 128 + vv) * 64 + kc2 * 8); }
    stage_T_ld<128>(vw, Z, ZP, base, 1536 + h * 128, tid);
    const int tt = w >> 1, t = tt * 32 + r32, vt0 = 2 * (w & 1);
    f32x4 hgv[2][4]; u32x2 sgv[2][4];
#pragma unroll
    for (int jj = 0; jj < 2; ++jj)
#pragma unroll
        for (int rq = 0; rq < 4; ++rq) { const int vv0 = (vt0 + jj) * 32 + 8 * rq + 4 * hi; hgv[jj][rq] = *(const f32x4*)(head_g + h * 128 + vv0); sgv[jj][rq] = *(const u32x2*)(Z + (size_t)(base + t) * ZP + 2048 + h * 128 + vv0); }
    stage_T_st<128>(VT, PV, vw, tid);
    gla_cumsum_st(G, SEG, la, tid);
#pragma unroll
    for (int j = 0; j < 2; ++j) { const int c = tid + 512 * j, s = c & 127, kc = c >> 7;
        const u32x4 qv = qw[j], kv = kw[j];
        u32x4 qo, ko;
#pragma unroll
        for (int e = 0; e < 4; ++e) { const int k0 = kc * 8 + 2 * e; const float d0 = G[s * GP + k0] - G[63 * GP + k0], d1 = G[s * GP + k0 + 1] - G[63 * GP + k0 + 1];
            qo[e] = pk2(blo(qv[e]) * ex(d0), bhi(qv[e]) * ex(d1)); ko[e] = pk2(blo(kv[e]) * ex(-d0), bhi(kv[e]) * ex(-d1)); }
        *(MLAS u32x4*)(QS + s * PK + kc * 8) = qo; *(MLAS u32x4*)(KS + s * PK + kc * 8) = ko; }
#pragma unroll
    for (int j = 0; j < 2; ++j) { const int c = tid + 512 * j, vv = c >> 3, kc = c & 7; const u32x4 sv = sw[j]; u32x4 so;
#pragma unroll
        for (int e = 0; e < 4; ++e) { const int k0 = kc * 8 + 2 * e; so[e] = pk2(blo(sv[e]) * ex(G[63 * GP + k0]), bhi(sv[e]) * ex(G[63 * GP + k0 + 1])); }
        *(MLAS u32x4*)(ST + vv * PK + kc * 8) = so; }
    __syncthreads();
#pragma unroll
    for (int q2 = 0; q2 < 2; ++q2) { const int st = (w & 1) + 2 * q2;
        if (st <= tt) { f32x16 acc = {}; const MLAS bf16_t* ap = KS + (st * 32 + r32) * PK + 8 * hi; const MLAS bf16_t* bp = QS + t * PK + 8 * hi;
#pragma unroll
            for (int ks = 0; ks < 4; ++ks) acc = mma32(*(const MLAS bf16x8*)(ap + 16 * ks), *(const MLAS bf16x8*)(bp + 16 * ks), acc);
#pragma unroll
            for (int rq = 0; rq < 4; ++rq) { const int s0 = st * 32 + 8 * rq + 4 * hi; float x[4];
#pragma unroll
                for (int j = 0; j < 4; ++j) x[j] = (s0 + j <= t) ? acc[4 * rq + j] : 0.f;
                u32x2 pw; pw.x = pk2(x[0], x[1]); pw.y = pk2(x[2], x[3]); *(MLAS u32x2*)(AT + t * PV + s0) = pw; } } }
    __syncthreads();
    f32x16 acc0 = {}, acc1 = {};
    { const MLAS bf16_t* bp = AT + t * PV + 8 * hi; const MLAS bf16_t* a0 = VT + (vt0 * 32 + r32) * PV + 8 * hi; const MLAS bf16_t* a1 = a0 + 32 * PV; const int nks = 2 * (tt + 1);
        for (int ks = 0; ks < nks; ++ks) { const bf16x8 b = *(const MLAS bf16x8*)(bp + 16 * ks); acc0 = mma32(*(const MLAS bf16x8*)(a0 + 16 * ks), b, acc0); acc1 = mma32(*(const MLAS bf16x8*)(a1 + 16 * ks), b, acc1); } }
    { const MLAS bf16_t* bp = QS + t * PK + 8 * hi; const MLAS bf16_t* a0 = ST + (vt0 * 32 + r32) * PK + 8 * hi; const MLAS bf16_t* a1 = a0 + 32 * PK;
#pragma unroll
        for (int ks = 0; ks < 4; ++ks) { const bf16x8 b = *(const MLAS bf16x8*)(bp + 16 * ks); acc0 = mma32(*(const MLAS bf16x8*)(a0 + 16 * ks), b, acc0); acc1 = mma32(*(const MLAS bf16x8*)(a1 + 16 * ks), b, acc1); } }
    float ss = 0.f;
#pragma unroll
    for (int r = 0; r < 16; ++r) ss += acc0[r] * acc0[r] + acc1[r] * acc1[r];
    ss += __shfl_xor(ss, 32);
    if (hi == 0) RSQ[t * 2 + (w & 1)] = ss;
    __syncthreads();
    const float rstd = __builtin_amdgcn_rsqf((RSQ[t * 2] + RSQ[t * 2 + 1]) * (1.f / 128.f) + 1e-6f);
#pragma unroll
    for (int jj = 0; jj < 2; ++jj)
#pragma unroll
        for (int rq = 0; rq < 4; ++rq) { const int vv0 = (vt0 + jj) * 32 + 8 * rq + 4 * hi;
            const f32x4 hg = hgv[jj][rq]; const u32x2 sg = sgv[jj][rq];
            float x[4];
#pragma unroll
            for (int j = 0; j < 4; ++j) x[j] = (jj == 0 ? acc0[4 * rq + j] : acc1[4 * rq + j]) * rstd * hg[j];
            u32x2 pw; pw.x = pk2(x[0] * blo(sg.x), x[1] * bhi(sg.x)); pw.y = pk2(x[2] * blo(sg.y), x[3] * bhi(sg.y));
            *(u32x2*)(MIX + (size_t)(base + t) * 1024 + 512 + h * 128 + vv0) = pw; }
    __syncthreads();
}

__device__ __forceinline__ void fgate_block(MLAS unsigned char* lds, int blk, const bf16_t* XB, const bf16_t* Wft, const float* ssq, const float* fb, float* LFC, float* BT, int tid) {
    typedef float f32x4_ __attribute__((ext_vector_type(4)));
    MLAS float* LF = (MLAS float*)lds;
    const int lane = tid & 63, w = tid >> 6, tg = w & 3, kh = w >> 2;
    { f32x4_ acc = {0.f, 0.f, 0.f, 0.f};
        const bf16_t* ap = XB + (size_t)(64 * blk + 16 * tg + (lane & 15)) * 1024 + 512 * kh + 8 * (lane >> 4); const bf16_t* bp = Wft + (size_t)(lane & 15) * 1024 + 512 * kh + 8 * (lane >> 4);
        bf16x8 av[16], bv[16];
#pragma unroll
        for (int ks = 0; ks < 16; ++ks) { av[ks] = *(const bf16x8*)(ap + 32 * ks); bv[ks] = *(const bf16x8*)(bp + 32 * ks); }
#pragma unroll
        for (int ks = 0; ks < 16; ++ks) acc = __builtin_amdgcn_mfma_f32_16x16x32_bf16(av[ks], bv[ks], acc, 0, 0, 0);
#pragma unroll
        for (int r = 0; r < 4; ++r) LF[kh * 1024 + (16 * tg + 4 * (lane >> 4) + r) * 16 + (lane & 15)] = acc[r]; }
    __syncthreads();
    for (int i = tid; i < 1024; i += 512) { const int tok = i >> 4, hh = i & 15; LF[i] = pg8::log_sigmoid_f((LF[i] + LF[1024 + i]) * pg8::row_rstd(ssq, 64 * blk + tok, 16) + fb[hh]); }
    __syncthreads();
    if (tid < 16) { const int b = blk >> 6, bl = blk & 63; float c = 0.f; float* dst = LFC + (size_t)(b * 16 + tid) * 4096 + bl * 64;
        for (int t = 0; t < 64; ++t) { c += LF[t * 16 + tid]; dst[t] = c; }
        BT[(b * 16 + tid) * 64 + bl] = c; }
    __syncthreads();
}
__device__ __forceinline__ void attn_bias(MLAS float* CB, MLAS float* OFF, int bh, const float* LFC, const float* BT, int tid) {
    if (tid < 64) { const float v = BT[bh * 64 + tid]; float x = v;
#pragma unroll
        for (int o = 1; o < 64; o <<= 1) { const float y = __shfl_up(x, o); if (tid >= o) x += y; }
        OFF[tid] = x - v; }
    __syncthreads();
    for (int s = tid; s < 4096; s += 512) CB[s] = -(LFC[(size_t)bh * 4096 + s] + OFF[s >> 6]) * L2E;
    __syncthreads();
}
}
typedef unsigned v2u __attribute__((ext_vector_type(2)));
#ifndef MK_WGM_IN0
#define MK_WGM_IN0 4
#endif
#ifndef MK_WGM_FFN1
#define MK_WGM_FFN1 4
#endif
#ifndef MK_WGM_IN1
#define MK_WGM_IN1 4
#endif
#ifndef MK_WGM_MOE1
#define MK_WGM_MOE1 4
#endif
#ifndef MK_ALIGN1
#define MK_ALIGN1 true
#endif
#ifndef MK_ALIGN
#define MK_ALIGN true
#endif
constexpr int NWAVES = 8;
constexpr int M = 16384, D = 1024, SEQ = 4096;
constexpr size_t MiB = 1u << 20, KiB = 1u << 10;
constexpr size_t WS_CTL = 0, CTL_ZERO_BYTES = 64 * KiB;
constexpr size_t WS_WE13 = 2 * MiB;
constexpr size_t WS_Y = 2 * MiB, WS_YP = 72 * MiB;
constexpr size_t WS_WE2 = 114 * MiB;
constexpr size_t WS_W0IN = 170 * MiB, WS_W0O = 176 * MiB, WS_W0F13 = 178 * MiB, WS_W0F2 = 189 * MiB, WS_W1IN = 195 * MiB, WS_W1O = 203 * MiB;
constexpr size_t WS_ACTE = 170 * MiB;
constexpr size_t WS_Z0 = 205 * MiB, WS_LOGA = 285 * MiB, WS_UT = 301 * MiB, WS_STT = 317 * MiB, WS_MIX = 325 * MiB;
constexpr size_t WS_SSQP1 = 360 * MiB, WS_SSQP2 = 361 * MiB, WS_VSTP = 362 * MiB;
constexpr size_t WS_ACT0 = 205 * MiB;
constexpr size_t WS_Q = 205 * MiB, WS_TSTRIDE = 32 * MiB;
constexpr size_t WS_TAB = 408 * MiB;
constexpr size_t TB_SSQ0 = WS_TAB, TB_DEC = WS_TAB + 64 * KiB, TB_LFC = WS_TAB + 256 * KiB, TB_BT = WS_TAB + 1280 * KiB, TB_ROWTOK = WS_TAB + 1536 * KiB, TB_ROWR = WS_TAB + 2048 * KiB,
                 TB_ROWW = WS_TAB + 2560 * KiB, TB_TOKINFO = WS_TAB + 3072 * KiB, TB_WST = WS_TAB + 3328 * KiB, TB_WFT = WS_TAB + 3456 * KiB, TB_GRH = WS_TAB + 3488 * KiB;
constexpr size_t WS_XB = 434 * MiB, WS_END = 466 * MiB;
constexpr size_t CT_BAR = 16 * KiB, CT_CNT = 48 * KiB, CT_QCTR = 52 * KiB;
constexpr int RING_BYTES = 131072, LDSCTL_OFF = RING_BYTES, MISC_OFF = LDSCTL_OFF + 320, TAB_OFF = LDSCTL_OFF + 512;
constexpr int LDS_BYTES = 147456;
constexpr int ATT_CB_OFF = 86016, ATT_OFF_OFF = 102400;

enum { IN_X = 0, IN_E_NMIX, IN_E_WIN, IN_E_GUP, IN_E_GBIAS, IN_E_WS, IN_E_BS, IN_E_LNG, IN_E_LNB, IN_E_HG, IN_E_WO, IN_E_NFFN, IN_E_W1, IN_E_W3, IN_E_W2,
       IN_O_NMIX, IN_O_WIN, IN_O_FB, IN_O_QG, IN_O_KG, IN_O_WO, IN_O_NFFN, IN_O_ROUTER, IN_O_W1, IN_O_W3, IN_O_W2, IN_FINAL, N_IN };

__device__ __forceinline__ float wave_sum(float v) {
#pragma unroll
    for (int o = 1; o < 64; o <<= 1) v += __shfl_xor(v, o);
    return v; }
template <int NB>
__device__ __forceinline__ void tr_item(const float* W, int ldw, int c0, int K, const float* gain, bf16* WT, int drow0, LAS float* scr, int kb, int lane) {
    const int k0 = 64 * kb;
    const float* wp = W + (size_t)(k0 + (lane >> 5)) * ldw + c0 + (lane & 31);
#pragma unroll
    for (int b = 0; b < 32 / NB; ++b) { float v[NB];
#pragma unroll
        for (int i = 0; i < NB; ++i) v[i] = __builtin_nontemporal_load(wp + (size_t)(2 * (b * NB + i)) * ldw);
        if (gain) {
#pragma unroll
            for (int i = 0; i < NB; ++i) v[i] *= gain[k0 + 2 * (b * NB + i) + (lane >> 5)]; }
#pragma unroll
        for (int i = 0; i < NB; ++i) scr[(2 * (b * NB + i) + (lane >> 5)) * 33 + (lane & 31)] = v[i];
        if (NB < 32) asm volatile("" ::: "memory"); }
    LDS_WAIT(); asm volatile("" ::: "memory");
    const int c = lane & 7;
#pragma unroll
    for (int j = 0; j < 4; ++j) { const int n = (lane >> 3) + 8 * j; const LAS float* s = scr + (8 * c) * 33 + n;
        v4u o; o.x = pk2(s[0 * 33], s[1 * 33]); o.y = pk2(s[2 * 33], s[3 * 33]); o.z = pk2(s[4 * 33], s[5 * 33]); o.w = pk2(s[6 * 33], s[7 * 33]);
        __builtin_nontemporal_store(o, (GAS v4u*)(WT + (size_t)(drow0 + n) * K + k0 + 8 * c)); }
    LDS_WAIT(); asm volatile("" ::: "memory");
}
enum { MAP_PLAIN = 0, MAP_GLU = 1, MAP_HEAD = 2 };
template <int MAP, int NB = 32>
__device__ __forceinline__ void tr_job(const float* W, int ldw, int c0, int ncols, int K, const float* gain, bf16* WT, int dbase, LAS float* scr, int r, int lane) {
    const int nblk = ncols / 32, kb = r / nblk, n0 = 32 * (r % nblk); int drow;
    if (MAP == MAP_PLAIN) drow = dbase + n0;
    else if (MAP == MAP_GLU) drow = dbase + (n0 >> 7) * 256 + (n0 & 127);
    else { const int head = n0 >> 6, d = n0 & 63; drow = dbase + 256 * (head >> 2) + 128 * (d >> 5) + 32 * (head & 3) + (d & 31); }
    tr_item<NB>(W, ldw, c0 + n0, K, gain, WT, drow, scr, kb, lane);
}

constexpr int MOE_IE = 1792, MOE_A_ITEMS = 8 * 2 * MOE_IE, MOE_B_ITEMS = 8 * MOE_IE;
#ifndef MK_QB0
#define MK_QB0 0
#endif
constexpr int MOE_QB0 = MK_QB0;
#ifndef MK_IDLE_ITEMS
#define MK_IDLE_ITEMS 10
#endif
constexpr int MOE_IDLE_ITEMS = MK_IDLE_ITEMS, MOE_Q_IN0 = 64 * 8 * MOE_IDLE_ITEMS, MOE_Q_FFN1 = 128 * 8 * MOE_IDLE_ITEMS;
template <int NB = 32>
__device__ __forceinline__ void moe_item_a(int r, const float* w1, const float* w3, const float* g3, bf16* WE13, LAS float* scr, int lane) {
    const int e = r / (2 * MOE_IE), q = r % (2 * MOE_IE);
    if (q < MOE_IE) tr_job<MAP_GLU, NB>(w1 + (size_t)e * 1024 * 3584, 3584, 0, 3584, 1024, g3, WE13 + (size_t)e * 7168 * 1024, 0, scr, q, lane);
    else tr_job<MAP_GLU, NB>(w3 + (size_t)e * 1024 * 3584, 3584, 0, 3584, 1024, g3, WE13 + (size_t)e * 7168 * 1024, 128, scr, q - MOE_IE, lane);
}
__device__ __forceinline__ void moe_item_b(int r, const float* w2, bf16* WE2, LAS float* scr, int lane) {
    const int e = r / MOE_IE, q = r % MOE_IE;
    tr_job<MAP_PLAIN>(w2 + (size_t)e * 3584 * 1024, 1024, 0, 1024, 3584, nullptr, WE2 + (size_t)e * 1024 * 3584, 0, scr, q, lane);
}
__device__ __forceinline__ void moe_queue_drain_b(unsigned* qctr, const float* w2, bf16* WE2, LAS float* scr, int lane) {
    for (;;) { unsigned q = 0; if (lane == 0) q = __hip_atomic_fetch_add(qctr, 4u, RLX_AGENT); q = (unsigned)__builtin_amdgcn_readfirstlane((int)q) + (unsigned)MOE_QB0;
        if ((int)q >= MOE_B_ITEMS) break;
#pragma unroll 1
        for (int j = 0; j < 4; ++j) moe_item_b((int)q + j, w2, WE2, scr, lane); }
}
#ifndef MK_ARRIVE_SYNC
#define MK_ARRIVE_SYNC 1
#endif
struct XbTicket { unsigned lead, gen, last; };
__device__ __forceinline__ void xcd_census(unsigned* bar, unsigned x, unsigned& nloc, unsigned& nx, unsigned& mask) {
    const unsigned G = gridDim.x * gridDim.y * gridDim.z;
    unsigned sum, cnt, mine, mk, sp = 0u;
    for (;;) {
        sum = 0u; cnt = 0u; mine = 0u; mk = 0u;
#pragma unroll
        for (unsigned j = 0; j < 16; ++j) { const unsigned c = xb_ld(&bar[XB_XCNT(j)]); sum += c; cnt += (c > 0u) ? 1u : 0u; mk |= (c > 0u) ? (1u << j) : 0u; mine = (j == x) ? c : mine; }
        if (sum == G) break;
        __builtin_amdgcn_s_sleep(1);
        if ((++sp & 255u) == 0u) { if (xb_ld(&bar[XB_TMO])) break; if (sp > XB_SPIN_CAP) { atomicAdd(&bar[XB_TMO], 1u); break; } }
    }
    nloc = mine > 0u ? mine : 1u; nx = cnt > 0u ? cnt : 1u; mask = mk | (1u << x);
}
__device__ __forceinline__ XbTicket xcd_barrier_arrive(const XcdBarrier& b) {
    asm volatile("s_waitcnt vmcnt(0)" ::: "memory");
    __syncthreads();
    XbTicket t; t.lead = 0u; t.gen = 0u; t.last = 0u;
    if (threadIdx.x == 0) {
        unsigned* bar = b.bar;
        __builtin_amdgcn_s_waitcnt(0);
        unsigned nloc = b.st[0], nx = b.st[1];
        if (nloc == 0u) { unsigned mk; xcd_census(bar, b.x, nloc, nx, mk); b.st[0] = nloc; b.st[1] = nx; b.st[2] = mk; }
        const unsigned old = xb_add(&bar[XB_XSUB(b.x)], 1u);
        t.gen = old / nloc;
        if (old + 1u == (t.gen + 1u) * nloc) {
            t.lead = 1u;
            __builtin_amdgcn_fence(__ATOMIC_RELEASE, "agent");
            asm volatile("s_waitcnt vmcnt(0)" ::: "memory");
            const unsigned og = xb_add(&bar[XB_TOP], 1u);
            const unsigned tg = og / nx;
            if (og + 1u == (tg + 1u) * nx) {
                t.last = 1u; const unsigned mk = b.st[2];
#pragma unroll
                for (unsigned j = 0; j < 16; ++j) if ((mk >> j) & 1u) xb_add(&bar[XB_XGEN(j)], 1u);
            }
        }
    }
    if (MK_ARRIVE_SYNC) __syncthreads();
    return t;
}
__device__ __forceinline__ void xcd_barrier_wait(const XcdBarrier& b, const XbTicket& t) {
    if (threadIdx.x == 0) {
        unsigned* bar = b.bar;
        if (!(t.lead && t.last)) XB_SPIN(xb_ld(&bar[XB_XGEN(b.x)]) == t.gen, bar);
        __builtin_amdgcn_fence(__ATOMIC_ACQUIRE, "agent");
        asm volatile("s_waitcnt vmcnt(0)" ::: "memory");
    }
    __syncthreads();
}
struct Args { const float* in[N_IN]; float* out; unsigned char* ws; int ph_lo, ph_hi, flags, pad; };
enum { PH_PRO = 0, PH_IN0, PH_MIXA, PH_SCAN, PH_GLAO, PH_OUT0, PH_FFN1, PH_FFN2, PH_IN1, PH_ATTN, PH_OUT1, PH_ROUTE, PH_MOE1, PH_MOE2, PH_FINAL, N_PHASES };

__global__ void __launch_bounds__(NWAVES * 64, 2) mk_fwd(Args args) {
    extern __shared__ __attribute__((aligned(16))) unsigned char lds_raw[];
    LAS unsigned char* lds = (LAS unsigned char*)lds_raw;
    volatile LAS unsigned* MISC = (volatile LAS unsigned*)(lds + MISC_OFF);
    LAS int* TAB = (LAS int*)(lds + TAB_OFF); LAS float* RSB = (LAS float*)(lds + LDSCTL_OFF + 1024);
    const int tid = threadIdx.x, lane = tid & 63, wave = __builtin_amdgcn_readfirstlane(tid >> 6);
    const int G = gridDim.x, bx = blockIdx.x, vcu = (G % 8 == 0) ? (bx % 8) * (G / 8) + bx / 8 : bx;
    unsigned char* ws = args.ws;
    gu32* ctl = (gu32*)(ws + WS_CTL);
    for (int u = tid; u < (LDS_BYTES - LDSCTL_OFF) / 4; u += NWAVES * 64) ((LAS unsigned*)(lds + LDSCTL_OFF))[u] = 0u;
    __syncthreads();
    XcdBarrier bar = xcd_barrier_post((unsigned*)(ws + CT_BAR), MISC + 8);
    const int lo = args.ph_lo, hi = args.ph_hi;
#define IN(k) (lo <= (k) && (k) < hi)
#ifndef MK_SEAM_REP
#define MK_SEAM_REP 1
#endif
#ifndef MK_SHADOW_NB
#define MK_SHADOW_NB 16
#endif
#ifndef MK_SHADOW
#define MK_SHADOW 1
#endif
#define SEAM(k) do { if (IN(k) && IN((k) + 1)) { for (int sr_ = 0; sr_ < MK_SEAM_REP; ++sr_) { const XbTicket tk_ = xcd_barrier_arrive(bar); \
        if (SHADOWS_ON && ((k) == PH_MIXA || (k) == PH_SCAN)) {     \
            const int u_ = vcu + 256 * ((k) - PH_MIXA); mx::gmlp_unit(lds, u_ >> 2, u_ & 3, Z0, VSTAT, args.in[IN_E_LNG], args.in[IN_E_LNB], WST, args.in[IN_E_BS], MIX, tid); } \
        else if (SHADOWS_ON && (k) <= 10 && wave >= 8 - MK_SHADOW_W) { const int it_ = NPRO + ((k) < PH_MIXA ? (k) : (k) - 2) * SHADOW_WAVES + vcu * MK_SHADOW_W + (wave - (8 - MK_SHADOW_W)); if (it_ < NITEMS) { CONV_ITEM(it_, MK_SHADOW_NB); } } \
        xcd_barrier_wait(bar, tk_); } } } while (0)
#ifndef MK_REP
#define MK_REP 0
#endif
#define REPS(k) for (int rep_ = 0; rep_ <= ((MK_REP >> (k)) & 1); ++rep_)
#ifdef MK_EXPERIMENT
#define FL(k) ((((args.flags >> 8) == 0) || (((args.flags >> 8) >> (k)) & 1)) ? (args.flags & 0xff) : 0)
#else
#define FL(k) 0
#endif
    bf16* WE13 = (bf16*)(ws + WS_WE13); bf16* WE2 = (bf16*)(ws + WS_WE2); bf16* W0IN = (bf16*)(ws + WS_W0IN); bf16* W0O = (bf16*)(ws + WS_W0O); bf16* W0F13 = (bf16*)(ws + WS_W0F13);
    bf16* W0F2 = (bf16*)(ws + WS_W0F2); bf16* W1IN = (bf16*)(ws + WS_W1IN); bf16* W1O = (bf16*)(ws + WS_W1O); bf16* WST = (bf16*)(ws + TB_WST); bf16* WFT = (bf16*)(ws + TB_WFT); bf16* GRH = (bf16*)(ws + TB_GRH);
    bf16* XB = (bf16*)(ws + WS_XB); bf16* Z0 = (bf16*)(ws + WS_Z0); float* LOGA = (float*)(ws + WS_LOGA); float* UT = (float*)(ws + WS_UT); bf16* STT = (bf16*)(ws + WS_STT);
    bf16* MIX = (bf16*)(ws + WS_MIX); bf16* ACT0 = (bf16*)(ws + WS_ACT0); bf16* QB = (bf16*)(ws + WS_Q); bf16* ACTE = (bf16*)(ws + WS_ACTE); bf16* YB = (bf16*)(ws + WS_Y); bf16* YP = (bf16*)(ws + WS_YP);
    float* SSQ0 = (float*)(ws + TB_SSQ0); float* SSQ1 = (float*)(ws + WS_SSQP1); float* SSQ2 = (float*)(ws + WS_SSQP2); float* VSTAT = (float*)(ws + WS_VSTP); float* DEC = (float*)(ws + TB_DEC);
    float* LFC = (float*)(ws + TB_LFC); float* BT = (float*)(ws + TB_BT); int* ROWTOK = (int*)(ws + TB_ROWTOK); float* ROWR = (float*)(ws + TB_ROWR); float* ROWW = (float*)(ws + TB_ROWW);
    int* TOKINFO = (int*)(ws + TB_TOKINFO); int* CNT = (int*)(ws + CT_CNT);
    float* X = args.out;
    const int gw = vcu * NWAVES + wave, NGW = G * NWAVES;
    LAS float* scr = (LAS float*)(lds + wave * 16384);
    const float* g0 = args.in[IN_E_NMIX]; const float* g1 = args.in[IN_E_NFFN]; const float* g2 = args.in[IN_O_NMIX]; const float* g3 = args.in[IN_O_NFFN];
    constexpr int I0 = 768, I1 = 256, I2 = 256, I3 = 512, I4 = 1408, I5 = 1408, I6 = 1408, I7 = 2048, I8 = 512, IE = 1792;
    constexpr int NSMALL = I0 + I1 + I2 + I3 + I4 + I5 + I6 + I7 + I8; static_assert(IE == MOE_IE, "");
    const int NA = (G == 256 ? MOE_A_ITEMS - MOE_Q_IN0 - MOE_Q_FFN1 : MOE_A_ITEMS); const int NITEMS = NSMALL + NA + MOE_QB0;
#ifndef MK_NSHADOW
#define MK_NSHADOW 9
#endif
#ifndef MK_SHADOW_W
#define MK_SHADOW_W 8
#endif
    constexpr int SHADOW_WAVES = MK_SHADOW_W * 256, NPRO = NSMALL + (MOE_A_ITEMS - MOE_Q_IN0 - MOE_Q_FFN1) + MOE_QB0 - MK_NSHADOW * SHADOW_WAVES;
    static_assert(NPRO >= I0 + I1 + I2 && MK_NSHADOW == 9 && (NPRO <= I0 + I1 + I2 + I3 + I4 + I5 || NPRO >= NSMALL), "shadow plan: W0IN and W0O stay in the prologue; the deferred list starts inside W0F13 (first use: phase 6, converted in shadows 0-1)");
    const bool SHADOWS_ON = MK_SHADOW && G == 256;
#define CONV_ITEM(it__, NB_) do { int r = (it__); \
        if (r < I0) { tr_job<MAP_PLAIN, NB_>(args.in[IN_E_WIN], 2576, 0, 1536, 1024, g0, W0IN, 0, scr, r, lane); break; } r -= I0; \
        if (r < I1) { tr_job<MAP_PLAIN, NB_>(args.in[IN_E_WIN], 2576, 1552, 512, 1024, g0, W0IN, 1792, scr, r, lane); break; } r -= I1; \
        if (r < I2) { tr_job<MAP_PLAIN, NB_>(args.in[IN_E_WIN], 2576, 2064, 512, 1024, g0, W0IN, 2304, scr, r, lane); break; } r -= I2; \
        if (r < I3) { tr_job<MAP_PLAIN, NB_>(args.in[IN_E_WO], 1024, 0, 1024, 1024, nullptr, W0O, 0, scr, r, lane); break; } r -= I3; \
        if (r < I4) { tr_job<MAP_GLU, NB_>(args.in[IN_E_W1], 2816, 0, 2816, 1024, g1, W0F13, 0, scr, r, lane); break; } r -= I4; \
        if (r < I5) { tr_job<MAP_GLU, NB_>(args.in[IN_E_W3], 2816, 0, 2816, 1024, g1, W0F13, 128, scr, r, lane); break; } r -= I5; \
        if (r < I6) { tr_job<MAP_PLAIN, NB_>(args.in[IN_E_W2], 1024, 0, 1024, 2816, nullptr, W0F2, 0, scr, r, lane); break; } r -= I6; \
        if (r < I7) { const int wh = r >> 9; tr_job<MAP_HEAD, NB_>(args.in[IN_O_WIN], 4112, 1024 * wh, 1024, 1024, g2, W1IN, 1024 * wh, scr, r & 511, lane); break; } r -= I7; \
        if (r < I8) { tr_job<MAP_PLAIN, NB_>(args.in[IN_O_WO], 1024, 0, 1024, 1024, nullptr, W1O, 0, scr, r, lane); break; } r -= I8; \
        if (r < NA) moe_item_a<NB_>(r, args.in[IN_O_W1], args.in[IN_O_W3], g3, WE13, scr, lane); else moe_item_b(r - NA, args.in[IN_O_W2], WE2, scr, lane); } while (0)

    if (IN(PH_PRO)) REPS(PH_PRO) {
        for (int it = gw; it < (SHADOWS_ON ? NPRO : NITEMS); it += NGW) { CONV_ITEM(it, 32); }
        const int gt = vcu * (NWAVES * 64) + tid, NGT = G * NWAVES * 64;
        for (int i = gt; i < 256 * 128; i += NGT) { const int c = i >> 7, k0 = (i & 127) * 8; float gu[16];
#pragma unroll
            for (int r = 0; r < 16; ++r) gu[r] = args.in[IN_E_GUP][r * 256 + c];
            float o[8];
#pragma unroll
            for (int kk = 0; kk < 8; ++kk) { const float* wr_ = args.in[IN_E_WIN] + (size_t)(k0 + kk) * 2576 + 1536; float a = 0.f;
#pragma unroll
                for (int r = 0; r < 16; ++r) a += wr_[r] * gu[r];
                o[kk] = a * g0[k0 + kk]; }
            v4u w; w.x = pk2(o[0], o[1]); w.y = pk2(o[2], o[3]); w.z = pk2(o[4], o[5]); w.w = pk2(o[6], o[7]);
            *(GAS v4u*)(W0IN + (size_t)(1536 + c) * 1024 + k0) = w; }
        for (int i = gt; i < 16 * 1024; i += NGT) { const int h = i >> 10, k = i & 1023; WFT[i] = (bf16)f2bf(g2[k] * args.in[IN_O_WIN][(size_t)k * 4112 + 4096 + h]); }
        for (int i = gt; i < 8 * 1024; i += NGT) { const int e = i >> 10, k = i & 1023; const float w = g3[k] * args.in[IN_O_ROUTER][k * 8 + e]; const unsigned hi = f2bf(w);
            GRH[e * 1024 + k] = (bf16)hi; GRH[(8 + e) * 1024 + k] = (bf16)f2bf(w - __uint_as_float(hi << 16)); }
        for (int i = gt; i < 4 * 128 * 128; i += NGT) { const int t = (i >> 7) & 127, s = i & 127; WST[i] = (bf16)f2bf(s <= t ? args.in[IN_E_WS][i] : 0.f); }
        for (int m = gw; m < M; m += NGW) { const GAS f32x4* xr = (const GAS f32x4*)(args.in[IN_X] + (size_t)m * D) + lane; f32x4 v[4]; float s = 0.f;
#pragma unroll
            for (int j = 0; j < 4; ++j) { v[j] = xr[64 * j]; s += (v[j].x * v[j].x + v[j].y * v[j].y) + (v[j].z * v[j].z + v[j].w * v[j].w); }
            s = wave_sum(s); if (lane == 0) SSQ0[m] = s;
            GAS unsigned long long* o8 = (GAS unsigned long long*)(XB + (size_t)m * D) + lane;
#pragma unroll
            for (int j = 0; j < 4; ++j) o8[64 * j] = (unsigned long long)pk2(v[j].x, v[j].y) | ((unsigned long long)pk2(v[j].z, v[j].w) << 32); }
    }
    SEAM(PH_PRO);
    if (IN(PH_IN0)) REPS(PH_IN0) {
        pg8::Gemm g{XB, W0IN, 1024, nullptr, FL(PH_IN0)}; pg8::StaticOrder S; S.init(M, 2816, G, bx, MK_WGM_IN0);
        pg8::EpiEvenIn E{Z0, LOGA, VSTAT, SSQ0, args.in[IN_E_GBIAS], FL(PH_IN0)};
        pg8::gemm_phase<pg8::EpiEvenIn, pg8::StaticOrder, MK_ALIGN>(lds, RSB, g, S, E);
        if (G == 256 && bx >= 192) {
            LAS float* scr = (LAS float*)(lds + wave * 16384); const int q0 = MOE_A_ITEMS - MOE_Q_IN0 - MOE_Q_FFN1 + ((bx - 192) * NWAVES + wave) * MOE_IDLE_ITEMS;
            for (int j = 0; j < MOE_IDLE_ITEMS; ++j) moe_item_a(q0 + j, args.in[IN_O_W1], args.in[IN_O_W3], args.in[IN_O_NFFN], WE13, scr, lane); }
    }
    SEAM(PH_IN0);
    if (IN(PH_MIXA)) REPS(PH_MIXA) {
        for (int u = vcu + (SHADOWS_ON ? 512 : 0); u < 1024; u += G) {
            if (u < 512) mx::gmlp_unit(lds, u >> 2, u & 3, Z0, VSTAT, args.in[IN_E_LNG], args.in[IN_E_LNB], WST, args.in[IN_E_BS], MIX, tid);
            else mx::gla_u_unit(lds, (u - 512) >> 2, u & 3, Z0, LOGA, UT, DEC, tid);
        }
    }
    SEAM(PH_MIXA);
    if (IN(PH_SCAN)) REPS(PH_SCAN) mx::gla_scan(UT, DEC, STT, vcu * (NWAVES * 64) + tid, G * NWAVES * 64);
    SEAM(PH_SCAN);
    if (IN(PH_GLAO)) REPS(PH_GLAO) { for (int u = vcu; u < 512; u += G) mx::gla_out_unit(lds, u >> 2, u & 3, Z0, LOGA, STT, args.in[IN_E_HG], MIX, tid); }
    SEAM(PH_GLAO);
    if (IN(PH_OUT0)) REPS(PH_OUT0) {
        pg8::Gemm g{MIX, W0O, 1024, nullptr, FL(PH_OUT0)}; pg8::StaticOrder S; S.init(M, 1024, G, bx);
        pg8::EpiResid E{args.in[IN_X], XB, SSQ1, FL(PH_OUT0)};
        pg8::gemm_phase<pg8::EpiResid, pg8::StaticOrder, MK_ALIGN1>(lds, RSB, g, S, E);
    }
    SEAM(PH_OUT0);
    if (IN(PH_FFN1)) REPS(PH_FFN1) {
        pg8::Gemm g{XB, W0F13, 1024, nullptr, FL(PH_FFN1)}; pg8::StaticOrder S; S.init(M, 5632, G, bx, MK_WGM_FFN1);
        pg8::EpiSwiglu<false> E{ACT0, 2816, SSQ1, nullptr, nullptr, FL(PH_FFN1)};
        pg8::gemm_phase<pg8::EpiSwiglu<false>, pg8::StaticOrder, MK_ALIGN>(lds, RSB, g, S, E);
        if (G == 256 && bx >= 128) {
            LAS float* scr = (LAS float*)(lds + wave * 16384); const int q0 = MOE_A_ITEMS - MOE_Q_FFN1 + ((bx - 128) * NWAVES + wave) * MOE_IDLE_ITEMS;
            for (int j = 0; j < MOE_IDLE_ITEMS; ++j) moe_item_a(q0 + j, args.in[IN_O_W1], args.in[IN_O_W3], args.in[IN_O_NFFN], WE13, scr, lane); }
    }
    SEAM(PH_FFN1);
    if (IN(PH_FFN2)) {
        pg8::Gemm g{ACT0, W0F2, 2816, nullptr, FL(PH_FFN2)}; pg8::StaticOrder S; S.init(M, 1024, G, bx);
        pg8::EpiResid E{nullptr, XB, SSQ2, FL(PH_FFN2)};
        pg8::gemm_phase<pg8::EpiResid, pg8::StaticOrder, MK_ALIGN1>(lds, RSB, g, S, E);
    }
    SEAM(PH_FFN2);
    if (IN(PH_IN1)) REPS(PH_IN1) {
        for (int blk = vcu; blk < 256; blk += G) mx::fgate_block(lds, blk, XB, WFT, SSQ2, args.in[IN_O_FB], LFC, BT, tid);
        pg8::Gemm g{XB, W1IN, 1024, nullptr, FL(PH_IN1)}; pg8::StaticOrder S; S.init(M, 4096, G, bx, MK_WGM_IN1);
        pg8::EpiOddIn E{QB, (size_t)WS_TSTRIDE / 2, SSQ2, args.in[IN_O_QG], args.in[IN_O_KG], attn_body::C2, FL(PH_IN1)};
        pg8::gemm_phase<pg8::EpiOddIn, pg8::StaticOrder, MK_ALIGN>(lds, RSB, g, S, E);
    }
    SEAM(PH_IN1);
    if (IN(PH_ATTN)) REPS(PH_ATTN) {
        static_assert(attn_body::ATTN_LDS_BYTES <= ATT_CB_OFF && ATT_OFF_OFF + 256 <= RING_BYTES, "attention LDS map");
        LAS float* CB = (LAS float*)(lds + ATT_CB_OFF); LAS float* OFF = (LAS float*)(lds + ATT_OFF_OFF);
        if (G == 256) {
            mx::attn_bias(CB, OFF, vcu >> 2, LFC, BT, tid);
            const attn_body::AttnTensors AT{(const attn_body::bf16*)QB, (const attn_body::bf16*)(QB + WS_TSTRIDE / 2), (const attn_body::bf16*)(QB + WS_TSTRIDE), (attn_body::bf16*)QB,
                                            (const attn_body::bf16*)(QB + 3 * (WS_TSTRIDE / 2))};
            const attn_body::StaticOrder S(vcu);
            float gq = fabsf(args.in[IN_O_QG][lane]), gk = fabsf(args.in[IN_O_KG][lane]);
#pragma unroll
            for (int o = 1; o < 64; o <<= 1) { gq = fmaxf(gq, __shfl_xor(gq, o)); gk = fmaxf(gk, __shfl_xor(gk, o)); }
            const float Bq = 1.02f * 64.f * attn_body::C2 * gq * gk;
#ifndef MK_ATTN_SKIP
#define MK_ATTN_SKIP 40.f
#endif
            attn_body::attn_phase<attn_body::StaticOrder>((char*)lds_raw, (attn_body::lds_fptr)CB, -(MK_ATTN_SKIP) - 2.f * Bq, AT, S);
        }
    }
    SEAM(PH_ATTN);
    if (IN(PH_OUT1)) {
        pg8::Gemm g{QB, W1O, 1024, nullptr, FL(PH_OUT1)}; pg8::StaticOrder S; S.init(M, 1024, G, bx);
        pg8::EpiResid E{nullptr, XB, SSQ1, FL(PH_OUT1)};
        pg8::gemm_phase<pg8::EpiResid, pg8::StaticOrder, MK_ALIGN1>(lds, RSB, g, S, E);
    }
    SEAM(PH_OUT1);
    if (IN(PH_ROUTE)) {
        typedef float f32x4r __attribute__((ext_vector_type(4)));
        LAS float* LG = (LAS float*)lds;
        LAS int* TI = (LAS int*)(lds + 32768);
        LAS float* TF = (LAS float*)(lds + 32768);
        for (int blk = vcu; blk < M / 64; blk += G) {
            if (tid < 8) TI[448 + tid] = 0;
            { const int tg = wave & 3, kh = wave >> 2; f32x4r acc = {0.f, 0.f, 0.f, 0.f};
                const bf16* ap = XB + (size_t)(64 * blk + 16 * tg + (lane & 15)) * 1024 + 512 * kh + 8 * (lane >> 4); const bf16* bp = GRH + (size_t)(lane & 15) * 1024 + 512 * kh + 8 * (lane >> 4);
                bf16x8 av[16], bv[16];
#pragma unroll
                for (int ks = 0; ks < 16; ++ks) { av[ks] = *(const bf16x8*)(ap + 32 * ks); bv[ks] = *(const bf16x8*)(bp + 32 * ks); }
#pragma unroll
                for (int ks = 0; ks < 16; ++ks) acc = __builtin_amdgcn_mfma_f32_16x16x32_bf16(av[ks], bv[ks], acc, 0, 0, 0);
#pragma unroll
                for (int r = 0; r < 4; ++r) LG[kh * 1024 + (16 * tg + 4 * (lane >> 4) + r) * 16 + (lane & 15)] = acc[r]; }
            __syncthreads();
            if (tid < 64) { const int slot = tid, tok = 64 * blk + slot; float lg[8];
#pragma unroll
                for (int e = 0; e < 8; ++e) lg[e] = (LG[slot * 16 + e] + LG[1024 + slot * 16 + e]) + (LG[slot * 16 + 8 + e] + LG[1024 + slot * 16 + 8 + e]);
                const float r = pg8::row_rstd(SSQ1, tok, 16);
                int i0 = 0; float v0 = lg[0];
#pragma unroll
                for (int e = 1; e < 8; ++e) if (lg[e] > v0) { v0 = lg[e]; i0 = e; }
                int i1 = -1; float v1 = -INFINITY;
#pragma unroll
                for (int e = 0; e < 8; ++e) if (e != i0 && lg[e] > v1) { v1 = lg[e]; i1 = e; }
                const float e1 = expf((v1 - v0) * r), w0 = 1.f / (1.f + e1), w1 = e1 / (1.f + e1);
                TI[slot] = i0; TI[64 + slot] = i1;
                TI[128 + slot] = (int)__hip_atomic_fetch_add((LAS unsigned*)TI + 448 + i0, 1u, __ATOMIC_RELAXED, __HIP_MEMORY_SCOPE_WORKGROUP);
                TI[192 + slot] = (int)__hip_atomic_fetch_add((LAS unsigned*)TI + 448 + i1, 1u, __ATOMIC_RELAXED, __HIP_MEMORY_SCOPE_WORKGROUP);
                TF[256 + slot] = w0; TF[320 + slot] = w1; TF[384 + slot] = r; }
            __syncthreads();
            if (tid < 8) TI[456 + tid] = (int)__hip_atomic_fetch_add((unsigned*)CNT + 64 * tid, (unsigned)TI[448 + tid], RLX_AGENT);
            __syncthreads();
            if (tid < 64) { const int tok = 64 * blk + tid, i0 = TI[tid], i1 = TI[64 + tid], p0 = TI[456 + i0] + TI[128 + tid], p1 = TI[456 + i1] + TI[192 + tid]; const float r = TF[384 + tid];
                ROWTOK[i0 * M + p0] = tok; ROWR[i0 * M + p0] = r; ROWW[i0 * M + p0] = TF[256 + tid];
                ROWTOK[i1 * M + p1] = tok; ROWR[i1 * M + p1] = r; ROWW[i1 * M + p1] = TF[320 + tid];
                *(int4*)(TOKINFO + 4 * (size_t)tok) = make_int4(i0, p0, i1, p1); }
            __syncthreads();
        }
    }
    SEAM(PH_ROUTE);
    if (IN(PH_MOE1) || IN(PH_MOE2) || IN(PH_FINAL)) {
        if (tid == 0) { int off = 0;
#pragma unroll
            for (int e = 0; e < 8; ++e) { const int c = (int)__hip_atomic_load((unsigned*)CNT + 64 * e, RLX_AGENT); TAB[e] = off; TAB[16 + e] = c; off += (c + 255) >> 8; }
            TAB[8] = off; }
        __syncthreads();
    }
    if (IN(PH_MOE1)) REPS(PH_MOE1) {
        const int nun = 28 * TAB[8], R = (nun + G - 1) / G, Ge = R > 0 ? (nun + R - 1) / R : G;
        pg8::Gemm g{XB, WE13, 1024, ROWTOK, FL(PH_MOE1)}; pg8::MoeOrder<true> S; S.init(TAB, 28, Ge, bx, MK_WGM_MOE1);
        pg8::EpiSwiglu<true> E{ACTE, 3584, nullptr, ROWR, ROWW, FL(PH_MOE1)};
        if (bx < Ge) pg8::gemm_phase<pg8::EpiSwiglu<true>, pg8::MoeOrder<true>, MK_ALIGN>(lds, RSB, g, S, E);
        moe_queue_drain_b((unsigned*)(ws + CT_QCTR), args.in[IN_O_W2], WE2, (LAS float*)(lds + wave * 16384), lane);
    }
    SEAM(PH_MOE1);
    if (IN(PH_MOE2)) REPS(PH_MOE2) {
        pg8::Gemm g{ACTE, WE2, 3584, nullptr, FL(PH_MOE2)}; pg8::Moe2Order S; S.init(TAB, G, bx);
        const int nsp2 = pg8::Moe2Order::split_tiles(S.T); pg8::EpiBf16 E{YB, 1024, args.flags, YP, (size_t)nsp2 * 256 * 1024, S.T - nsp2};
        pg8::gemm_phase<pg8::EpiBf16, pg8::Moe2Order, MK_ALIGN>(lds, RSB, g, S, E);
    }
    SEAM(PH_MOE2);
    if (IN(PH_FINAL)) {
        for (int tok = gw; tok < M; tok += NGW) {
            const int4 ti = *(const int4*)(TOKINFO + 4 * (size_t)tok);
            const size_t r0 = (size_t)TAB[ti.x] * 256 + ti.y, r1 = (size_t)TAB[ti.z] * 256 + ti.w;
            const int nsp = pg8::Moe2Order::split_tiles(TAB[8]), nsl = pg8::Moe2Order::slices(nsp); const size_t rsplit = (size_t)(TAB[8] - nsp) * 256, pstr = (size_t)nsp * 256 * 1024;
            GAS f32x4* xr = (GAS f32x4*)(X + (size_t)tok * D) + lane; const GAS v2u* xbr = (const GAS v2u*)(XB + (size_t)tok * D) + lane; const GAS v2u* y0 = (const GAS v2u*)(YB + r0 * D) + lane; const GAS v2u* y1 = (const GAS v2u*)(YB + r1 * D) + lane;
            f32x4 v[4]; float ss = 0.f;
#pragma unroll
            for (int j = 0; j < 4; ++j) { const v2u xw = xbr[64 * j]; v[j] = (f32x4){__uint_as_float(xw.x << 16), __uint_as_float(xw.x & 0xffff0000u), __uint_as_float(xw.y << 16), __uint_as_float(xw.y & 0xffff0000u)};
                v2u a = {0u, 0u}, b = {0u, 0u}; if (r0 < rsplit) a = y0[64 * j]; if (r1 < rsplit) b = y1[64 * j];
                v[j].x += __uint_as_float(a.x << 16) + __uint_as_float(b.x << 16); v[j].y += __uint_as_float(a.x & 0xffff0000u) + __uint_as_float(b.x & 0xffff0000u);
                v[j].z += __uint_as_float(a.y << 16) + __uint_as_float(b.y << 16); v[j].w += __uint_as_float(a.y & 0xffff0000u) + __uint_as_float(b.y & 0xffff0000u);
                }
            if (r0 >= rsplit || r1 >= rsplit) {
                for (int k = 0; k < nsl; ++k) {
#pragma unroll
                    for (int j = 0; j < 4; ++j) { v2u a = {0u, 0u}, b = {0u, 0u};
                        if (r0 >= rsplit) a = ((const GAS v2u*)(YP + (size_t)k * pstr + (r0 - rsplit) * D) + lane)[64 * j];
                        if (r1 >= rsplit) b = ((const GAS v2u*)(YP + (size_t)k * pstr + (r1 - rsplit) * D) + lane)[64 * j];
                        v[j].x += __uint_as_float(a.x << 16) + __uint_as_float(b.x << 16); v[j].y += __uint_as_float(a.x & 0xffff0000u) + __uint_as_float(b.x & 0xffff0000u);
                        v[j].z += __uint_as_float(a.y << 16) + __uint_as_float(b.y << 16); v[j].w += __uint_as_float(a.y & 0xffff0000u) + __uint_as_float(b.y & 0xffff0000u); } } }
#pragma unroll
            for (int j = 0; j < 4; ++j) ss += (v[j].x * v[j].x + v[j].y * v[j].y) + (v[j].z * v[j].z + v[j].w * v[j].w);
            ss = wave_sum(ss); const float r = 1.0f / sqrtf(ss * (1.f / 1024.f) + 1e-6f);
#pragma unroll
            for (int j = 0; j < 4; ++j) { const f32x4 gf = *((const GAS f32x4*)args.in[IN_FINAL] + lane + 64 * j); xr[64 * j] = v[j] * r * gf; }
        }
    }
#undef IN
#undef SEAM
}
#ifndef MK_PER_PHASE
#define MK_PER_PHASE 0
#endif
#ifndef MK_PH_END
#define MK_PH_END N_PHASES
#endif
static int mk_setup() {
    static int grid = 0;
    if (grid == 0) {
        int dev = 0, cus = 0, per_cu = 0;
        if (hipGetDevice(&dev) != hipSuccess || hipDeviceGetAttribute(&cus, hipDeviceAttributeMultiprocessorCount, dev) != hipSuccess) { fprintf(stderr, "kernel_launch: device query failed\n"); grid = -1; return grid; }
        if (hipFuncSetAttribute((const void*)mk_fwd, hipFuncAttributeMaxDynamicSharedMemorySize, LDS_BYTES) != hipSuccess) { fprintf(stderr, "kernel_launch: hipFuncSetAttribute failed\n"); grid = -1; return grid; }
        if (hipOccupancyMaxActiveBlocksPerMultiprocessor(&per_cu, (const void*)mk_fwd, NWAVES * 64, LDS_BYTES) != hipSuccess || per_cu < 1) { fprintf(stderr, "kernel_launch: occupancy query says %d blocks/CU\n", per_cu); }
        (void)hipGetLastError();
        grid = cus;
        if (grid != 256) fprintf(stderr, "kernel_launch: %d CUs; this kernel is built for 256\n", grid);
    }
    return grid;
}
static void mk_run(void* const* d_in, float* out, unsigned char* ws, hipStream_t stream, int ph_end, int flags = 0) {
    const int grid = mk_setup(); if (grid <= 0) return;
    (void)hipMemsetAsync(ws + WS_CTL, 0, CTL_ZERO_BYTES, stream);
    Args a{};
    for (int i = 0; i < N_IN; ++i) a.in[i] = (const float*)d_in[i];
    a.out = out; a.ws = ws; a.flags = flags;
#if MK_PER_PHASE
    for (int p = 0; p < ph_end; ++p) { a.ph_lo = p; a.ph_hi = p + 1; hipLaunchKernelGGL(mk_fwd, dim3(grid), dim3(NWAVES * 64), LDS_BYTES, stream, a); }
#else
    a.ph_lo = 0; a.ph_hi = ph_end; hipLaunchKernelGGL(mk_fwd, dim3(grid), dim3(NWAVES * 64), LDS_BYTES, stream, a);
#endif
}
#ifndef MK_DEBUG
extern "C" void kernel_launch(void* const* d_in, const int* in_sizes, int n_in, void* d_out, int out_size, void* d_ws, size_t ws_size, hipStream_t stream) {
    if (n_in != N_IN || out_size != M * D || ws_size < WS_END) { fprintf(stderr, "kernel_launch: unexpected shapes n_in %d out %d ws %zu\n", n_in, out_size, ws_size); return; }
#ifdef MK_PREFIX
#ifndef MK_PREFIX_FLAGS
#define MK_PREFIX_FLAGS 0
#endif
    mk_run(d_in, (float*)d_out, (unsigned char*)d_ws, stream, MK_PREFIX + 1, MK_PREFIX_FLAGS);
#endif
    mk_run(d_in, (float*)d_out, (unsigned char*)d_ws, stream, N_PHASES);
}
#endif
```

```cpp
#include <hip/hip_runtime.h>
#include <cstdio>
#include <cstdint>
#include <cmath>
#define GAS __attribute__((address_space(1)))
#define LAS __attribute__((address_space(3)))
typedef unsigned short bf16;
typedef unsigned v4u __attribute__((ext_vector_type(4)));
typedef float f32x4 __attribute__((ext_vector_type(4)));
typedef short bf16x8 __attribute__((ext_vector_type(8)));
typedef GAS unsigned gu32;
typedef GAS unsigned long long gu64;
#define RLX_AGENT __ATOMIC_RELAXED, __HIP_MEMORY_SCOPE_AGENT
#define LDS_WAIT() asm volatile("s_waitcnt lgkmcnt(0)" ::: "memory")
#define VM_WAIT() asm volatile("s_waitcnt vmcnt(0)" ::: "memory")
__device__ __forceinline__ unsigned long long rt() { return __builtin_amdgcn_s_memrealtime(); }
__device__ __forceinline__ unsigned f2bf(float f) { unsigned u = __builtin_bit_cast(unsigned, f); return (u + 0x7fffu + ((u >> 16) & 1u)) >> 16; }
__device__ __forceinline__ unsigned pk2(float lo, float hi) { return f2bf(lo) | (f2bf(hi) << 16); }

#define XB_TMO      128
#define XB_XCNT(j)  (256  + 64 * (j))
#define XB_XSUB(j)  (1280 + 64 * (j))
#define XB_XGEN(j)  (2304 + 64 * (j))
#define XB_TOP      3328
#define XB_TOPGEN   3392
#define XCD_BAR_WORDS 3456
#define XB_SPIN_CAP (1u << 18)

__device__ __forceinline__ unsigned xb_ld(unsigned* p)              { return __hip_atomic_load(p, __ATOMIC_RELAXED, __HIP_MEMORY_SCOPE_AGENT); }
__device__ __forceinline__ unsigned xb_add(unsigned* p, unsigned v) { return __hip_atomic_fetch_add(p, v, __ATOMIC_RELAXED, __HIP_MEMORY_SCOPE_AGENT); }
__device__ __forceinline__ unsigned xb_xcc_id() { return (unsigned)__builtin_amdgcn_s_getreg((3 << 11) | 20) & 0xFu; }
#define XB_SPIN(cond, bar) do { unsigned _sp = 0; while (cond) { __builtin_amdgcn_s_sleep(1); \
    if ((++_sp & 255u) == 0u) { if (xb_ld(&(bar)[XB_TMO])) break; if (_sp > XB_SPIN_CAP) { atomicAdd(&(bar)[XB_TMO], 1u); break; } } } } while (0)

struct XcdBarrier {
    unsigned* bar; unsigned x;
    volatile LAS unsigned* st;
};

__device__ __forceinline__ XcdBarrier xcd_barrier_post(unsigned* bar, volatile LAS unsigned* st) {
    XcdBarrier b; b.bar = bar; b.x = xb_xcc_id(); b.st = st;
    if (threadIdx.x == 0) (void)xb_add(&bar[XB_XCNT(b.x)], 1u);
    return b;
}
__device__ __forceinline__ void xcd_barrier_complete(unsigned* bar, unsigned x, unsigned& nloc, unsigned& nx) {
    const unsigned G = gridDim.x * gridDim.y * gridDim.z;
    unsigned sum, cnt, mine, sp = 0u;
    for (;;) {
        sum = 0u; cnt = 0u; mine = 0u;
#pragma unroll
        for (unsigned j = 0; j < 16; ++j) { const unsigned c = xb_ld(&bar[XB_XCNT(j)]); sum += c; cnt += (c > 0u) ? 1u : 0u; mine = (j == x) ? c : mine; }
        if (sum == G) break;
        __builtin_amdgcn_s_sleep(1);
        if ((++sp & 255u) == 0u) { if (xb_ld(&bar[XB_TMO])) break; if (sp > XB_SPIN_CAP) { atomicAdd(&bar[XB_TMO], 1u); break; } }
    }
    nloc = mine > 0u ? mine : 1u; nx = cnt > 0u ? cnt : 1u;
}

__device__ __forceinline__ void xcd_barrier(const XcdBarrier& b) {
    asm volatile("s_waitcnt vmcnt(0)" ::: "memory");
    __syncthreads();
    if (threadIdx.x == 0) {
        unsigned* bar = b.bar;
        __builtin_amdgcn_s_waitcnt(0);
        unsigned nloc = b.st[0], nx = b.st[1];
        if (nloc == 0u) { xcd_barrier_complete(bar, b.x, nloc, nx); b.st[0] = nloc; b.st[1] = nx; }
        const unsigned old = xb_add(&bar[XB_XSUB(b.x)], 1u);
        const unsigned gen = old / nloc;
        if (old + 1u == (gen + 1u) * nloc) {
            __builtin_amdgcn_fence(__ATOMIC_RELEASE, "agent");
            asm volatile("s_waitcnt vmcnt(0)" ::: "memory");
            const unsigned og = xb_add(&bar[XB_TOP], 1u);
            const unsigned tg = og / nx;
            if (og + 1u == (tg + 1u) * nx) xb_add(&bar[XB_TOPGEN], 1u);
            else XB_SPIN(xb_ld(&bar[XB_TOPGEN]) == tg, bar);
            __builtin_amdgcn_fence(__ATOMIC_ACQUIRE, "agent");
            xb_add(&bar[XB_XGEN(b.x)], 1u);
            asm volatile("s_waitcnt vmcnt(0)" ::: "memory");
        } else {
            XB_SPIN(xb_ld(&bar[XB_XGEN(b.x)]) == gen, bar);
            __builtin_amdgcn_fence(__ATOMIC_ACQUIRE, "agent");
            asm volatile("s_waitcnt vmcnt(0)" ::: "memory");
        }
    }
    __syncthreads();
}
#ifndef MK_WGM
#define MK_WGM 4
#endif
namespace pg8 {
#define PG8_LAS __attribute__((address_space(3)))
typedef unsigned short bf16_t;
typedef short bf16x8 __attribute__((ext_vector_type(8)));
typedef float f32x4 __attribute__((ext_vector_type(4)));
typedef float f32x2 __attribute__((ext_vector_type(2)));
typedef unsigned u32x4 __attribute__((ext_vector_type(4)));
typedef unsigned u32x2 __attribute__((ext_vector_type(2)));
constexpr int BM = 256, BK = 64, HALF = 128, HTB = HALF * BK * 2  , STAGE_BYTES = 8 * HTB, NXCD = 8, WGM = MK_WGM;
constexpr float L2E = 1.4426950408889634f, LN2 = 0.6931471805599453f;

__host__ __device__ __forceinline__ int lds_byte(int r, int c) { const int st = (r >> 4) * 2 + (c >> 5), rr = r & 15, cc = c & 31, ob = rr * 64 + cc * 2; return st * 1024 + (ob ^ (((ob >> 9) & 1) << 5)); }
__host__ __device__ __forceinline__ void stage_rc(int b, int& R, int& C) { const int st = b / 1024, sb = b % 1024, swz = sb ^ (((sb >> 9) & 1) << 5); R = (st >> 1) * 16 + swz / 64; C = (st & 1) * 32 + (swz % 64) / 2; }
__host__ __device__ __forceinline__ int perm32(int rho) { const int n = rho >> 4, i = rho & 15; return 8 * (i >> 2) + 4 * n + (i & 3); }

struct Unit { int pm, pn, pe, ga, nv, nt, ks; };
__device__ __forceinline__ int unit_k0(const Unit& u) { return u.ks < 0 ? 0 : u.ks * u.nt * BK; }
struct Gemm { const bf16_t* A; const bf16_t* Bt; int K; const int* rowtok; int flags; };

struct StaticOrder {
    static constexpr bool GATHER = false;
    int nM, nN, nwg, G, c, wgm;
    __device__ __forceinline__ void init(int M, int N, int G_, int c_, int wgm_ = WGM) { nM = M / BM; nN = N / BM; nwg = nM * nN; G = G_; c = c_; wgm = wgm_; }
    __device__ __forceinline__ bool next(int i, Unit& u) const {
        const long L = (long)i * G + c; if (L >= nwg) return false;
        int wgid = (int)L; { const int q = nwg / NXCD, r = nwg % NXCD, xcd = wgid % NXCD, off = wgid / NXCD; wgid = (xcd < r ? xcd * (q + 1) : r * (q + 1) + (xcd - r) * q) + off; }
        const int nig = wgm * nN, gid = wgid / nig, fm = gid * wgm, gsz = (nM - fm) < wgm ? (nM - fm) : wgm;
        u.pm = fm + ((wgid % nig) % gsz); u.pn = (wgid % nig) / gsz; u.pe = u.pn; u.ga = 0; u.nv = BM; u.nt = 0; u.ks = -1; return true;
    }
};
template <bool GATHER_>
struct MoeOrder {
    static constexpr bool GATHER = GATHER_;
    const PG8_LAS int* tab; int nN, T, nwg, G, c, wgm;
    __device__ __forceinline__ void init(const PG8_LAS int* tab_, int nN_, int G_, int c_, int wgm_ = WGM) { tab = tab_; nN = nN_; T = tab_[8]; nwg = T * nN_; G = G_; c = c_; wgm = wgm_; }
    __device__ __forceinline__ bool next(int i, Unit& u) const {
        const long L = (long)i * G + c; if (L >= nwg) return false;
        int wgid = (int)L; { const int q = nwg / NXCD, r = nwg % NXCD, xcd = wgid % NXCD, off = wgid / NXCD; wgid = (xcd < r ? xcd * (q + 1) : r * (q + 1) + (xcd - r) * q) + off; }
        const int nig = wgm * nN, gid = wgid / nig, fm = gid * wgm, gsz = (T - fm) < wgm ? (T - fm) : wgm;
        const int ct = fm + ((wgid % nig) % gsz), pn = (wgid % nig) / gsz;
        int e = 0;
#pragma unroll
        for (int j = 1; j < 8; ++j) e += (ct >= tab[j]) ? 1 : 0;
        const int lt = ct - tab[e], rem = tab[16 + e] - lt * BM;
        u.pm = ct; u.pn = e * nN + pn; u.pe = pn; u.ga = e * 16384 + lt * BM; u.nv = rem < BM ? rem : BM; u.nt = 0; u.ks = -1; return true;
    }
};
struct Moe2Order {
    static constexpr bool GATHER = false;
    const PG8_LAS int* tab; int T, G, c;
    __device__ __forceinline__ static int split_tiles(int T) { return T > 128 ? T - 128 : 0; }
#ifdef MK_FORCE_S7
    __device__ __forceinline__ static int slices(int nsplit) { return 7; }
#else
    __device__ __forceinline__ static int slices(int nsplit) { return 4 * nsplit <= 18 ? 14 : 7; }
#endif
    __device__ __forceinline__ void init(const PG8_LAS int* tab_, int G_, int c_) { tab = tab_; T = tab_[8]; G = G_; c = c_; }
    __device__ __forceinline__ bool next(int i, Unit& u) const {
        const int nsplit = split_tiles(T), s = slices(nsplit), nnorm = (T - nsplit) * 4, total = nnorm + nsplit * 4 * s;
        const long L = (long)i * G + c; if (L >= total) return false;
        int ct, pn;
        if (L < nnorm) { int wgid = (int)L; { const int q = nnorm / NXCD, r = nnorm % NXCD, xcd = wgid % NXCD, off = wgid / NXCD; wgid = (xcd < r ? xcd * (q + 1) : r * (q + 1) + (xcd - r) * q) + off; }
            const int Tn = T - nsplit, nig = WGM * 4, gid = wgid / nig, fm = gid * WGM, gsz = (Tn - fm) < WGM ? (Tn - fm) : WGM;
            ct = fm + ((wgid % nig) % gsz); pn = (wgid % nig) / gsz; u.nt = 0; u.ks = -1;
#if PG8_MOE2_REV
            ct = Tn - 1 - ct;
#endif
        }
        else { const int j = (int)L - nnorm, sl = j % s, un = j / s; ct = T - nsplit + (un >> 2); pn = un & 3; u.nt = 56 / s; u.ks = sl; }
        int e = 0;
#pragma unroll
        for (int j = 1; j < 8; ++j) e += (ct >= tab[j]) ? 1 : 0;
        u.pm = ct; u.pn = e * 4 + pn; u.pe = pn; u.ga = 0; u.nv = BM; return true;
    }
};

__device__ __forceinline__ unsigned cvt_pk_bf16(float lo, float hi) { unsigned r; asm volatile("v_cvt_pk_bf16_f32 %0, %1, %2" : "=v"(r) : "v"(lo), "v"(hi)); return r; }
__device__ __forceinline__ float bf_lo(unsigned w) { return __uint_as_float(w << 16); }
__device__ __forceinline__ float bf_hi(unsigned w) { return __uint_as_float(w & 0xffff0000u); }
__device__ __forceinline__ float fexp2(float x) { return __builtin_amdgcn_exp2f(x); }
__device__ __forceinline__ float frcp(float x) { return __builtin_amdgcn_rcpf(x); }
__device__ __forceinline__ float sigmoid_f(float x) { return frcp(1.f + fexp2(-L2E * x)); }
__device__ __forceinline__ float silu_f(float x) { return x * sigmoid_f(x); }
__device__ __forceinline__ float gelu_tanh_f(float x) { const float y = 0.7978845608028654f * (x + 0.044715f * x * x * x); return x * frcp(1.f + fexp2(-2.f * L2E * y)); }
__device__ __forceinline__ float log_sigmoid_f(float x) { return fminf(x, 0.f) - LN2 * __builtin_amdgcn_logf(1.f + fexp2(-L2E * fabsf(x))); }
__device__ __forceinline__ u32x4 pack8(const f32x4 a, const f32x4 b) { u32x4 w; w.x = cvt_pk_bf16(a[0], a[1]); w.y = cvt_pk_bf16(a[2], a[3]); w.z = cvt_pk_bf16(b[0], b[1]); w.w = cvt_pk_bf16(b[2], b[3]); return w; }
#ifndef PG8_SC1
#define PG8_SC1 0
#endif
#ifndef PG8_FIRSTAHEAD
#define PG8_FIRSTAHEAD 0
#endif
#ifndef PG8_MOE2_REV
#define PG8_MOE2_REV 0
#endif
#ifndef PG8_MOEAHEAD
#define PG8_MOEAHEAD 1
#endif
#ifndef PG8_RAHEAD
#define PG8_RAHEAD 0
#endif
#ifndef PG8_KROT_MODE
#define PG8_KROT_MODE 0
#endif
#ifndef PG8_KROT
#define PG8_KROT 0
#endif
#ifndef PG8_WARM
#define PG8_WARM 0
#endif
#ifndef PG8_NT
#define PG8_NT 0
#endif
__device__ __forceinline__ void st16(void* p, u32x4 v, bool ok = true) { if (!ok) { asm volatile("" :: "v"(v)); return; } if (PG8_SC1) asm volatile("s_nop 0\n\tglobal_store_dwordx4 %0, %1, off sc1\n\ts_nop 1" :: "v"(p), "v"(v) : "memory");
    else if (PG8_NT) __builtin_nontemporal_store(v, (u32x4*)p); else *(u32x4*)p = v; }
__device__ __forceinline__ void st16f(void* p, f32x4 v, bool ok = true) { if (!ok) { asm volatile("" :: "v"(v)); return; } if (PG8_NT) __builtin_nontemporal_store(v, (f32x4*)p); else *(f32x4*)p = v; }
__device__ __forceinline__ float row_rstd(const float* p, int row, int ns) { float s;
    if (ns == 1) s = p[row]; else { const f32x4* q = (const f32x4*)(p + (size_t)row * 16); const f32x4 a = q[0], b = q[1], c = q[2], d = q[3];
        s = (((a[0] + a[1]) + (a[2] + a[3])) + ((b[0] + b[1]) + (b[2] + b[3]))) + (((c[0] + c[1]) + (c[2] + c[3])) + ((d[0] + d[1]) + (d[2] + d[3]))); }
    return __builtin_amdgcn_rsqf(s * (1.f / 1024.f) + 1e-6f); }

struct RRaw { f32x4 q[4]; };
__device__ __forceinline__ void rstd16_issue(const float* p, int row, RRaw& r) { const f32x4* q = (const f32x4*)(p + (size_t)row * 16);
    asm volatile("global_load_dwordx4 %0, %4, off\n\tglobal_load_dwordx4 %1, %4, off offset:16\n\tglobal_load_dwordx4 %2, %4, off offset:32\n\tglobal_load_dwordx4 %3, %4, off offset:48"
                 : "=&v"(r.q[0]), "=&v"(r.q[1]), "=&v"(r.q[2]), "=&v"(r.q[3]) : "v"(q) : "memory"); }
__device__ __forceinline__ void rstd1_issue(const float* p, RRaw& r) { float x; asm volatile("global_load_dword %0, %1, off" : "=&v"(x) : "v"(p) : "memory"); r.q[0][0] = x; }
__device__ __forceinline__ float rstd16_finish(const RRaw& r) { const f32x4 a = r.q[0], b = r.q[1], c = r.q[2], d = r.q[3];
    const float s = (((a[0] + a[1]) + (a[2] + a[3])) + ((b[0] + b[1]) + (b[2] + b[3]))) + (((c[0] + c[1]) + (c[2] + c[3])) + ((d[0] + d[1]) + (d[2] + d[3])));
    return __builtin_amdgcn_rsqf(s * (1.f / 1024.f) + 1e-6f); }
struct EpiEvenIn {
    static constexpr bool PERM = true;
    bf16_t* Z; float* loga; float* vstp; const float* ssq; const float* gate_bias; int fl;
    __device__ __forceinline__ void rload(const Unit& u, int tid, float& a, float& b) const { a = (tid < BM) ? row_rstd(ssq, u.pm * BM + tid, 1) : 0.f; b = 0.f; }
    static constexpr int NRAW = 1;
    static constexpr bool AHEAD = true;
    __device__ __forceinline__ void rissue(const Unit& u, int tid, RRaw& r) const { rstd1_issue(ssq + u.pm * BM + (tid & (BM - 1)), r); }
    __device__ __forceinline__ void rfinish(const RRaw& r, int tid, float& a, float& b) const { a = (tid < BM) ? __builtin_amdgcn_rsqf(r.q[0][0] * (1.f / 1024.f) + 1e-6f) : 0.f; b = 0.f; }
    __device__ __forceinline__ void rstore(PG8_LAS float* rs, int tid, float a, float) const { if (tid < BM) rs[tid] = a; }
    __device__ __forceinline__ void operator()(const f32x4 (&acc)[2][2][4][2], const Unit& u, int wr, int wc, int fr, int fq, const PG8_LAS float* rs) const {
        const int pn = u.pe, row0 = u.pm * BM + wr * 64 + fr, cl = wc * 32 + 8 * fq;
        if (pn == 6) {
            f32x4 gb[2][2];
#pragma unroll
            for (int bj = 0; bj < 2; ++bj)
#pragma unroll
                for (int n = 0; n < 2; ++n) gb[bj][n] = *(const f32x4*)(gate_bias + bj * HALF + cl + 4 * n);
#pragma unroll
            for (int ai = 0; ai < 2; ++ai)
#pragma unroll
                for (int m = 0; m < 4; ++m) { const int row = row0 + ai * HALF + m * 16; const float r = rs[wr * 64 + fr + ai * HALF + m * 16];
#pragma unroll
                    for (int bj = 0; bj < 2; ++bj)
#pragma unroll
                        for (int n = 0; n < 2; ++n) { f32x4 v = acc[ai][bj][m][n] * r + gb[bj][n];
#pragma unroll
                            for (int e = 0; e < 4; ++e) v[e] = log_sigmoid_f(v[e]) * (1.f / 16.f);
                            st16f(loga + (size_t)row * 256 + bj * HALF + cl + 4 * n, v, !(fl & 2)); } }
            return;
        }
        const int zc = (pn < 6 ? pn : pn - 1) * BM + cl;
        const int ty = pn < 4 ? 1 : (pn == 4 ? 2 : (pn >= 9 ? 3 : 0));
        const bool st = (pn == 2 || pn == 3);
#pragma unroll
        for (int ai = 0; ai < 2; ++ai)
#pragma unroll
            for (int m = 0; m < 4; ++m) { const int row = row0 + ai * HALF + m * 16; const float r = rs[wr * 64 + fr + ai * HALF + m * 16];
                float s1 = 0.f, s2 = 0.f;
#pragma unroll
                for (int bj = 0; bj < 2; ++bj) { f32x4 v0 = acc[ai][bj][m][0] * r, v1 = acc[ai][bj][m][1] * r;
                    if (ty == 1) {
#pragma unroll
                        for (int e = 0; e < 4; ++e) { v0[e] = gelu_tanh_f(v0[e]); v1[e] = gelu_tanh_f(v1[e]); } }
                    else if (ty == 2) { v0 = v0 * 0.125f; v1 = v1 * 0.125f; }
                    else if (ty == 3) {
#pragma unroll
                        for (int e = 0; e < 4; ++e) { v0[e] = silu_f(v0[e]); v1[e] = silu_f(v1[e]); } }
                    if (st) {
#pragma unroll
                        for (int e = 0; e < 4; ++e) { s1 += v0[e] + v1[e]; s2 += v0[e] * v0[e] + v1[e] * v1[e]; } }
                    st16(Z + (size_t)row * 2560 + zc + bj * HALF, pack8(v0, v1), !(fl & 2)); }
                if (st) { s1 += __shfl_xor(s1, 16); s1 += __shfl_xor(s1, 32); s2 += __shfl_xor(s2, 16); s2 += __shfl_xor(s2, 32);
                    if (fq == 0) { const int j = 4 * (pn - 2) + wc; vstp[(size_t)row * 16 + j] = s1; vstp[(size_t)row * 16 + 8 + j] = s2; } } }
    }
};
struct EpiResid {
    static constexpr bool PERM = true;
    const float* xin; bf16_t* xb; float* ssqp; int fl;
    __device__ __forceinline__ void rload(const Unit&, int, float& a, float& b) const { a = 0.f; b = 0.f; }
    __device__ __forceinline__ void rstore(PG8_LAS float*, int, float, float) const {}
    static constexpr int NRAW = 0;
    static constexpr bool AHEAD = false;
    __device__ __forceinline__ void rissue(const Unit&, int, RRaw&) const {}
    __device__ __forceinline__ void rfinish(const RRaw&, int, float& a, float& b) const { a = 0.f; b = 0.f; }
    __device__ __forceinline__ void operator()(const f32x4 (&acc)[2][2][4][2], const Unit& u, int wr, int wc, int fr, int fq, const PG8_LAS float*) const {
        const int row0 = u.pm * BM + wr * 64 + fr, c0 = u.pe * BM + wc * 32 + 8 * fq;
#pragma unroll
        for (int ai = 0; ai < 2; ++ai) { u32x4 rv[4][2];
#pragma unroll
            for (int m = 0; m < 4; ++m)
#pragma unroll
                for (int bj = 0; bj < 2; ++bj) rv[m][bj] = *(const u32x4*)(xb + (size_t)(row0 + ai * HALF + m * 16) * 1024 + c0 + bj * HALF);
#pragma unroll
            for (int m = 0; m < 4; ++m) { const int row = row0 + ai * HALF + m * 16; const size_t off = (size_t)row * 1024 + c0; float s = 0.f;
#pragma unroll
                for (int bj = 0; bj < 2; ++bj) { const u32x4 o = rv[m][bj];
                    f32x4 v0 = (f32x4){bf_lo(o.x), bf_hi(o.x), bf_lo(o.y), bf_hi(o.y)}, v1 = (f32x4){bf_lo(o.z), bf_hi(o.z), bf_lo(o.w), bf_hi(o.w)};
                    v0 = v0 + acc[ai][bj][m][0]; v1 = v1 + acc[ai][bj][m][1];
                    st16(xb + off + bj * HALF, pack8(v0, v1), !(fl & 2));
#pragma unroll
                    for (int e = 0; e < 4; ++e) s += v0[e] * v0[e] + v1[e] * v1[e]; }
                if (ssqp) { s += __shfl_xor(s, 16); s += __shfl_xor(s, 32); if (fq == 0) ssqp[(size_t)row * 16 + u.pe * 4 + wc] = s; } }
            asm volatile("" ::: "memory"); }
    }
};
template <bool MOE>
struct EpiSwiglu {
    static constexpr bool PERM = true;
    bf16_t* O; int ldo; const float* ssq; const float* rowr; const float* roww; int fl;
    __device__ __forceinline__ void rload(const Unit& u, int tid, float& a, float& b) const { a = 0.f; b = 0.f; if (tid < BM) { if (MOE) { a = rowr[u.ga + tid]; b = roww[u.ga + tid]; } else a = row_rstd(ssq, u.pm * BM + tid, 16); } }
    static constexpr int NRAW = MOE ? 1 : 4;
    static constexpr bool AHEAD = !MOE;
    __device__ __forceinline__ void rissue(const Unit& u, int tid, RRaw& r) const { const int tl = tid & (BM - 1); if (MOE) { r.q[0][0] = rowr[u.ga + tl]; r.q[0][1] = roww[u.ga + tl]; } else rstd16_issue(ssq, u.pm * BM + tl, r); }
    __device__ __forceinline__ void rfinish(const RRaw& r, int tid, float& a, float& b) const { a = 0.f; b = 0.f; if (tid < BM) { if (MOE) { a = r.q[0][0]; b = r.q[0][1]; } else a = rstd16_finish(r); } }
    __device__ __forceinline__ void rissue_asm(const Unit& u, int tid, float& a, float& b) const { const int tl = tid & (BM - 1); const float* pa = rowr + u.ga + tl; const float* pb = roww + u.ga + tl;
        asm volatile("global_load_dword %0, %2, off\n\tglobal_load_dword %1, %3, off" : "=&v"(a), "=&v"(b) : "v"(pa), "v"(pb) : "memory"); }
    __device__ __forceinline__ void rstore(PG8_LAS float* rs, int tid, float a, float b) const { if (tid < BM) { rs[tid] = a; if (MOE) rs[BM + tid] = b; } }
    __device__ __forceinline__ void operator()(const f32x4 (&acc)[2][2][4][2], const Unit& u, int wr, int wc, int fr, int fq, const PG8_LAS float* rs) const { rows<0, 2>(acc, u, wr, wc, fr, fq, rs); }
    template <int A0, int A1>
    __device__ __forceinline__ void rows(const f32x4 (&acc)[2][2][4][2], const Unit& u, int wr, int wc, int fr, int fq, const PG8_LAS float* rs) const {
        const int rl0 = wr * 64 + fr, c0 = u.pe * HALF + wc * 32 + 8 * fq;
#pragma unroll
        for (int ai = A0; ai < A1; ++ai)
#pragma unroll
            for (int m = 0; m < 4; ++m) { const int rl = rl0 + ai * HALF + m * 16, row = u.pm * BM + rl; float r, w = 1.f;
                r = rs[rl]; if (MOE) w = rs[BM + rl];
                const float c = -L2E * r, rw = w * r * r;
                const f32x4 a0 = acc[ai][0][m][0], a1 = acc[ai][0][m][1];
                f32x4 t0 = a0 * c, t1 = a1 * c, o0 = (a0 * acc[ai][1][m][0]) * rw, o1 = (a1 * acc[ai][1][m][1]) * rw;
#ifdef MK_EXPERIMENT
                if (!(fl & 4))
#endif
#pragma unroll
                for (int e = 0; e < 4; ++e) { t0[e] = frcp(1.f + fexp2(t0[e])); t1[e] = frcp(1.f + fexp2(t1[e])); }
                o0 = o0 * t0; o1 = o1 * t1;
                st16(O + (size_t)row * ldo + c0, pack8(o0, o1), !(fl & 2)); }
    }
};
struct EpiBf16 {
    static constexpr bool PERM = true;
    bf16_t* O; int ldo; int fl; bf16_t* OP; size_t pstride; int prow0;
    __device__ __forceinline__ void rload(const Unit&, int, float& a, float& b) const { a = 0.f; b = 0.f; }
    __device__ __forceinline__ void rstore(PG8_LAS float*, int, float, float) const {}
    static constexpr int NRAW = 0;
    static constexpr bool AHEAD = false;
    __device__ __forceinline__ void rissue(const Unit&, int, RRaw&) const {}
    __device__ __forceinline__ void rfinish(const RRaw&, int, float& a, float& b) const { a = 0.f; b = 0.f; }
    __device__ __forceinline__ void operator()(const f32x4 (&acc)[2][2][4][2], const Unit& u, int wr, int wc, int fr, int fq, const PG8_LAS float*) const {
        const int row0 = u.pm * BM + wr * 64 + fr, c0 = u.pe * BM + wc * 32 + 8 * fq;
#pragma unroll
        for (int ai = 0; ai < 2; ++ai)
#pragma unroll
            for (int m = 0; m < 4; ++m) { bf16_t* rp = (u.ks < 0 ? O : OP + (size_t)u.ks * pstride - (size_t)prow0 * BM * ldo) + (size_t)(row0 + ai * HALF + m * 16) * ldo + c0;
#pragma unroll
                for (int bj = 0; bj < 2; ++bj) st16(rp + bj * HALF, pack8(acc[ai][bj][m][0], acc[ai][bj][m][1]), !(fl & 2)); }
    }
};
struct EpiOddIn {
    static constexpr bool PERM = true;
    bf16_t* QKVG; size_t tstride; const float* ssq; const float* q_g; const float* k_g; float qscale; int fl;
    __device__ __forceinline__ void rload(const Unit& u, int tid, float& a, float& b) const { a = (tid < BM) ? row_rstd(ssq, u.pm * BM + tid, 16) : 0.f; b = 0.f; }
    static constexpr int NRAW = 4;
    static constexpr bool AHEAD = true;
    __device__ __forceinline__ void rissue(const Unit& u, int tid, RRaw& r) const { rstd16_issue(ssq, u.pm * BM + (tid & (BM - 1)), r); }
    __device__ __forceinline__ void rfinish(const RRaw& r, int tid, float& a, float& b) const { a = (tid < BM) ? rstd16_finish(r) : 0.f; b = 0.f; }
    __device__ __forceinline__ void rstore(PG8_LAS float* rs, int tid, float a, float) const { if (tid < BM) rs[tid] = a; }
    __device__ __forceinline__ void operator()(const f32x4 (&acc)[2][2][4][2], const Unit& u, int wr, int wc, int fr, int fq, const PG8_LAS float* rs) const {
        const int which = u.pe >> 2, head = (u.pe & 3) * 4 + wc, row0 = u.pm * BM + wr * 64 + fr;
        bf16_t* base = QKVG + (size_t)which * tstride + head * 64 + 8 * fq;
        f32x4 gv[2][2];
        if (which < 2) { const float* gp = which == 0 ? q_g : k_g; const float sc = which == 0 ? qscale : 1.f;
#pragma unroll
            for (int bj = 0; bj < 2; ++bj)
#pragma unroll
                for (int n = 0; n < 2; ++n) gv[bj][n] = *(const f32x4*)(gp + 32 * bj + 8 * fq + 4 * n) * sc; }
#pragma unroll
        for (int ai = 0; ai < 2; ++ai)
#pragma unroll
            for (int m = 0; m < 4; ++m) { const int row = row0 + ai * HALF + m * 16; const float r = rs[wr * 64 + fr + ai * HALF + m * 16];
                f32x4 v[2][2];
#pragma unroll
                for (int bj = 0; bj < 2; ++bj)
#pragma unroll
                    for (int n = 0; n < 2; ++n) v[bj][n] = acc[ai][bj][m][n] * r;
                if (which < 2) { float s = 0.f;
#pragma unroll
                    for (int bj = 0; bj < 2; ++bj)
#pragma unroll
                        for (int n = 0; n < 2; ++n)
#pragma unroll
                            for (int e = 0; e < 4; ++e) s += v[bj][n][e] * v[bj][n][e];
                    s += __shfl_xor(s, 16); s += __shfl_xor(s, 32);
                    const float rh = __builtin_amdgcn_rsqf(s * (1.f / 64.f) + 1e-6f);
#pragma unroll
                    for (int bj = 0; bj < 2; ++bj)
#pragma unroll
                        for (int n = 0; n < 2; ++n) v[bj][n] = v[bj][n] * gv[bj][n] * rh; }
                else if (which == 3) {
#pragma unroll
                    for (int bj = 0; bj < 2; ++bj)
#pragma unroll
                        for (int n = 0; n < 2; ++n)
#pragma unroll
                            for (int e = 0; e < 4; ++e) v[bj][n][e] = sigmoid_f(v[bj][n][e]); }
#pragma unroll
                for (int bj = 0; bj < 2; ++bj) st16(base + (size_t)row * 1024 + 32 * bj, pack8(v[bj][0], v[bj][1]), !(fl & 2)); }
    }
};

template <class Epi, class Sched, bool ALIGN_EPI>
__device__ __forceinline__ void gemm_phase(PG8_LAS unsigned char* lds, PG8_LAS float* rs, const Gemm g, const Sched& S, const Epi& E) {
    const int tid = threadIdx.x, wid = __builtin_amdgcn_readfirstlane(tid >> 6), lane = tid & 63, wr = wid >> 2, wc = wid & 3, fr = lane & 15, fq = lane >> 4;
    const int K = g.K, nt = K / BK;
    int Ra[2], Ca[2]; unsigned voffB[2];
#pragma unroll
    for (int i = 0; i < 2; ++i) { int R, C; stage_rc(tid * 16 + i * 8192, R, C); const int Rb = Epi::PERM ? ((R & ~31) + perm32(R & 31)) : R;
        Ra[i] = R; Ca[i] = C; voffB[i] = (unsigned)(Rb * K + C) * 2u; }
    const size_t kstep = (size_t)(BK * 2);
    const size_t hstep = (size_t)HALF * K * 2;
    const size_t tstep = 2 * hstep;
    const unsigned ldsw = (unsigned)wid * 1024u;
    const int aoff = lds_byte(wr * 64 + fr, fq * 8), boff = lds_byte(wc * 32 + fr, fq * 8);
#define PG8_SA(b, h) (((b) * 2 + (h)) * HTB)
#define PG8_SB(b, h) ((4 + (b) * 2 + (h)) * HTB)
#define PG8_STAGE(bufoff, gbase, voff) do { _Pragma("unroll") for (int _i = 0; _i < 2; ++_i) \
        __builtin_amdgcn_global_load_lds((const unsigned*)((const char*)(gbase) + (voff)[_i]), (PG8_LAS unsigned*)(lds + (bufoff) + ldsw + _i * 8192), 16, 0, 0); } while (0)
#define PG8_STAGE_A(bufoff, kb, offs) do { const char* _ab = (const char*)g.A + (kb); _Pragma("unroll") for (int _i = 0; _i < 2; ++_i) \
        __builtin_amdgcn_global_load_lds((const unsigned*)(_ab + (offs)[_i]), (PG8_LAS unsigned*)(lds + (bufoff) + ldsw + _i * 8192), 16, 0, 0); } while (0)
#define PG8_ROWS(dst, uu) do { _Pragma("unroll") for (int _h = 0; _h < 2; ++_h) _Pragma("unroll") for (int _i = 0; _i < 2; ++_i) { const int _rl = _h * HALF + Ra[_i]; \
        if constexpr (Sched::GATHER) { const int _rc = _rl < (uu).nv ? _rl : (uu).nv - 1; dst[_h][_i] = (unsigned)g.rowtok[(uu).ga + _rc]; }     \
        else { dst[_h][_i] = (unsigned)((uu).pm * BM + _rl); } } } while (0)
#define PG8_FIN(dst, src, uu) do { _Pragma("unroll") for (int _h = 0; _h < 2; ++_h) _Pragma("unroll") for (int _i = 0; _i < 2; ++_i) \
        dst[_h][_i] = src[_h][_i] * (unsigned)(K * 2) + (unsigned)((Ca[_i] + unit_k0(uu)) * 2); } while (0)
#define PG8_LDA(dst, b, h) do { _Pragma("unroll") for (int m = 0; m < 4; ++m) _Pragma("unroll") for (int k = 0; k < 2; ++k) dst[m][k] = *(const PG8_LAS bf16x8*)(lds + PG8_SA(b, h) + aoff + m * 2048 + k * 1024); } while (0)
#define PG8_LDB(dst, b, h) do { _Pragma("unroll") for (int n = 0; n < 2; ++n) _Pragma("unroll") for (int k = 0; k < 2; ++k) dst[n][k] = *(const PG8_LAS bf16x8*)(lds + PG8_SB(b, h) + boff + n * 2048 + k * 1024); } while (0)
#define PG8_MMA(ai, bj, At, Bt) do { __builtin_amdgcn_s_setprio(1); _Pragma("unroll") for (int m = 0; m < 4; ++m) _Pragma("unroll") for (int n = 0; n < 2; ++n) _Pragma("unroll") for (int k = 0; k < 2; ++k) \
        acc[ai][bj][m][n] = __builtin_amdgcn_mfma_f32_16x16x32_bf16(Bt[n][k], At[m][k], acc[ai][bj][m][n], 0, 0, 0); __builtin_amdgcn_s_setprio(0); } while (0)
#define PG8_WAIT_V(n) asm volatile("s_waitcnt vmcnt(" #n ")" ::: "memory")
#define PG8_WAIT_L(n) asm volatile("s_waitcnt lgkmcnt(" #n ")" ::: "memory")
#define PG8_BAR __builtin_amdgcn_s_barrier()
#define PG8_SCHED __builtin_amdgcn_sched_barrier(0)
    Unit cur, nxt; int ui = 0;
    if (!S.next(0, cur)) return;
    bool has_next = S.next(1, nxt);
    unsigned coff[2][2], noff[2][2];
    PG8_ROWS(coff, cur); PG8_FIN(coff, coff, cur);
    if (has_next) { PG8_ROWS(noff, nxt); PG8_FIN(noff, noff, nxt); } else {
#pragma unroll
        for (int h = 0; h < 2; ++h)
#pragma unroll
            for (int i = 0; i < 2; ++i) noff[h][i] = coff[h][i]; }
#if PG8_WARM
    { unsigned hx = 0u;
#pragma unroll
      for (int kt = 0; kt < 4; ++kt) { const int t = 2 + 4 * kt + (cur.pe & 3);
          if (t < nt && cur.nt == 0) {
#pragma unroll
              for (int h = 0; h < 2; ++h)
#pragma unroll
                  for (int i = 0; i < 2; ++i) { const u32x4 v = *(const u32x4*)((const char*)g.A + coff[h][i] + (size_t)t * kstep); hx ^= v.x ^ v.y ^ v.z ^ v.w; } } }
      asm volatile("" :: "v"(hx)); }
#endif
    f32x4 acc[2][2][4][2];
#pragma unroll
    for (int a = 0; a < 2; ++a)
#pragma unroll
        for (int b = 0; b < 2; ++b)
#pragma unroll
            for (int m = 0; m < 4; ++m)
#pragma unroll
                for (int n = 0; n < 2; ++n) acc[a][b][m][n] = (f32x4){0.f, 0.f, 0.f, 0.f};
    bf16x8 At[4][2], B0[2][2], B1[2][2];
    const char* cB = (const char*)g.Bt + (size_t)cur.pn * tstep + (size_t)unit_k0(cur) * 2;
    constexpr bool MA = PG8_MOEAHEAD && Sched::GATHER;
    constexpr bool FA = PG8_FIRSTAHEAD && Epi::NRAW > 0;
    RRaw fraw; float fa_ = 0.f, fb_ = 0.f;
    if constexpr (FA) { if constexpr (MA) E.rissue_asm(cur, tid, fa_, fb_); else E.rissue(cur, tid, fraw); }
#if PG8_KROT_MODE == 0
    const int krot = PG8_KROT * 2 * (int)(blockIdx.x & 7);
#else
    const int krot = PG8_KROT * 2 * (int)((blockIdx.x >> 3) & 3);
#endif
#define PG8_ROT(ntc_) ((ntc_) > 0 ? krot % (ntc_) : 0)
#if PG8_KROT
    { const int nt0 = cur.nt ? cur.nt : nt; const size_t r0 = (size_t)PG8_ROT(nt0) * kstep;
#else
    { constexpr size_t r0 = 0;
#endif
    PG8_STAGE(PG8_SB(0, 0), cB + r0, voffB); PG8_STAGE(PG8_SB(0, 1), cB + hstep + r0, voffB); PG8_STAGE_A(PG8_SA(0, 0), r0, coff[0]); PG8_STAGE_A(PG8_SA(0, 1), r0, coff[1]);
    if (wr == 1) PG8_BAR;
    PG8_WAIT_V(2); PG8_BAR;
    PG8_STAGE(PG8_SB(1, 0), cB + r0 + kstep, voffB); PG8_STAGE_A(PG8_SA(1, 0), r0 + kstep, coff[0]); PG8_STAGE(PG8_SB(1, 1), cB + hstep + r0 + kstep, voffB);
    PG8_WAIT_V(6); PG8_BAR; }
    float rsa, rsb;
    if constexpr (PG8_RAHEAD && Epi::AHEAD) E.rload(cur, tid, rsa, rsb);
    if constexpr (FA) {
        if constexpr (MA) { asm volatile("" : "+v"(fa_), "+v"(fb_)); rsa = tid < BM ? fa_ : 0.f; rsb = tid < BM ? fb_ : 0.f; }
        else { if constexpr (Epi::NRAW == 4) asm volatile("" : "+v"(fraw.q[0]), "+v"(fraw.q[1]), "+v"(fraw.q[2]), "+v"(fraw.q[3])); else { float x_ = fraw.q[0][0]; asm volatile("" : "+v"(x_)); fraw.q[0][0] = x_; }
               E.rfinish(fraw, tid, rsa, rsb); } }
    else if constexpr (MA) { E.rload(cur, tid, rsa, rsb); asm volatile("" : "+v"(rsa), "+v"(rsb)); }
    for (;;) {
        const char* nB = has_next ? (const char*)g.Bt + (size_t)nxt.pn * tstep + (size_t)unit_k0(nxt) * 2 : cB;
        const int ntc = cur.nt ? cur.nt : nt;
#if PG8_KROT
        const int rotc = PG8_ROT(ntc), rotn = PG8_ROT(has_next ? (nxt.nt ? nxt.nt : nt) : ntc);
#else
        constexpr int rotn = 0;
#endif
        if constexpr (!(PG8_RAHEAD && Epi::AHEAD) && !MA) { if (!FA || ui > 0) E.rload(cur, tid, rsa, rsb); }
        for (int t = 0; t < ntc; t += 2) {
            const bool last = (t == ntc - 2);
#if PG8_KROT
            const int p0 = (t + rotc >= ntc) ? t + rotc - ntc : t + rotc, p2 = (t + 2 + rotc >= ntc) ? t + 2 + rotc - ntc : t + 2 + rotc;
#else
            const int p0 = t, p2 = t + 2;
#endif
            const size_t k1 = (size_t)(p0 + 1) * kstep;
            const size_t k2 = last ? (size_t)rotn * kstep : (size_t)p2 * kstep; const char* b2 = last ? nB + (size_t)rotn * kstep : cB + (size_t)p2 * kstep;
            const size_t k3 = k2 + kstep; const char* b3 = b2 + kstep;
            unsigned o2[2][2];
#pragma unroll
            for (int h = 0; h < 2; ++h)
#pragma unroll
                for (int i = 0; i < 2; ++i) o2[h][i] = last ? noff[h][i] : coff[h][i];
            PG8_LDB(B0, 0, 0); PG8_LDB(B1, 0, 1); PG8_SCHED; PG8_LDA(At, 0, 0); PG8_STAGE_A(PG8_SA(1, 1), k1, coff[1]);
            PG8_WAIT_V(8); PG8_WAIT_L(0); PG8_BAR; PG8_MMA(0, 0, At, B0); PG8_MMA(0, 1, At, B1); PG8_BAR; PG8_SCHED;
            PG8_LDA(At, 0, 1); PG8_STAGE(PG8_SB(0, 0), b2, voffB); PG8_STAGE(PG8_SB(0, 1), b2 + hstep, voffB); PG8_STAGE_A(PG8_SA(0, 0), k2, o2[0]);
            PG8_WAIT_V(8); PG8_WAIT_L(0); PG8_BAR; PG8_MMA(1, 0, At, B0); PG8_MMA(1, 1, At, B1); PG8_BAR; PG8_SCHED;
            PG8_LDB(B0, 1, 0); PG8_LDB(B1, 1, 1); PG8_SCHED; PG8_LDA(At, 1, 0); PG8_STAGE_A(PG8_SA(0, 1), k2, o2[1]);
            PG8_WAIT_V(8); PG8_WAIT_L(0); PG8_BAR; PG8_MMA(0, 0, At, B0); PG8_MMA(0, 1, At, B1); PG8_BAR; PG8_SCHED;
            PG8_LDA(At, 1, 1); PG8_STAGE(PG8_SB(1, 0), b3, voffB); PG8_STAGE(PG8_SB(1, 1), b3 + hstep, voffB); PG8_STAGE_A(PG8_SA(1, 0), k3, o2[0]);
            PG8_WAIT_V(8); PG8_WAIT_L(0); PG8_BAR; PG8_MMA(1, 0, At, B0); PG8_MMA(1, 1, At, B1); PG8_BAR; PG8_SCHED;
        }
        if constexpr (ALIGN_EPI) { if (wr == 0) PG8_BAR; }
        Unit nn = nxt; const bool has_nn = has_next && S.next(ui + 2, nn);
        unsigned nnoff[2][2];
        if constexpr (MA && PG8_MOEAHEAD == 2) {
            if (has_nn) {
#pragma unroll
                for (int _h = 0; _h < 2; ++_h)
#pragma unroll
                    for (int _i = 0; _i < 2; ++_i) { const int _rl = _h * HALF + Ra[_i]; const int _rc = _rl < nn.nv ? _rl : nn.nv - 1; const int* _p = g.rowtok + nn.ga + _rc;
                        asm volatile("global_load_dword %0, %1, off" : "=&v"(nnoff[_h][_i]) : "v"(_p) : "memory"); } }
            else {
#pragma unroll
                for (int h = 0; h < 2; ++h)
#pragma unroll
                    for (int i = 0; i < 2; ++i) nnoff[h][i] = 0u; } }
        else if (has_nn) { PG8_ROWS(nnoff, nn); } else {
#pragma unroll
            for (int h = 0; h < 2; ++h)
#pragma unroll
                for (int i = 0; i < 2; ++i) nnoff[h][i] = 0u; }
        RRaw nraw;
        float mra = 0.f, mrb = 0.f;
        if constexpr (MA && PG8_MOEAHEAD == 2) { if (has_next) E.rissue_asm(nxt, tid, mra, mrb); }
        else if constexpr ((PG8_RAHEAD && Epi::AHEAD) || MA) { if (has_next) E.rissue(nxt, tid, nraw); }
        { const int ln = (int)__builtin_amdgcn_mbcnt_hi(~0u, __builtin_amdgcn_mbcnt_lo(~0u, 0u));
          E.rstore(rs, wid * 64 + ln, rsa, rsb);
          if constexpr (Sched::GATHER && !MA) { asm volatile("" : "+v"(nnoff[0][0]), "+v"(nnoff[0][1]), "+v"(nnoff[1][0]), "+v"(nnoff[1][1])); }
          PG8_WAIT_L(0); PG8_BAR;
          if constexpr (MA && PG8_MOEAHEAD == 2) {
              E.template rows<0, 1>(acc, cur, wr, wc, ln & 15, ln >> 4, rs);
              asm volatile("s_waitcnt vmcnt(4)" : "+v"(mra), "+v"(mrb), "+v"(nnoff[0][0]), "+v"(nnoff[0][1]), "+v"(nnoff[1][0]), "+v"(nnoff[1][1]) :: "memory");
              if (has_next) { const bool lo_ = (wid * 64 + ln) < BM; rsa = lo_ ? mra : 0.f; rsb = lo_ ? mrb : 0.f; }
              E.template rows<1, 2>(acc, cur, wr, wc, ln & 15, ln >> 4, rs); }
          else if (!(g.flags & 1)) E(acc, cur, wr, wc, ln & 15, ln >> 4, rs); }
        if (!has_next) break;
        if constexpr (MA && PG8_MOEAHEAD != 2) {
            asm volatile("" : "+v"(nraw.q[0]), "+v"(nnoff[0][0]), "+v"(nnoff[0][1]), "+v"(nnoff[1][0]), "+v"(nnoff[1][1]));
            E.rfinish(nraw, tid, rsa, rsb); }
        if constexpr (PG8_RAHEAD && Epi::AHEAD) {
            if constexpr (Epi::NRAW == 4) asm volatile("s_waitcnt vmcnt(0)" : "+v"(nraw.q[0]), "+v"(nraw.q[1]), "+v"(nraw.q[2]), "+v"(nraw.q[3]) :: "memory");
            else { float x_ = nraw.q[0][0]; asm volatile("s_waitcnt vmcnt(0)" : "+v"(x_) :: "memory"); nraw.q[0][0] = x_; }
            E.rfinish(nraw, tid, rsa, rsb); }
#pragma unroll
        for (int a = 0; a < 2; ++a)
#pragma unroll
            for (int b = 0; b < 2; ++b)
#pragma unroll
                for (int m = 0; m < 4; ++m)
#pragma unroll
                    for (int n = 0; n < 2; ++n) acc[a][b][m][n] = (f32x4){0.f, 0.f, 0.f, 0.f};
        cur = nxt; cB = nB; ++ui;
#pragma unroll
        for (int h = 0; h < 2; ++h)
#pragma unroll
            for (int i = 0; i < 2; ++i) coff[h][i] = noff[h][i];
        if (has_nn) { PG8_FIN(noff, nnoff, nn); }
        nxt = nn; has_next = has_nn;
        if constexpr (ALIGN_EPI) { if (wr == 1) PG8_BAR; }
    }
    PG8_WAIT_V(0);
    if constexpr (!ALIGN_EPI) { if (wr == 0) PG8_BAR; }
    PG8_BAR;
#undef PG8_SA
#undef PG8_SB
#undef PG8_STAGE
#undef PG8_STAGE_A
#undef PG8_ROWS
#undef PG8_FIN
#undef PG8_LDA
#undef PG8_LDB
#undef PG8_MMA
#undef PG8_WAIT_V
#undef PG8_WAIT_L
#undef PG8_BAR
#undef PG8_SCHED
}
}
#include <hip/hip_bf16.h>
namespace attn_body {
using bf16=__hip_bfloat16;
using bf16x8=__attribute__((ext_vector_type(8)))short;
using s16x4=__attribute__((ext_vector_type(4)))short;
using f32x16=__attribute__((ext_vector_type(16)))float;
using u32x4=__attribute__((ext_vector_type(4)))unsigned;
using f32x4l=__attribute__((ext_vector_type(4)))float;
constexpr int BATCH=4,NHEAD=16,SEQ=4096,D=64,DM=NHEAD*D;
constexpr int NW=8,QBLK=32,QB=QBLK*NW,KVBLK=64,NQB=SEQ/QB;
constexpr int ATTN_PITCH=DM, ATTN_UNIT_ROWS=QB;
__device__ __forceinline__ int crow(int r,int hi){return (r&3)+8*(r>>2)+4*hi;}
#define SBAR() __builtin_amdgcn_sched_barrier(0)
__device__ __forceinline__ void cmask(f32x16&p0,f32x16&p1,int jb,int qrel,int hi){
  const float NEG=-INFINITY; int kb=64*jb+4*hi;
  #pragma unroll
  for(int r=0;r<16;++r){int kv=kb+(r&3)+8*(r>>2); if(kv>qrel)p0[r]=NEG; if(kv+32>qrel)p1[r]=NEG;}
}

constexpr int NSLOT=3, SLOTB=8192;
constexpr int LDS_K=0, LDS_V=NSLOT*SLOTB, LDS_WS=2*NSLOT*SLOTB, LDS_OST=LDS_WS+NW*64*4, LDS_BYTES=LDS_OST+NW*4096;
constexpr float C2=0.125f*1.4426950408889634f;
__device__ __forceinline__ void glds16(const void*gsrc,unsigned lds_dst){unsigned keep;
  asm volatile("s_mov_b32 %0, m0\n\ts_mov_b32 m0, %2\n\ts_nop 0\n\tglobal_load_lds_dwordx4 %1, off\n\ts_mov_b32 m0, %0":"=&s"(keep):"v"(gsrc),"s"(lds_dst):"memory");}
__device__ __forceinline__ float max3f(float a,float b,float c){float r;asm("v_max3_f32 %0, %1, %2, %3":"=v"(r):"v"(a),"v"(b),"v"(c));return r;}
__device__ __forceinline__ float max2f(float a,float b){float r;asm("v_max_f32_e32 %0, %1, %2":"=v"(r):"v"(a),"v"(b));return r;}
__device__ __forceinline__ float fadd_s(float a,float b){float r;asm("v_add_f32_e32 %0, %1, %2":"=v"(r):"v"(a),"v"(b));return r;}
__device__ __forceinline__ float fsub_s(float a,float b){float r;asm("v_sub_f32_e32 %0, %1, %2":"=v"(r):"v"(a),"v"(b));return r;}
typedef float f32x2_t __attribute__((ext_vector_type(2))); typedef __bf16 bf16x2_t __attribute__((ext_vector_type(2)));
__device__ __forceinline__ unsigned cvtpk_s(float lo,float hi){f32x2_t v={lo,hi};bf16x2_t b=__builtin_convertvector(v,bf16x2_t);return __builtin_bit_cast(unsigned,b);}
#define WAIT_BAR(N) asm volatile("s_waitcnt vmcnt(" #N ") lgkmcnt(0)\n\ts_barrier":::"memory")

__device__ __forceinline__ void qkt(f32x16&p0,f32x16&p1,const char*Kslot,const bf16x8*qr,int r32,int hi){
  const char*kb=Kslot+hi*1024+r32*16;
  #pragma unroll
  for(int d0=0;d0<4;++d0){
    const bf16x8 b0=*reinterpret_cast<const bf16x8*>(kb+d0*2048);
    const bf16x8 b1=*reinterpret_cast<const bf16x8*>(kb+d0*2048+512);
    {p0=__builtin_amdgcn_mfma_f32_32x32x16_bf16(b0,qr[d0],p0,0,0,0);p1=__builtin_amdgcn_mfma_f32_32x32x16_bf16(b1,qr[d0],p1,0,0,0);}}
}
typedef __attribute__((address_space(3))) const char* lds_cptr;
typedef short v4i16_t __attribute__((ext_vector_type(4)));
__device__ __forceinline__ void kload8(bf16x8*kf,lds_cptr kp){
  kf[0]=*(const __attribute__((address_space(3))) bf16x8*)(kp);      kf[1]=*(const __attribute__((address_space(3))) bf16x8*)(kp+512);
  kf[2]=*(const __attribute__((address_space(3))) bf16x8*)(kp+2048); kf[3]=*(const __attribute__((address_space(3))) bf16x8*)(kp+2560);
  kf[4]=*(const __attribute__((address_space(3))) bf16x8*)(kp+4096); kf[5]=*(const __attribute__((address_space(3))) bf16x8*)(kp+4608);
  kf[6]=*(const __attribute__((address_space(3))) bf16x8*)(kp+6144); kf[7]=*(const __attribute__((address_space(3))) bf16x8*)(kp+6656);
}
__device__ __forceinline__ void kload2(bf16x8*kf,lds_cptr kp,int j){ kf[2*j]=*(const __attribute__((address_space(3))) bf16x8*)(kp+j*2048); kf[2*j+1]=*(const __attribute__((address_space(3))) bf16x8*)(kp+j*2048+512); }
__device__ __forceinline__ s16x4 vtr(lds_cptr p){ return __builtin_bit_cast(s16x4,__builtin_amdgcn_ds_read_tr16_b64_v4i16((__attribute__((address_space(3))) v4i16_t*)p)); }
__device__ __forceinline__ float rowmax(const f32x16&p0,const f32x16&p1){
  float a=max3f(p0[0],p0[1],p1[0]),b=max3f(p0[2],p0[3],p1[1]);a=max3f(a,p1[2],p1[3]);
  #pragma unroll
  for(int r=4;r<16;r+=4){a=max3f(a,p0[r],p0[r+1]);b=max3f(b,p0[r+2],p0[r+3]);a=max3f(a,p1[r],p1[r+1]);b=max3f(b,p1[r+2],p1[r+3]);}
  const float m=max2f(a,b);
  auto rr=__builtin_amdgcn_permlane32_swap(__float_as_uint(m),__float_as_uint(m),false,false);
  return max2f(__uint_as_float(rr[0]),__uint_as_float(rr[1]));
}
__device__ __forceinline__ void pv(f32x16*o,int vb,bf16x8 pa0,bf16x8 pa1,bf16x8 pa2,bf16x8 pa3){
  #pragma unroll
  for(int d0=0;d0<2;++d0){s16x4 lo[4],hi[4];
    #pragma unroll
    for(int ks=0;ks<4;++ks){
      asm volatile("ds_read_b64_tr_b16 %0,%1 offset:%c2":"=&v"(lo[ks]):"v"(vb),"i"(d0*4096+ks*1024):"memory");
      asm volatile("ds_read_b64_tr_b16 %0,%1 offset:%c2":"=&v"(hi[ks]):"v"(vb),"i"(d0*4096+ks*1024+512):"memory");}
    asm volatile("s_waitcnt lgkmcnt(0)":::"memory");SBAR();
    #define PK(k) (bf16x8){lo[k][0],lo[k][1],lo[k][2],lo[k][3],hi[k][0],hi[k][1],hi[k][2],hi[k][3]}
    o[d0]=__builtin_amdgcn_mfma_f32_32x32x16_bf16(pa0,PK(0),o[d0],0,0,0);
    o[d0]=__builtin_amdgcn_mfma_f32_32x32x16_bf16(pa1,PK(1),o[d0],0,0,0);
    o[d0]=__builtin_amdgcn_mfma_f32_32x32x16_bf16(pa2,PK(2),o[d0],0,0,0);
    o[d0]=__builtin_amdgcn_mfma_f32_32x32x16_bf16(pa3,PK(3),o[d0],0,0,0);
    #undef PK
  }
}

#ifndef ATTN_STORE16
#define ATTN_STORE16(p,v) (*(u32x4*)(p)=(v))
#endif
typedef __attribute__((address_space(3))) const float* lds_fptr; typedef __attribute__((address_space(3))) const f32x4l* lds_f4ptr;
template<int THRL> __device__ __forceinline__ void attn_unit(int b,int h,int qb,const bf16*Q,const bf16*__restrict__ K,const bf16*__restrict__ V,bf16*O,const bf16*__restrict__ OG,lds_fptr cbl,float skipthr,char*shm){
  const int tid=threadIdx.x,lane=tid&63,r32=lane&31,hi=lane>>5; const int wid=__builtin_amdgcn_readfirstlane(tid>>6);
  const long rowbase=(long)b*SEQ; const int q0=qb*QB;
  const bf16*Qw=Q+(rowbase+q0+wid*QBLK)*DM+h*D;
  int t0; { const int NTf=(q0+QB)/KVBLK; const float need=cbl[q0]+skipthr; const bool keep=(lane<NTf)?(cbl[64*lane+63]>=need):true;
    const unsigned long long mk=__ballot(keep); int f=(int)__builtin_ctzll(mk); f&=~1; t0=f<NTf-4?f:NTf-4; t0=__builtin_amdgcn_readfirstlane(t0); }
  const bf16*Kh=K+(rowbase+(long)t0*KVBLK)*DM+h*D,*Vh=V+(rowbase+(long)t0*KVBLK)*DM+h*D;
  const unsigned lds0=(unsigned)(uintptr_t)shm;
  float*wsf=(float*)(shm+LDS_WS)+wid*64;
  const bf16*ksrc=Kh+(long)lane*DM+wid*8;
  const bf16*vsrc=Vh+(long)(16*(wid&3)+(lane>>2))*DM+(wid>>2)*32+(lane&3)*8;
  const unsigned kdst=lds0+LDS_K+wid*1024, vdst=lds0+LDS_V+wid*1024;
  #define DMA_K(t,slot) glds16(ksrc+(long)(t)*KVBLK*DM,(unsigned)__builtin_amdgcn_readfirstlane(kdst+(slot)))
  #define DMA_V(t,slot) glds16(vsrc+(long)(t)*KVBLK*DM,(unsigned)__builtin_amdgcn_readfirstlane(vdst+(slot)))
  const int vb0=(int)(lds0+LDS_V)+((lane>>4)&1)*32+(lane&3)*8+(4*hi+((lane&15)>>2))*64;
  const char*Kbase=shm+LDS_K; bf16x8 kf[8];
  const lds_cptr shm3=(lds_cptr)shm; const lds_cptr kp0=shm3+LDS_K+hi*1024+r32*16; const lds_cptr vp0=shm3+LDS_V+((lane>>4)&1)*32+(lane&3)*8+(4*hi+((lane&15)>>2))*64;
  const int NT=(q0+QB)/KVBLK-t0;
  DMA_K(0,0);DMA_V(0,0);DMA_K(1,SLOTB);
  bf16x8 qr[4];
  #pragma unroll
  for(int d0=0;d0<4;++d0)qr[d0]=*reinterpret_cast<const bf16x8*>(&Qw[(long)r32*DM+d0*16+hi*8]);
  float mhat=cbl[q0+wid*QBLK+r32],l_reg=0.f;f32x16 o[2];o[0]=f32x16{};o[1]=f32x16{};

  const lds_fptr cbh=cbl+64*t0+4*hi;
  #define CINIT(C0,C1,t) do{ const lds_fptr cb_=cbh+64*(t); _Pragma("unroll") for(int g_=0;g_<4;++g_){ const f32x4l x0_=*(lds_f4ptr)(cb_+8*g_), x1_=*(lds_f4ptr)(cb_+32+8*g_); \
      _Pragma("unroll") for(int j_=0;j_<4;++j_){ C0[4*g_+j_]=x0_[j_]-mhat; C1[4*g_+j_]=x1_[j_]-mhat; } } }while(0)
  const int qrel=wid*QBLK+r32;
  #define CMASK(P0,P1,t) do{int jb_=(t)-(NT-4); if(jb_>=0)cmask(P0,P1,jb_,qrel,hi);}while(0)
  bool resc=false;
  #define START(P0,P1) do{ resc=false; \
    _Pragma("unroll") for(int r=0;r<16;++r)P0[r]=__builtin_amdgcn_exp2f(P0[r]); }while(0)
  #define RESC() do{ if(resc){ asm volatile("s_waitcnt lgkmcnt(0)":::"memory"); \
      _Pragma("unroll") for(int d_=0;d_<2;++d_) _Pragma("unroll") for(int r=0;r<16;++r)o[d_][r]*=wsf[crow(r,hi)]; } }while(0)
  f32x16 pA0,pA1,pB0,pB1;
  int sl_prev=0,sl_cur=0,sl_next=SLOTB;
  #define ROT() do{sl_prev=sl_cur;sl_cur=sl_next;sl_next=(sl_next==(NSLOT-1)*SLOTB)?0:sl_next+SLOTB;}while(0)
  DMA_K(2,2*SLOTB);
  WAIT_BAR(3);
  CINIT(pA0,pA1,0); qkt(pA0,pA1,Kbase,qr,r32,hi);asm volatile("s_nop 15\n\ts_nop 7":"+v"(pA0),"+v"(pA1));CMASK(pA0,pA1,0);
  START(pA0,pA1);
  _Pragma("unroll") for(int r=0;r<16;++r)pA1[r]=__builtin_amdgcn_exp2f(pA1[r]);
  WAIT_BAR(0);
  DMA_K(3,0);DMA_V(1,SLOTB);
  ROT();
  kload8(kf,kp0+sl_cur);
  WAIT_BAR(2);
  s16x4 vlo[8],vhi[8]; u32x4 pw0,pw1,pw2,pw3;
  #define PKW(P,B) cvtpk_s(P[B],P[B+1])
  #define PAF(k) __builtin_bit_cast(bf16x8,pw##k)
  #define VFR(i) (bf16x8){vlo[i][0],vlo[i][1],vlo[i][2],vlo[i][3],vhi[i][0],vhi[i][1],vhi[i][2],vhi[i][3]}
  #define PIN(x) asm volatile("":"+v"(x))
  #define MX3(a,b,c) __builtin_fmaxf(__builtin_fmaxf((a),(b)),(c))
  #define GAPA(MF,A0,A1,A2,A3,W0,W1,PW) do{ MF; sacc+=A0; sacc+=A1; sacc+=A2; sacc+=A3; PIN(sacc); W0; W1; PIN(PW); SBAR(); }while(0)
  #define EX(v) __builtin_amdgcn_exp2f(v)
  #define GAPB(MF,X,B) do{ MF; X[B]=EX(X[B]); X[B+1]=EX(X[B+1]); X[B+2]=EX(X[B+2]); X[B+3]=EX(X[B+3]); PIN(X); SBAR(); }while(0)
  #define VRD(i) do{ vlo[i]=vtr(vp_+(((i)>>2)*4096+((i)&3)*1024)); vhi[i]=vtr(vp_+(((i)>>2)*4096+((i)&3)*1024+512)); }while(0)
  #define KRD(G,j) do{ if(G){ kload2(kf,kp0+sl_next,j); SBAR(); } }while(0)
  #define STEP(C0,C1,P0,P1,t,GK,GV,GL) do{ SBAR(); \
    const lds_cptr vp_=vp0+sl_prev; \
    CINIT(C0,C1,t); SBAR(); VRD(0); SBAR(); float sacc=(P0[0]+P0[1]); \
    GAPA(C0=__builtin_amdgcn_mfma_f32_32x32x16_bf16(kf[0],qr[0],C0,0,0,0), P0[2],P0[3],P0[4],P0[5],     pw0[0]=PKW(P0,0), pw0[1]=PKW(P0,2), pw0); \
    VRD(4); SBAR(); GAPA(C1=__builtin_amdgcn_mfma_f32_32x32x16_bf16(kf[1],qr[0],C1,0,0,0), P0[6],P0[7],P0[8],P0[9],     pw0[2]=PKW(P0,4), pw0[3]=PKW(P0,6), pw0); \
    VRD(1); SBAR(); GAPA(C0=__builtin_amdgcn_mfma_f32_32x32x16_bf16(kf[2],qr[1],C0,0,0,0),   P0[10],P0[11],P0[12],P0[13], pw1[0]=PKW(P0,8), pw1[1]=PKW(P0,10), pw1); \
    VRD(5); SBAR(); GAPA(C1=__builtin_amdgcn_mfma_f32_32x32x16_bf16(kf[3],qr[1],C1,0,0,0),   P0[14],P0[15],P1[0],P1[1],   pw1[2]=PKW(P0,12),pw1[3]=PKW(P0,14), pw1); \
    VRD(2); SBAR(); GAPA(C0=__builtin_amdgcn_mfma_f32_32x32x16_bf16(kf[4],qr[2],C0,0,0,0),   P1[2],P1[3],P1[4],P1[5],     pw2[0]=PKW(P1,0), pw2[1]=PKW(P1,2), pw2); \
    VRD(6); SBAR(); GAPA(C1=__builtin_amdgcn_mfma_f32_32x32x16_bf16(kf[5],qr[2],C1,0,0,0),   P1[6],P1[7],P1[8],P1[9],     pw2[2]=PKW(P1,4), pw2[3]=PKW(P1,6), pw2); \
    VRD(3); SBAR(); GAPA(C0=__builtin_amdgcn_mfma_f32_32x32x16_bf16(kf[6],qr[3],C0,0,0,0),   P1[10],P1[11],P1[12],P1[13], pw3[0]=PKW(P1,8), pw3[1]=PKW(P1,10), pw3); \
    VRD(7); SBAR(); GAPA(C1=__builtin_amdgcn_mfma_f32_32x32x16_bf16(kf[7],qr[3],C1,0,0,0),   P1[14],P1[15],0.f,0.f,       pw3[2]=PKW(P1,12),pw3[3]=PKW(P1,14), pw3); \
    l_reg+=sacc; \
    if(GK){DMA_K((t)+3,sl_cur);} if(GV){DMA_V((t)+1,sl_next);} \
    CMASK(C0,C1,t); \
    { float a=MX3(C0[0],C0[1],C1[0]),b=MX3(C0[2],C0[3],C1[1]); a=MX3(a,C1[2],C1[3]); \
      _Pragma("unroll") for(int r=4;r<16;r+=4){a=MX3(a,C0[r],C0[r+1]);b=MX3(b,C0[r+2],C0[r+3]);a=MX3(a,C1[r],C1[r+1]);b=MX3(b,C1[r+2],C1[r+3]);} \
      float rm=__builtin_fmaxf(a,b); { auto rr=__builtin_amdgcn_permlane32_swap(__float_as_uint(rm),__float_as_uint(rm),false,false); rm=__builtin_fmaxf(__uint_as_float(rr[0]),__uint_as_float(rr[1])); } \
      resc=false; \
      if(__builtin_expect(__any(rm>(float)THRL),0)){ const float dl=__builtin_fmaxf(rm,0.f); mhat+=dl; \
        _Pragma("unroll") for(int r=0;r<16;++r){C0[r]-=dl;C1[r]-=dl;} \
        const float f=__builtin_amdgcn_exp2f(-dl); l_reg*=f; if(hi==0)wsf[r32]=f; resc=true; } } \
    SBAR(); \
    GAPB(o[0]=__builtin_amdgcn_mfma_f32_32x32x16_bf16(PAF(0),VFR(0),o[0],0,0,0), C0,0); \
    GAPB(o[1]=__builtin_amdgcn_mfma_f32_32x32x16_bf16(PAF(0),VFR(4),o[1],0,0,0), C0,4); \
    KRD(GL,0); GAPB(o[0]=__builtin_amdgcn_mfma_f32_32x32x16_bf16(PAF(1),VFR(1),o[0],0,0,0), C0,8); \
    KRD(GL,1); GAPB(o[1]=__builtin_amdgcn_mfma_f32_32x32x16_bf16(PAF(1),VFR(5),o[1],0,0,0), C0,12); \
    KRD(GL,2); GAPB(o[0]=__builtin_amdgcn_mfma_f32_32x32x16_bf16(PAF(2),VFR(2),o[0],0,0,0), C1,0); \
    KRD(GL,3); GAPB(o[1]=__builtin_amdgcn_mfma_f32_32x32x16_bf16(PAF(2),VFR(6),o[1],0,0,0), C1,4); \
    GAPB(o[0]=__builtin_amdgcn_mfma_f32_32x32x16_bf16(PAF(3),VFR(3),o[0],0,0,0), C1,8); \
    GAPB(o[1]=__builtin_amdgcn_mfma_f32_32x32x16_bf16(PAF(3),VFR(7),o[1],0,0,0), C1,12); \
    }while(0)
  int t=1;
  #undef CMASK
  #define CMASK(P0,P1,t) do{}while(0)
  for(;t+5<NT;t+=2){
    STEP(pB0,pB1,pA0,pA1,t,true,true,true);     WAIT_BAR(2); RESC(); ROT();
    STEP(pA0,pA1,pB0,pB1,t+1,true,true,true);   WAIT_BAR(2); RESC(); ROT();
  }
  #undef CMASK
  #define CMASK(P0,P1,t) do{int jb_=(t)-(NT-4); if(jb_>=0)cmask(P0,P1,jb_,qrel,hi);}while(0)
  #define ENDW(tt) do{ if((tt)+3<NT){WAIT_BAR(2);} else if((tt)+2<NT){WAIT_BAR(1);} else {WAIT_BAR(0);} }while(0)
  for(;t+1<NT;t+=2){
    STEP(pB0,pB1,pA0,pA1,t,(t+3<NT),(t+1<NT),(t+1<NT));       ENDW(t);   RESC(); ROT();
    STEP(pA0,pA1,pB0,pB1,t+1,(t+4<NT),(t+2<NT),(t+2<NT));     ENDW(t+1); RESC(); ROT();
  }
  STEP(pB0,pB1,pA0,pA1,NT-1,false,false,false); RESC();
  { float sacc=pB0[0]+pB0[1]; _Pragma("unroll") for(int r=2;r<16;++r)sacc+=pB0[r]; _Pragma("unroll") for(int r=0;r<16;++r)sacc+=pB1[r]; l_reg+=sacc;
    pw0=(u32x4){PKW(pB0,0),PKW(pB0,2),PKW(pB0,4),PKW(pB0,6)};pw1=(u32x4){PKW(pB0,8),PKW(pB0,10),PKW(pB0,12),PKW(pB0,14)};pw2=(u32x4){PKW(pB1,0),PKW(pB1,2),PKW(pB1,4),PKW(pB1,6)};pw3=(u32x4){PKW(pB1,8),PKW(pB1,10),PKW(pB1,12),PKW(pB1,14)};
    SBAR(); pv(o,vb0+sl_cur,PAF(0),PAF(1),PAF(2),PAF(3)); }
  #undef PKW
  #undef PAF
  #undef VFR
  #undef PIN
  #undef MX3
  #undef GAPA
  #undef GAPB
  #undef EX
  #undef VRD
  #undef KRD
  #undef STEP
  #undef ENDW
  {auto rr=__builtin_amdgcn_permlane32_swap(__float_as_uint(l_reg),__float_as_uint(l_reg),false,false);l_reg=__uint_as_float(rr[0])+__uint_as_float(rr[1]);}
  if(hi==0)wsf[32+r32]=l_reg;asm volatile("s_waitcnt lgkmcnt(0)":::"memory");
  float rli[16];
  #pragma unroll
  for(int r=0;r<16;++r)rli[r]=__builtin_amdgcn_rcpf(wsf[32+crow(r,hi)]);
  bf16*Ow=O+(rowbase+q0+wid*QBLK)*DM+h*D; const bf16*OGw=OG+(rowbase+q0+wid*QBLK)*DM+h*D;
  { bf16*stg=(bf16*)(shm+LDS_OST)+wid*2048;
    #pragma unroll
    for(int r=0;r<16;++r){const int orow=crow(r,hi);
      #pragma unroll
      for(int d0=0;d0<2;++d0)stg[orow*64+d0*32+r32]=__float2bfloat16(o[d0][r]*rli[r]);}
    asm volatile("s_waitcnt lgkmcnt(0)":::"memory");
    #pragma unroll
    for(int i=0;i<4;++i){const int row=i*8+(lane>>3),ch=lane&7; u32x4 v=*(const u32x4*)(stg+row*64+ch*8); const u32x4 gt=*(const u32x4*)(OGw+(long)row*DM+ch*8);
      #pragma unroll
      for(int e=0;e<4;++e){ const float lo=__uint_as_float(v[e]<<16)*__uint_as_float(gt[e]<<16), hh=__uint_as_float(v[e]&0xffff0000u)*__uint_as_float(gt[e]&0xffff0000u); v[e]=cvtpk_s(lo,hh); }
      ATTN_STORE16(Ow+(long)row*DM+ch*8,v);} }
  asm volatile("s_waitcnt lgkmcnt(0)\n\ts_barrier":::"memory");
  #undef DMA_K
  #undef DMA_V
  #undef CMASK
  #undef START
  #undef RESC
  #undef ROT
  #undef CINIT
}
constexpr int ATTN_LDS_BYTES=LDS_BYTES;
struct AttnTensors { const bf16* Q; const bf16* K; const bf16* V; bf16* O; const bf16* OG; };
struct AttnUnit { int bh; int qb; };
struct StaticOrder {
  int vcu;
  __device__ __forceinline__ explicit StaticOrder(int vcu_):vcu(vcu_){}
#ifndef MK_ATTN_CONTIG
#define MK_ATTN_CONTIG 1
#endif
  __device__ __forceinline__ bool next(int i,AttnUnit&u)const{ if(i>=4)return false; u.bh=vcu>>2;
    if(MK_ATTN_CONTIG){ u.qb=4*(vcu&3)+i; } else { const int s0=2*(vcu&3); u.qb=(i==0)?15-s0:(i==1)?s0:(i==2)?14-s0:s0+1; } return true; }
  __device__ __forceinline__ void a_ready(const AttnUnit&)const{}
  __device__ __forceinline__ void done(const AttnUnit&)const{}
};
template<class Sched,int THRL=8> __device__ __forceinline__ void attn_phase(char*lds,lds_fptr cbl,float skipthr,const AttnTensors&T,const Sched&S){
  AttnUnit u;
  for(int i=0;S.next(i,u);++i){ S.a_ready(u); attn_unit<THRL>(u.bh/NHEAD,u.bh%NHEAD,u.qb,T.Q,T.K,T.V,T.O,T.OG,cbl,skipthr,lds); S.done(u); }
}
#undef SBAR
#undef WAIT_BAR
}
namespace mx {
#define MLAS __attribute__((address_space(3)))
typedef unsigned short bf16_t;
typedef short bf16x8 __attribute__((ext_vector_type(8)));
typedef float f32x16 __attribute__((ext_vector_type(16)));
typedef float f32x4 __attribute__((ext_vector_type(4)));
typedef unsigned u32x4 __attribute__((ext_vector_type(4)));
typedef unsigned u32x2 __attribute__((ext_vector_type(2)));
constexpr float L2E = 1.4426950408889634f;
constexpr int ZP = 2560;
constexpr int PV = 136, PK = 72;
constexpr int GP = 65;

__device__ __forceinline__ unsigned pk2(float lo, float hi) { unsigned r; asm("v_cvt_pk_bf16_f32 %0, %1, %2" : "=v"(r) : "v"(lo), "v"(hi)); return r; }
__device__ __forceinline__ bf16_t f2bf(float f) { return (bf16_t)(pk2(f, 0.f) & 0xffffu); }
__device__ __forceinline__ float bf2f(bf16_t b) { return __uint_as_float((unsigned)b << 16); }
__device__ __forceinline__ float blo(unsigned w) { return __uint_as_float(w << 16); }
__device__ __forceinline__ float bhi(unsigned w) { return __uint_as_float(w & 0xffff0000u); }
__device__ __forceinline__ float ex(float x) { return __builtin_amdgcn_exp2f(L2E * x); }
__device__ __forceinline__ f32x16 mma32(bf16x8 a, bf16x8 b, f32x16 c) { return __builtin_amdgcn_mfma_f32_32x32x16_bf16(a, b, c, 0, 0, 0); }
__device__ __forceinline__ float wsum(float v) {
#pragma unroll
    for (int o = 32; o; o >>= 1) v += __shfl_xor(v, o);
    return v; }

template <int NF>
__device__ __forceinline__ void stage_T(MLAS bf16_t* T, int P, const bf16_t* src, int pitch, int base, int col0, int tid) {
    for (int c = tid; c < 128 * (NF / 8); c += 512) { const int s = c & 127, fc = c >> 7;
        const u32x4 w = *(const u32x4*)(src + (size_t)(base + s) * pitch + col0 + fc * 8);
#pragma unroll
        for (int e = 0; e < 4; ++e) { T[(fc * 8 + 2 * e) * P + s] = (bf16_t)(w[e] & 0xffffu); T[(fc * 8 + 2 * e + 1) * P + s] = (bf16_t)(w[e] >> 16); } }
}
template <int NF>
__device__ __forceinline__ void stage_T_ld(u32x4 (&w)[NF / 32], const bf16_t* src, int pitch, int base, int col0, int tid) {
#pragma unroll
    for (int j = 0; j < NF / 32; ++j) { const int c = tid + 512 * j, s = c & 127, fc = c >> 7; w[j] = *(const u32x4*)(src + (size_t)(base + s) * pitch + col0 + fc * 8); }
}
template <int NF>
__device__ __forceinline__ void stage_T_st(MLAS bf16_t* T, int P, const u32x4 (&w)[NF / 32], int tid) {
#pragma unroll
    for (int j = 0; j < NF / 32; ++j) { const int c = tid + 512 * j, s = c & 127, fc = c >> 7;
#pragma unroll
        for (int e = 0; e < 4; ++e) { T[(fc * 8 + 2 * e) * P + s] = (bf16_t)(w[j][e] & 0xffffu); T[(fc * 8 + 2 * e + 1) * P + s] = (bf16_t)(w[j][e] >> 16); } }
}
__device__ __forceinline__ void gla_cumsum_ld(float (&la)[16], const float* loga, int base, int h, int tid) {
    const int kk = tid & 63, seg = tid >> 6;
#pragma unroll
    for (int i = 0; i < 16; ++i) la[i] = loga[(size_t)(base + seg * 16 + i) * 256 + h * 64 + kk];
}
__device__ __forceinline__ void gla_cumsum_st(MLAS float* G, MLAS float* SEG, const float (&la)[16], int tid) {
    const int kk = tid & 63, seg = tid >> 6; float v[16]; float run = 0.f;
#pragma unroll
    for (int i = 0; i < 16; ++i) { run += la[i]; v[i] = run; }
    SEG[seg * 64 + kk] = run;
    __syncthreads();
    float pre = 0.f;
#pragma unroll
    for (int s = 0; s < 8; ++s) pre += (s < seg) ? SEG[s * 64 + kk] : 0.f;
#pragma unroll
    for (int i = 0; i < 16; ++i) G[(seg * 16 + i) * GP + kk] = v[i] + pre;
    __syncthreads();
}
__device__ __forceinline__ void gla_cumsum(MLAS float* G, MLAS float* SEG, const float* loga, int base, int h, int tid) {
    const int kk = tid & 63, seg = tid >> 6; float v[16]; float run = 0.f;
#pragma unroll
    for (int i = 0; i < 16; ++i) { run += loga[(size_t)(base + seg * 16 + i) * 256 + h * 64 + kk]; v[i] = run; }
    SEG[seg * 64 + kk] = run;
    __syncthreads();
    float pre = 0.f;
#pragma unroll
    for (int s = 0; s < 8; ++s) pre += (s < seg) ? SEG[s * 64 + kk] : 0.f;
#pragma unroll
    for (int i = 0; i < 16; ++i) G[(seg * 16 + i) * GP + kk] = v[i] + pre;
    __syncthreads();
}

__device__ __forceinline__ void gmlp_unit(MLAS unsigned char* lds, int chunk, int g, const bf16_t* Z, const float* vstp, const float* ln_g, const float* ln_b,
                                          const bf16_t* WSt, const float* b_s, bf16_t* MIX, int tid) {
    MLAS bf16_t* VT = (MLAS bf16_t*)lds;
    MLAS float* MU = (MLAS float*)(lds + 34816); MLAS float* RS = MU + 128;
    const int base = chunk * 128, lane = tid & 63, w = tid >> 6, r32 = lane & 31, hi = lane >> 5;
    bf16x8 wa[8];
    { const bf16_t* wrow = WSt + ((size_t)g * 128 + (w >> 1) * 32 + r32) * 128 + 8 * hi;
#pragma unroll
        for (int ks = 0; ks < 8; ++ks) wa[ks] = *(const bf16x8*)(wrow + 16 * ks); }
    u32x4 vw[4];
#pragma unroll
    for (int j = 0; j < 4; ++j) { const int c = tid + 512 * j, s = c & 127, dc = c >> 7; vw[j] = *(const u32x4*)(Z + (size_t)(base + s) * ZP + 512 + g * 128 + dc * 8); }
    const int it = w >> 1, jt0 = 2 * (w & 1);
    bf16_t u0[16], u1[16]; float bs[16];
    { const int d0 = jt0 * 32 + r32;
#pragma unroll
        for (int r = 0; r < 16; ++r) { const int t = it * 32 + (r & 3) + 8 * (r >> 2) + 4 * hi; const size_t zo = (size_t)(base + t) * ZP + g * 128; bs[r] = b_s[g * 128 + t]; u0[r] = Z[zo + d0]; u1[r] = Z[zo + d0 + 32]; } }
    if (tid < 128) { const f32x4* q = (const f32x4*)(vstp + (size_t)(base + tid) * 16); const f32x4 a = q[0], b = q[1], c = q[2], d = q[3];
        const float s1 = ((a[0] + a[1]) + (a[2] + a[3])) + ((b[0] + b[1]) + (b[2] + b[3])), s2 = ((c[0] + c[1]) + (c[2] + c[3])) + ((d[0] + d[1]) + (d[2] + d[3])); const float mu = s1 * (1.f / 512.f);
        const float var = fmaxf(s2 * (1.f / 512.f) - mu * mu, 0.f); MU[tid] = mu; RS[tid] = 1.0f / sqrtf(var + 1e-6f); }
    __syncthreads();
#pragma unroll
    for (int j = 0; j < 4; ++j) { const int c = tid + 512 * j, s = c & 127, dc = c >> 7;
        const u32x4 wv = vw[j];
        const float mu = MU[s], rs = RS[s];
        const f32x4 g0 = *(const f32x4*)(ln_g + g * 128 + dc * 8), g1 = *(const f32x4*)(ln_g + g * 128 + dc * 8 + 4);
        const f32x4 b0 = *(const f32x4*)(ln_b + g * 128 + dc * 8), b1 = *(const f32x4*)(ln_b + g * 128 + dc * 8 + 4);
        const float gg[8] = {g0[0], g0[1], g0[2], g0[3], g1[0], g1[1], g1[2], g1[3]}, bb[8] = {b0[0], b0[1], b0[2], b0[3], b1[0], b1[1], b1[2], b1[3]};
#pragma unroll
        for (int e = 0; e < 4; ++e) { const unsigned p = pk2((blo(wv[e]) - mu) * rs * gg[2 * e] + bb[2 * e], (bhi(wv[e]) - mu) * rs * gg[2 * e + 1] + bb[2 * e + 1]);
            VT[(dc * 8 + 2 * e) * PV + s] = (bf16_t)(p & 0xffffu); VT[(dc * 8 + 2 * e + 1) * PV + s] = (bf16_t)(p >> 16); } }
    __syncthreads();
    f32x16 acc0 = {}, acc1 = {};
    const MLAS bf16_t* v0 = VT + (jt0 * 32 + r32) * PV + 8 * hi; const MLAS bf16_t* v1 = v0 + 32 * PV;
#pragma unroll
    for (int ks = 0; ks < 8; ++ks) acc0 = mma32(wa[ks], *(const MLAS bf16x8*)(v0 + 16 * ks), acc0);
#pragma unroll
    for (int ks = 0; ks < 8; ++ks) acc1 = mma32(wa[ks], *(const MLAS bf16x8*)(v1 + 16 * ks), acc1);
    { const int d0 = jt0 * 32 + r32;
#pragma unroll
        for (int r = 0; r < 16; ++r) { const int t = it * 32 + (r & 3) + 8 * (r >> 2) + 4 * hi; const size_t mo = (size_t)(base + t) * 1024 + g * 128;
            MIX[mo + d0] = f2bf(bf2f(u0[r]) * (acc0[r] + bs[r])); MIX[mo + d0 + 32] = f2bf(bf2f(u1[r]) * (acc1[r] + bs[r])); } }
    __syncthreads();
}

__device__ __forceinline__ void gla_u_unit(MLAS unsigned char* lds, int cidx, int h, const bf16_t* Z, const float* loga, float* Ut, float* DEC, int tid) {
    MLAS float* G = (MLAS float*)lds; MLAS float* SEG = (MLAS float*)(lds + 33280);
    MLAS bf16_t* KT = (MLAS bf16_t*)(lds + 35328); MLAS bf16_t* VT = (MLAS bf16_t*)(lds + 52736);
    const int base = cidx * 128, unit = cidx * 4 + h, lane = tid & 63, w = tid >> 6, r32 = lane & 31, hi = lane >> 5;
    float la[16]; u32x4 kw[2], vw[4];
    gla_cumsum_ld(la, loga, base, h, tid);
#pragma unroll
    for (int j = 0; j < 2; ++j) { const int c = tid + 512 * j, s = c & 127, kc = c >> 7; kw[j] = *(const u32x4*)(Z + (size_t)(base + s) * ZP + 1280 + h * 64 + kc * 8); }
    stage_T_ld<128>(vw, Z, ZP, base, 1536 + h * 128, tid);
    stage_T_st<128>(VT, PV, vw, tid);
    gla_cumsum_st(G, SEG, la, tid);
#pragma unroll
    for (int j = 0; j < 2; ++j) { const int c = tid + 512 * j, s = c & 127, kc = c >> 7; const u32x4 wv = kw[j];
#pragma unroll
        for (int e = 0; e < 4; ++e) { const int k0 = kc * 8 + 2 * e;
            const unsigned p = pk2(blo(wv[e]) * ex(G[127 * GP + k0] - G[s * GP + k0]), bhi(wv[e]) * ex(G[127 * GP + k0 + 1] - G[s * GP + k0 + 1]));
            KT[k0 * PV + s] = (bf16_t)(p & 0xffffu); KT[(k0 + 1) * PV + s] = (bf16_t)(p >> 16); } }
    if (tid < 64) DEC[unit * 64 + tid] = ex(G[127 * GP + tid]);
    __syncthreads();
    const int vt = w >> 1, kt = w & 1; f32x16 acc = {};
    const MLAS bf16_t* ap = VT + (vt * 32 + r32) * PV + 8 * hi; const MLAS bf16_t* bp = KT + (kt * 32 + r32) * PV + 8 * hi;
#pragma unroll
    for (int ks = 0; ks < 8; ++ks) acc = mma32(*(const MLAS bf16x8*)(ap + 16 * ks), *(const MLAS bf16x8*)(bp + 16 * ks), acc);
#pragma unroll
    for (int r = 0; r < 16; ++r) { const int vv = vt * 32 + (r & 3) + 8 * (r >> 2) + 4 * hi; Ut[((size_t)unit * 128 + vv) * 64 + kt * 32 + r32] = acc[r]; }
    __syncthreads();
}
__device__ __forceinline__ void gla_scan(const float* Ut, const float* DEC, bf16_t* STt, int gtid, int gthreads) {
    for (int e = gtid; e < 16 * 128 * 64; e += gthreads) { const int kk = e & 63, vv = (e >> 6) & 127, bh = e >> 13, b = bh >> 2, h = bh & 3; float S = 0.f;
        float uu[32], dd[32];
#pragma unroll
        for (int n = 0; n < 32; ++n) { const int unit = (b * 32 + n) * 4 + h; uu[n] = Ut[((size_t)unit * 128 + vv) * 64 + kk]; dd[n] = DEC[unit * 64 + kk]; }
#pragma unroll
        for (int n = 0; n < 32; ++n) { const int unit = (b * 32 + n) * 4 + h; STt[((size_t)unit * 128 + vv) * 64 + kk] = f2bf(S); S = dd[n] * S + uu[n]; } }
}
__device__ __forceinline__ void gla_out_unit(MLAS unsigned char* lds, int cidx, int h, const bf16_t* Z, const float* loga, const bf16_t* STt, const float* head_g, bf16_t* MIX, int tid) {
    MLAS float* G = (MLAS float*)lds; MLAS bf16_t* AT = (MLAS bf16_t*)lds;
    MLAS float* SEG = (MLAS float*)(lds + 34816);
    MLAS bf16_t* QS = (MLAS bf16_t*)(lds + 36864); MLAS bf16_t* KS = (MLAS bf16_t*)(lds + 55296);
    MLAS bf16_t* VT = (MLAS bf16_t*)(lds + 73728);
    MLAS bf16_t* ST = (MLAS bf16_t*)(lds + 108544);
    MLAS float* RSQ = (MLAS float*)(lds + 126976);
    const int base = cidx * 128, unit = cidx * 4 + h, lane = tid & 63, w = tid >> 6, r32 = lane & 31, hi = lane >> 5;
    float la[16]; u32x4 qw[2], kw[2], vw[4], sw[2];
    gla_cumsum_ld(la, loga, base, h, tid);
#pragma unroll
    for (int j = 0; j < 2; ++j) { const int c = tid + 512 * j, s = c & 127, kc = c >> 7;
        qw[j] = *(const u32x4*)(Z + (size_t)(base + s) * ZP + 1024 + h * 64 + kc * 8); kw[j] = *(const u32x4*)(Z + (size_t)(base + s) * ZP + 1280 + h * 64 + kc * 8);
        const int c2 = tid + 512 * j, vv = c2 >> 3, kc2 = c2 & 7; sw[j] = *(const u32x4*)(STt + ((size_t)unit * 128 + vv) * 64 + kc2 * 8); }
    stage_T_ld<128>(vw, Z, ZP, base, 1536 + h * 128, tid);
    const int tt = w >> 1, t = tt * 32 + r32, vt0 = 2 * (w & 1);
    f32x4 hgv[2][4]; u32x2 sgv[2][4];
#pragma unroll
    for (int jj = 0; jj < 2; ++jj)
#pragma unroll
        for (int rq = 0; rq < 4; ++rq) { const int vv0 = (vt0 + jj) * 32 + 8 * rq + 4 * hi; hgv[jj][rq] = *(const f32x4*)(head_g + h * 128 + vv0); sgv[jj][rq] = *(const u32x2*)(Z + (size_t)(base + t) * ZP + 2048 + h * 128 + vv0); }
    stage_T_st<128>(VT, PV, vw, tid);
    gla_cumsum_st(G, SEG, la, tid);
#pragma unroll
    for (int j = 0; j < 2; ++j) { const int c = tid + 512 * j, s = c & 127, kc = c >> 7;
        const u32x4 qv = qw[j], kv = kw[j];
        u32x4 qo, ko;
#pragma unroll
        for (int e = 0; e < 4; ++e) { const int k0 = kc * 8 + 2 * e; const float d0 = G[s * GP + k0] - G[63 * GP + k0], d1 = G[s * GP + k0 + 1] - G[63 * GP + k0 + 1];
            qo[e] = pk2(blo(qv[e]) * ex(d0), bhi(qv[e]) * ex(d1)); ko[e] = pk2(blo(kv[e]) * ex(-d0), bhi(kv[e]) * ex(-d1)); }
        *(MLAS u32x4*)(QS + s * PK + kc * 8) = qo; *(MLAS u32x4*)(KS + s * PK + kc * 8) = ko; }
#pragma unroll
    for (int j = 0; j < 2; ++j) { const int c = tid + 512 * j, vv = c >> 3, kc = c & 7; const u32x4 sv = sw[j]; u32x4 so;
#pragma unroll
        for (int e = 0; e < 4; ++e) { const int k0 = kc * 8 + 2 * e; so[e] = pk2(blo(sv[e]) * ex(G[63 * GP + k0]), bhi(sv[e]) * ex(G[63 * GP + k0 + 1])); }
        *(MLAS u32x4*)(ST + vv * PK + kc * 8) = so; }
    __syncthreads();
#pragma unroll
    for (int q2 = 0; q2 < 2; ++q2) { const int st = (w & 1) + 2 * q2;
        if (st <= tt) { f32x16 acc = {}; const MLAS bf16_t* ap = KS + (st * 32 + r32) * PK + 8 * hi; const MLAS bf16_t* bp = QS + t * PK + 8 * hi;
#pragma unroll
            for (int ks = 0; ks < 4; ++ks) acc = mma32(*(const MLAS bf16x8*)(ap + 16 * ks), *(const MLAS bf16x8*)(bp + 16 * ks), acc);
#pragma unroll
            for (int rq = 0; rq < 4; ++rq) { const int s0 = st * 32 + 8 * rq + 4 * hi; float x[4];
#pragma unroll
                for (int j = 0; j < 4; ++j) x[j] = (s0 + j <= t) ? acc[4 * rq + j] : 0.f;
                u32x2 pw; pw.x = pk2(x[0], x[1]); pw.y = pk2(x[2], x[3]); *(MLAS u32x2*)(AT + t * PV + s0) = pw; } } }
    __syncthreads();
    f32x16 acc0 = {}, acc1 = {};
    { const MLAS bf16_t* bp = AT + t * PV + 8 * hi; const MLAS bf16_t* a0 = VT + (vt0 * 32 + r32) * PV + 8 * hi; const MLAS bf16_t* a1 = a0 + 32 * PV; const int nks = 2 * (tt + 1);
        for (int ks = 0; ks < nks; ++ks) { const bf16x8 b = *(const MLAS bf16x8*)(bp + 16 * ks); acc0 = mma32(*(const MLAS bf16x8*)(a0 + 16 * ks), b, acc0); acc1 = mma32(*(const MLAS bf16x8*)(a1 + 16 * ks), b, acc1); } }
    { const MLAS bf16_t* bp = QS + t * PK + 8 * hi; const MLAS bf16_t* a0 = ST + (vt0 * 32 + r32) * PK + 8 * hi; const MLAS bf16_t* a1 = a0 + 32 * PK;
#pragma unroll
        for (int ks = 0; ks < 4; ++ks) { const bf16x8 b = *(const MLAS bf16x8*)(bp + 16 * ks); acc0 = mma32(*(const MLAS bf16x8*)(a0 + 16 * ks), b, acc0); acc1 = mma32(*(const MLAS bf16x8*)(a1 + 16 * ks), b, acc1); } }
    float ss = 0.f;
#pragma unroll
    for (int r = 0; r < 16; ++r) ss += acc0[r] * acc0[r] + acc1[r] * acc1[r];
    ss += __shfl_xor(ss, 32);
    if (hi == 0) RSQ[t * 2 + (w & 1)] = ss;
    __syncthreads();
    const float rstd = __builtin_amdgcn_rsqf((RSQ[t * 2] + RSQ[t * 2 + 1]) * (1.f / 128.f) + 1e-6f);
#pragma unroll
    for (int jj = 0; jj < 2; ++jj)
#pragma unroll
        for (int rq = 0; rq < 4; ++rq) { const int vv0 = (vt0 + jj) * 32 + 8 * rq + 4 * hi;
            const f32x4 hg = hgv[jj][rq]; const u32x2 sg = sgv[jj][rq];
            float x[4];
#pragma unroll
            for (int j = 0; j < 4; ++j) x[j] = (jj == 0 ? acc0[4 * rq + j] : acc1[4 * rq + j]) * rstd * hg[j];
            u32x2 pw; pw.x = pk2(x[0] * blo(sg.x), x[1] * bhi(sg.x)); pw.y = pk2(x[2] * blo(sg.y), x[3] * bhi(sg.y));
            *(u32x2*)(MIX + (size_t)(base + t) * 1024 + 512 + h * 128 + vv0) = pw; }
    __syncthreads();
}

__device__ __forceinline__ void fgate_block(MLAS unsigned char* lds, int blk, const bf16_t* XB, const bf16_t* Wft, const float* ssq, const float* fb, float* LFC, float* BT, int tid) {
    typedef float f32x4_ __attribute__((ext_vector_type(4)));
    MLAS float* LF = (MLAS float*)lds;
    const int lane = tid & 63, w = tid >> 6, tg = w & 3, kh = w >> 2;
    f32x4_ pa[2][4]; float fbv[2];
#pragma unroll
    for (int j = 0; j < 2; ++j) { const int i = tid + 512 * j, tok = i >> 4, hh = i & 15; const f32x4_* q = (const f32x4_*)(ssq + (size_t)(64 * blk + tok) * 16);
        pa[j][0] = q[0]; pa[j][1] = q[1]; pa[j][2] = q[2]; pa[j][3] = q[3]; fbv[j] = fb[hh]; }
    { f32x4_ acc = {0.f, 0.f, 0.f, 0.f};
        const bf16_t* ap = XB + (size_t)(64 * blk + 16 * tg + (lane & 15)) * 1024 + 512 * kh + 8 * (lane >> 4); const bf16_t* bp = Wft + (size_t)(lane & 15) * 1024 + 512 * kh + 8 * (lane >> 4);
        bf16x8 av[16], bv[16];
#pragma unroll
        for (int ks = 0; ks < 16; ++ks) { av[ks] = *(const bf16x8*)(ap + 32 * ks); bv[ks] = *(const bf16x8*)(bp + 32 * ks); }
#pragma unroll
        for (int ks = 0; ks < 16; ++ks) acc = __builtin_amdgcn_mfma_f32_16x16x32_bf16(av[ks], bv[ks], acc, 0, 0, 0);
#pragma unroll
        for (int r = 0; r < 4; ++r) LF[kh * 1024 + (16 * tg + 4 * (lane >> 4) + r) * 16 + (lane & 15)] = acc[r]; }
    __syncthreads();
#pragma unroll
    for (int j = 0; j < 2; ++j) { const int i = tid + 512 * j; const f32x4_ a = pa[j][0], b = pa[j][1], c = pa[j][2], d = pa[j][3];
        const float ss = (((a[0] + a[1]) + (a[2] + a[3])) + ((b[0] + b[1]) + (b[2] + b[3]))) + (((c[0] + c[1]) + (c[2] + c[3])) + ((d[0] + d[1]) + (d[2] + d[3])));
        LF[i] = pg8::log_sigmoid_f((LF[i] + LF[1024 + i]) * __builtin_amdgcn_rsqf(ss * (1.f / 1024.f) + 1e-6f) + fbv[j]); }
    __syncthreads();
    if (tid < 16) { const int b = blk >> 6, bl = blk & 63; float c = 0.f; float* dst = LFC + (size_t)(b * 16 + tid) * 4096 + bl * 64;
        for (int t = 0; t < 64; ++t) { c += LF[t * 16 + tid]; dst[t] = c; }
        BT[(b * 16 + tid) * 64 + bl] = c; }
    __syncthreads();
}
__device__ __forceinline__ void attn_bias(MLAS float* CB, MLAS float* OFF, int bh, const float* LFC, const float* BT, int tid) {
    float lf[8];
#pragma unroll
    for (int i = 0; i < 8; ++i) lf[i] = LFC[(size_t)bh * 4096 + tid + 512 * i];
    if (tid < 64) { const float v = BT[bh * 64 + tid]; float x = v;
#pragma unroll
        for (int o = 1; o < 64; o <<= 1) { const float y = __shfl_up(x, o); if (tid >= o) x += y; }
        OFF[tid] = x - v; }
    __syncthreads();
#pragma unroll
    for (int i = 0; i < 8; ++i) { const int s = tid + 512 * i; CB[s] = -(lf[i] + OFF[s >> 6]) * L2E; }
    __syncthreads();
}
}
typedef unsigned v2u __attribute__((ext_vector_type(2)));
#ifndef MK_WGM_IN0
#define MK_WGM_IN0 4
#endif
#ifndef MK_WGM_FFN1
#define MK_WGM_FFN1 4
#endif
#ifndef MK_WGM_IN1
#define MK_WGM_IN1 4
#endif
#ifndef MK_WGM_MOE1
#define MK_WGM_MOE1 4
#endif
#ifndef MK_ALIGN1
#define MK_ALIGN1 true
#endif
#ifndef MK_ALIGN
#define MK_ALIGN true
#endif
constexpr int NWAVES = 8;
constexpr int M = 16384, D = 1024, SEQ = 4096;
constexpr size_t MiB = 1u << 20, KiB = 1u << 10;
constexpr size_t WS_CTL = 0, CTL_ZERO_BYTES = 64 * KiB;
constexpr size_t WS_WE13 = 2 * MiB;
constexpr size_t WS_Y = 2 * MiB, WS_YP = 72 * MiB;
constexpr size_t WS_WE2 = 114 * MiB;
constexpr size_t WS_W0IN = 170 * MiB, WS_W0O = 176 * MiB, WS_W0F13 = 178 * MiB, WS_W0F2 = 189 * MiB, WS_W1IN = 195 * MiB, WS_W1O = 203 * MiB;
constexpr size_t WS_ACTE = 170 * MiB;
constexpr size_t WS_Z0 = 205 * MiB, WS_LOGA = 285 * MiB, WS_UT = 301 * MiB, WS_STT = 317 * MiB, WS_MIX = 325 * MiB;
constexpr size_t WS_SSQP1 = 360 * MiB, WS_SSQP2 = 361 * MiB, WS_VSTP = 362 * MiB;
constexpr size_t WS_ACT0 = 205 * MiB;
constexpr size_t WS_Q = 205 * MiB, WS_TSTRIDE = 32 * MiB;
constexpr size_t WS_TAB = 408 * MiB;
constexpr size_t TB_SSQ0 = WS_TAB, TB_DEC = WS_TAB + 64 * KiB, TB_LFC = WS_TAB + 256 * KiB, TB_BT = WS_TAB + 1280 * KiB, TB_ROWTOK = WS_TAB + 1536 * KiB, TB_ROWR = WS_TAB + 2048 * KiB,
                 TB_ROWW = WS_TAB + 2560 * KiB, TB_TOKINFO = WS_TAB + 3072 * KiB, TB_WST = WS_TAB + 3328 * KiB, TB_WFT = WS_TAB + 3456 * KiB, TB_GRH = WS_TAB + 3488 * KiB;
constexpr size_t WS_XB = 434 * MiB, WS_END = 466 * MiB;
constexpr size_t CT_BAR = 16 * KiB, CT_CNT = 48 * KiB, CT_QCTR = 52 * KiB;
constexpr int RING_BYTES = 131072, LDSCTL_OFF = RING_BYTES, MISC_OFF = LDSCTL_OFF + 320, TAB_OFF = LDSCTL_OFF + 512;
constexpr int LDS_BYTES = 147456;
constexpr int ATT_CB_OFF = 86016, ATT_OFF_OFF = 102400;

enum { IN_X = 0, IN_E_NMIX, IN_E_WIN, IN_E_GUP, IN_E_GBIAS, IN_E_WS, IN_E_BS, IN_E_LNG, IN_E_LNB, IN_E_HG, IN_E_WO, IN_E_NFFN, IN_E_W1, IN_E_W3, IN_E_W2,
       IN_O_NMIX, IN_O_WIN, IN_O_FB, IN_O_QG, IN_O_KG, IN_O_WO, IN_O_NFFN, IN_O_ROUTER, IN_O_W1, IN_O_W3, IN_O_W2, IN_FINAL, N_IN };

__device__ __forceinline__ float wave_sum(float v) {
#pragma unroll
    for (int o = 1; o < 64; o <<= 1) v += __shfl_xor(v, o);
    return v; }
template <int NB>
__device__ __forceinline__ void tr_item(const float* W, int ldw, int c0, int K, const float* gain, bf16* WT, int drow0, LAS float* scr, int kb, int lane) {
    const int k0 = 64 * kb;
    const float* wp = W + (size_t)(k0 + (lane >> 5)) * ldw + c0 + (lane & 31);
#pragma unroll
    for (int b = 0; b < 32 / NB; ++b) { float v[NB];
#pragma unroll
        for (int i = 0; i < NB; ++i) v[i] = __builtin_nontemporal_load(wp + (size_t)(2 * (b * NB + i)) * ldw);
        if (gain) {
#pragma unroll
            for (int i = 0; i < NB; ++i) v[i] *= gain[k0 + 2 * (b * NB + i) + (lane >> 5)]; }
#pragma unroll
        for (int i = 0; i < NB; ++i) scr[(2 * (b * NB + i) + (lane >> 5)) * 33 + (lane & 31)] = v[i];
        if (NB < 32) asm volatile("" ::: "memory"); }
    LDS_WAIT(); asm volatile("" ::: "memory");
    const int c = lane & 7;
#pragma unroll
    for (int j = 0; j < 4; ++j) { const int n = (lane >> 3) + 8 * j; const LAS float* s = scr + (8 * c) * 33 + n;
        v4u o; o.x = pk2(s[0 * 33], s[1 * 33]); o.y = pk2(s[2 * 33], s[3 * 33]); o.z = pk2(s[4 * 33], s[5 * 33]); o.w = pk2(s[6 * 33], s[7 * 33]);
        __builtin_nontemporal_store(o, (GAS v4u*)(WT + (size_t)(drow0 + n) * K + k0 + 8 * c)); }
    LDS_WAIT(); asm volatile("" ::: "memory");
}
#ifndef MK_W2_NT
#define MK_W2_NT 1
#endif
__device__ __forceinline__ void tr_item_pair(const float* W, int ldw, int c0, int K, const float* gain, bf16* WT, int drow0, LAS float* scr, int kb, int lane) {
    const int k0 = 64 * kb;
    const float* wp = W + (size_t)(k0 + (lane >> 5)) * ldw + c0 + (lane & 31);
    float v0[32], v1[32];
#pragma unroll
    for (int i = 0; i < 32; ++i) { v0[i] = __builtin_nontemporal_load(wp + (size_t)(2 * i) * ldw); v1[i] = __builtin_nontemporal_load(wp + (size_t)(2 * i) * ldw + 32); }
    if (gain) {
#pragma unroll
        for (int i = 0; i < 32; ++i) { const float g = gain[k0 + 2 * i + (lane >> 5)]; v0[i] *= g; v1[i] *= g; } }
    const int c = lane & 7;
#pragma unroll
    for (int h = 0; h < 2; ++h) {
#pragma unroll
        for (int i = 0; i < 32; ++i) scr[(2 * i + (lane >> 5)) * 33 + (lane & 31)] = h ? v1[i] : v0[i];
        LDS_WAIT(); asm volatile("" ::: "memory");
#pragma unroll
        for (int j = 0; j < 4; ++j) { const int n = (lane >> 3) + 8 * j; const LAS float* s = scr + (8 * c) * 33 + n;
            v4u o; o.x = pk2(s[0 * 33], s[1 * 33]); o.y = pk2(s[2 * 33], s[3 * 33]); o.z = pk2(s[4 * 33], s[5 * 33]); o.w = pk2(s[6 * 33], s[7 * 33]);
#if MK_W2_NT
            __builtin_nontemporal_store(o, (GAS v4u*)(WT + (size_t)(drow0 + 32 * h + n) * K + k0 + 8 * c)); }
#else
            *(GAS v4u*)(WT + (size_t)(drow0 + 32 * h + n) * K + k0 + 8 * c) = o; }
#endif
        LDS_WAIT(); asm volatile("" ::: "memory"); }
}
enum { MAP_PLAIN = 0, MAP_GLU = 1, MAP_HEAD = 2 };
template <int MAP, int NB = 32>
__device__ __forceinline__ void tr_job(const float* W, int ldw, int c0, int ncols, int K, const float* gain, bf16* WT, int dbase, LAS float* scr, int r, int lane) {
    const int nblk = ncols / 32, kb = r / nblk, n0 = 32 * (r % nblk); int drow;
    if (MAP == MAP_PLAIN) drow = dbase + n0;
    else if (MAP == MAP_GLU) drow = dbase + (n0 >> 7) * 256 + (n0 & 127);
    else { const int head = n0 >> 6, d = n0 & 63; drow = dbase + 256 * (head >> 2) + 128 * (d >> 5) + 32 * (head & 3) + (d & 31); }
    tr_item<NB>(W, ldw, c0 + n0, K, gain, WT, drow, scr, kb, lane);
}

constexpr int MOE_IE = 1792, MOE_A_ITEMS = 8 * 2 * MOE_IE, MOE_B_ITEMS = 8 * MOE_IE;
#ifndef MK_QB0
#define MK_QB0 0
#endif
constexpr int MOE_QB0 = MK_QB0;
#ifndef MK_IDLE_ITEMS
#define MK_IDLE_ITEMS 10
#endif
#ifndef MK_IDLE_IN0
#define MK_IDLE_IN0 MK_IDLE_ITEMS
#endif
#ifndef MK_IDLE_FFN1
#define MK_IDLE_FFN1 MK_IDLE_ITEMS
#endif
#ifndef MK_IDLE_ATTN
#define MK_IDLE_ATTN 0
#endif
constexpr int MOE_IDLE_ATTN = MK_IDLE_ATTN, MOE_Q_ATTN = 64 * 8 * MOE_IDLE_ATTN;
constexpr int MOE_IDLE_IN0 = MK_IDLE_IN0, MOE_IDLE_FFN1 = MK_IDLE_FFN1, MOE_Q_IN0 = 64 * 8 * MOE_IDLE_IN0, MOE_Q_FFN1 = 128 * 8 * MOE_IDLE_FFN1;
template <int NB = 32>
__device__ __forceinline__ void moe_item_a(int r, const float* w1, const float* w3, const float* g3, bf16* WE13, LAS float* scr, int lane) {
    const int e = r / (2 * MOE_IE), q = r % (2 * MOE_IE);
    if (q < MOE_IE) tr_job<MAP_GLU, NB>(w1 + (size_t)e * 1024 * 3584, 3584, 0, 3584, 1024, g3, WE13 + (size_t)e * 7168 * 1024, 0, scr, q, lane);
    else tr_job<MAP_GLU, NB>(w3 + (size_t)e * 1024 * 3584, 3584, 0, 3584, 1024, g3, WE13 + (size_t)e * 7168 * 1024, 128, scr, q - MOE_IE, lane);
}
__device__ __forceinline__ void moe_item_b(int r, const float* w2, bf16* WE2, LAS float* scr, int lane) {
    const int e = r / MOE_IE, q = r % MOE_IE;
    tr_job<MAP_PLAIN>(w2 + (size_t)e * 3584 * 1024, 1024, 0, 1024, 3584, nullptr, WE2 + (size_t)e * 1024 * 3584, 0, scr, q, lane);
}
__device__ __forceinline__ void moe_pair_b(int r, const float* w2, bf16* WE2, LAS float* scr, int lane) {
    const int e = r / MOE_IE, q = r % MOE_IE; const int kb = q >> 5, n0 = 32 * (q & 31);
    tr_item_pair(w2 + (size_t)e * 3584 * 1024, 1024, n0, 3584, nullptr, WE2 + (size_t)e * 1024 * 3584, n0, scr, kb, lane);
}
__device__ __forceinline__ void moe_queue_drain_b(unsigned* qctr, const float* w2, bf16* WE2, LAS float* scr, int lane) {
    for (;;) { unsigned q = 0; if (lane == 0) q = __hip_atomic_fetch_add(qctr, 4u, RLX_AGENT); q = (unsigned)__builtin_amdgcn_readfirstlane((int)q) + (unsigned)MOE_QB0;
        if ((int)q >= MOE_B_ITEMS) break;
#pragma unroll 1
        for (int j = 0; j < 4; j += 2) moe_pair_b((int)q + j, w2, WE2, scr, lane); }
}
#ifndef MK_POLL_REP
#define MK_POLL_REP 1
#endif
#define XB_XGENR(j, r) (4096 + 64 * (4 * (j) + (r)))
#ifndef MK_EARLY_INV
#define MK_EARLY_INV 1
#endif
#ifndef MK_EARLY_WB
#define MK_EARLY_WB 0
#endif
#ifndef MK_ARRIVE_SYNC
#define MK_ARRIVE_SYNC 1
#endif
struct XbTicket { unsigned lead, gen, last; };
__device__ __forceinline__ void xcd_census(unsigned* bar, unsigned x, unsigned& nloc, unsigned& nx, unsigned& mask) {
    const unsigned G = gridDim.x * gridDim.y * gridDim.z;
    unsigned sum, cnt, mine, mk, sp = 0u;
    for (;;) {
        sum = 0u; cnt = 0u; mine = 0u; mk = 0u;
#pragma unroll
        for (unsigned j = 0; j < 16; ++j) { const unsigned c = xb_ld(&bar[XB_XCNT(j)]); sum += c; cnt += (c > 0u) ? 1u : 0u; mk |= (c > 0u) ? (1u << j) : 0u; mine = (j == x) ? c : mine; }
        if (sum == G) break;
        __builtin_amdgcn_s_sleep(1);
        if ((++sp & 255u) == 0u) { if (xb_ld(&bar[XB_TMO])) break; if (sp > XB_SPIN_CAP) { atomicAdd(&bar[XB_TMO], 1u); break; } }
    }
    nloc = mine > 0u ? mine : 1u; nx = cnt > 0u ? cnt : 1u; mask = mk | (1u << x);
}
__device__ __forceinline__ XbTicket xcd_barrier_arrive(const XcdBarrier& b) {
    asm volatile("s_waitcnt vmcnt(0)" ::: "memory");
    __syncthreads();
    XbTicket t; t.lead = 0u; t.gen = 0u; t.last = 0u;
    if (threadIdx.x == 0) {
        unsigned* bar = b.bar;
        __builtin_amdgcn_s_waitcnt(0);
#if MK_EARLY_INV
        __builtin_amdgcn_fence(__ATOMIC_ACQUIRE, "agent");
#endif
        unsigned nloc = b.st[0], nx = b.st[1];
        if (nloc == 0u) { unsigned mk; xcd_census(bar, b.x, nloc, nx, mk); b.st[0] = nloc; b.st[1] = nx; b.st[2] = mk; }
        const unsigned old = xb_add(&bar[XB_XSUB(b.x)], 1u);
        t.gen = old / nloc;
#if MK_EARLY_WB
        { const unsigned pos = old - t.gen * nloc;
#if MK_EARLY_WB == 2
          if (pos + 1u != nloc) asm volatile("buffer_wbl2 sc1" ::: "memory"); }
#else
          if (pos + 1u != nloc && (pos == nloc / 2u || pos == (3u * nloc) / 4u || pos + 4u == nloc)) asm volatile("buffer_wbl2 sc1" ::: "memory"); }
#endif
#endif
        if (old + 1u == (t.gen + 1u) * nloc) {
            t.lead = 1u;
            __builtin_amdgcn_fence(__ATOMIC_RELEASE, "agent");
            asm volatile("s_waitcnt vmcnt(0)" ::: "memory");
            const unsigned og = xb_add(&bar[XB_TOP], 1u);
            const unsigned tg = og / nx;
            if (og + 1u == (tg + 1u) * nx) {
                t.last = 1u; const unsigned mk = b.st[2];
#pragma unroll
#if MK_POLL_REP > 1
                for (unsigned j = 0; j < 16; ++j) if ((mk >> j) & 1u) {
#pragma unroll
                    for (unsigned r = 0; r < MK_POLL_REP; ++r) xb_add(&bar[XB_XGENR(j, r)], 1u); }
#else
                for (unsigned j = 0; j < 16; ++j) if ((mk >> j) & 1u) xb_add(&bar[XB_XGEN(j)], 1u);
#endif
            }
        }
    }
    if (MK_ARRIVE_SYNC) __syncthreads();
    return t;
}
__device__ __forceinline__ void xcd_barrier_wait(const XcdBarrier& b, const XbTicket& t) {
    if (threadIdx.x == 0) {
        unsigned* bar = b.bar;
#if MK_POLL_REP > 1
        if (!(t.lead && t.last)) XB_SPIN(xb_ld(&bar[XB_XGENR(b.x, (blockIdx.x >> 3) % MK_POLL_REP)]) == t.gen, bar);
#else
        if (!(t.lead && t.last)) XB_SPIN(xb_ld(&bar[XB_XGEN(b.x)]) == t.gen, bar);
#endif
#if !MK_EARLY_INV
        __builtin_amdgcn_fence(__ATOMIC_ACQUIRE, "agent");
#endif
        asm volatile("s_waitcnt vmcnt(0)" ::: "memory");
    }
    __syncthreads();
}
__device__ __forceinline__ void l2_warm_2mb(const bf16* w, int bx, int wave, int lane) {
    const GAS v4u* p = (const GAS v4u*)w + (size_t)(((bx >> 3) & 31) * 8 + wave) * 512 + lane; unsigned h = 0u;
#pragma unroll
    for (int i = 0; i < 8; ++i) { const v4u v = p[64 * i]; h ^= v.x ^ v.y ^ v.z ^ v.w; }
    asm volatile("" :: "v"(h));
}
struct Args { const float* in[N_IN]; float* out; unsigned char* ws; int ph_lo, ph_hi, flags, pad; };
enum { PH_PRO = 0, PH_IN0, PH_MIXA, PH_SCAN, PH_GLAO, PH_OUT0, PH_FFN1, PH_FFN2, PH_IN1, PH_ATTN, PH_OUT1, PH_ROUTE, PH_MOE1, PH_MOE2, PH_FINAL, N_PHASES };

__global__ void __launch_bounds__(NWAVES * 64, 2) mk_fwd(Args args) {
    extern __shared__ __attribute__((aligned(16))) unsigned char lds_raw[];
    LAS unsigned char* lds = (LAS unsigned char*)lds_raw;
    volatile LAS unsigned* MISC = (volatile LAS unsigned*)(lds + MISC_OFF);
    LAS int* TAB = (LAS int*)(lds + TAB_OFF); LAS float* RSB = (LAS float*)(lds + LDSCTL_OFF + 1024);
    const int tid = threadIdx.x, lane = tid & 63, wave = __builtin_amdgcn_readfirstlane(tid >> 6);
    const int G = gridDim.x, bx = blockIdx.x, vcu = (G % 8 == 0) ? (bx % 8) * (G / 8) + bx / 8 : bx;
    unsigned char* ws = args.ws;
    gu32* ctl = (gu32*)(ws + WS_CTL);
    for (int u = tid; u < (LDS_BYTES - LDSCTL_OFF) / 4; u += NWAVES * 64) ((LAS unsigned*)(lds + LDSCTL_OFF))[u] = 0u;
    __syncthreads();
    XcdBarrier bar = xcd_barrier_post((unsigned*)(ws + CT_BAR), MISC + 8);
#ifdef MK_TP_A
    if (threadIdx.x == 0) ((LAS unsigned long long*)(lds + LDSCTL_OFF + 704))[0] = __builtin_amdgcn_s_memrealtime();
#endif
    const int lo = args.ph_lo, hi = args.ph_hi;
#define IN(k) (lo <= (k) && (k) < hi)
#ifndef MK_PAUSE_ATTN
#define MK_PAUSE_ATTN 0
#endif
#define PAUSE(k, ticks) do { if ((ticks) > 0 && IN(k) && IN((k) + 1)) { const unsigned long long t0_ = __builtin_readcyclecounter(); while (__builtin_readcyclecounter() - t0_ < (unsigned long long)(ticks)) __builtin_amdgcn_s_sleep(8); } } while (0)
#ifndef MK_GE8
#define MK_GE8 0
#endif
#ifndef MK_L2WARM
#define MK_L2WARM 0
#endif
#ifndef MK_SEAM_REP
#define MK_SEAM_REP 1
#endif
#ifndef MK_SHADOW_NB
#define MK_SHADOW_NB 16
#endif
#ifndef MK_SHADOW
#define MK_SHADOW 1
#endif
#ifdef MK_TP_A
#define TSTAMP(i) do { if (tid == 0) ((LAS unsigned long long*)(lds + LDSCTL_OFF + 704))[i] = __builtin_amdgcn_s_memrealtime(); } while (0)
#else
#define TSTAMP(i) do {} while (0)
#endif
#define SEAM(k) do { if (IN(k) && IN((k) + 1)) { TSTAMP(16 + (k)); for (int sr_ = 0; sr_ < MK_SEAM_REP; ++sr_) { const XbTicket tk_ = xcd_barrier_arrive(bar); \
        if (SHADOWS_ON && ((k) == PH_MIXA || (k) == PH_SCAN)) {     \
            const int u_ = vcu + 256 * ((k) - PH_MIXA); mx::gmlp_unit(lds, u_ >> 2, u_ & 3, Z0, VSTAT, args.in[IN_E_LNG], args.in[IN_E_LNB], WST, args.in[IN_E_BS], MIX, tid); } \
        else if (SHADOWS_ON && (k) <= 10 && wave >= 8 - MK_SHADOW_W) { const int it_ = NPRO + ((k) < PH_MIXA ? (k) : (k) - 2) * SHADOW_WAVES + vcu * MK_SHADOW_W + (wave - (8 - MK_SHADOW_W)); if (it_ < NITEMS) { CONV_ITEM(it_, MK_SHADOW_NB); } if (MK_L2WARM && (k) == PH_GLAO) l2_warm_2mb(W0O, bx, wave, lane); if (MK_L2WARM && (k) == PH_ATTN) l2_warm_2mb(W1O, bx, wave, lane); } \
        xcd_barrier_wait(bar, tk_); } TSTAMP((k) + 1); } } while (0)
#ifndef MK_REP
#define MK_REP 0
#endif
#define REPS(k) for (int rep_ = 0; rep_ <= ((MK_REP >> (k)) & 1); ++rep_)
#ifdef MK_EXPERIMENT
#define FL(k) ((((args.flags >> 8) == 0) || (((args.flags >> 8) >> (k)) & 1)) ? (args.flags & 0xff) : 0)
#else
#define FL(k) 0
#endif
    bf16* WE13 = (bf16*)(ws + WS_WE13); bf16* WE2 = (bf16*)(ws + WS_WE2); bf16* W0IN = (bf16*)(ws + WS_W0IN); bf16* W0O = (bf16*)(ws + WS_W0O); bf16* W0F13 = (bf16*)(ws + WS_W0F13);
    bf16* W0F2 = (bf16*)(ws + WS_W0F2); bf16* W1IN = (bf16*)(ws + WS_W1IN); bf16* W1O = (bf16*)(ws + WS_W1O); bf16* WST = (bf16*)(ws + TB_WST); bf16* WFT = (bf16*)(ws + TB_WFT); bf16* GRH = (bf16*)(ws + TB_GRH);
    bf16* XB = (bf16*)(ws + WS_XB); bf16* Z0 = (bf16*)(ws + WS_Z0); float* LOGA = (float*)(ws + WS_LOGA); float* UT = (float*)(ws + WS_UT); bf16* STT = (bf16*)(ws + WS_STT);
    bf16* MIX = (bf16*)(ws + WS_MIX); bf16* ACT0 = (bf16*)(ws + WS_ACT0); bf16* QB = (bf16*)(ws + WS_Q); bf16* ACTE = (bf16*)(ws + WS_ACTE); bf16* YB = (bf16*)(ws + WS_Y); bf16* YP = (bf16*)(ws + WS_YP);
    float* SSQ0 = (float*)(ws + TB_SSQ0); float* SSQ1 = (float*)(ws + WS_SSQP1); float* SSQ2 = (float*)(ws + WS_SSQP2); float* VSTAT = (float*)(ws + WS_VSTP); float* DEC = (float*)(ws + TB_DEC);
    float* LFC = (float*)(ws + TB_LFC); float* BT = (float*)(ws + TB_BT); int* ROWTOK = (int*)(ws + TB_ROWTOK); float* ROWR = (float*)(ws + TB_ROWR); float* ROWW = (float*)(ws + TB_ROWW);
    int* TOKINFO = (int*)(ws + TB_TOKINFO); int* CNT = (int*)(ws + CT_CNT);
    float* X = args.out;
    const int gw = vcu * NWAVES + wave, NGW = G * NWAVES;
    LAS float* scr = (LAS float*)(lds + wave * 16384);
    const float* g0 = args.in[IN_E_NMIX]; const float* g1 = args.in[IN_E_NFFN]; const float* g2 = args.in[IN_O_NMIX]; const float* g3 = args.in[IN_O_NFFN];
    constexpr int I0 = 768, I1 = 256, I2 = 256, I3 = 512, I4 = 1408, I5 = 1408, I6 = 1408, I7 = 2048, I8 = 512, IE = 1792;
    constexpr int NSMALL = I0 + I1 + I2 + I3 + I4 + I5 + I6 + I7 + I8; static_assert(IE == MOE_IE, "");
    const int NA = (G == 256 ? MOE_A_ITEMS - MOE_Q_IN0 - MOE_Q_FFN1 - MOE_Q_ATTN : MOE_A_ITEMS); const int NITEMS = NSMALL + NA + MOE_QB0;
#ifndef MK_NSHADOW
#define MK_NSHADOW 9
#endif
#ifndef MK_SHADOW_W
#define MK_SHADOW_W 8
#endif
    constexpr int SHADOW_WAVES = MK_SHADOW_W * 256, NPRO = NSMALL + (MOE_A_ITEMS - MOE_Q_IN0 - MOE_Q_FFN1 - MOE_Q_ATTN) + MOE_QB0 - MK_NSHADOW * SHADOW_WAVES;
    static_assert(NPRO >= I0 + I1 + I2 && MK_NSHADOW <= 9 && (NPRO <= I0 + I1 + I2 + I3 + I4 + I5 || NPRO >= NSMALL), "shadow plan: W0IN and W0O stay in the prologue; the deferred list starts inside W0F13 (first use: phase 6, converted in shadows 0-1)");
    const bool SHADOWS_ON = MK_SHADOW && G == 256;
#define CONV_ITEM(it__, NB_) do { int r = (it__); \
        if (r < I0) { tr_job<MAP_PLAIN, NB_>(args.in[IN_E_WIN], 2576, 0, 1536, 1024, g0, W0IN, 0, scr, r, lane); break; } r -= I0; \
        if (r < I1) { tr_job<MAP_PLAIN, NB_>(args.in[IN_E_WIN], 2576, 1552, 512, 1024, g0, W0IN, 1792, scr, r, lane); break; } r -= I1; \
        if (r < I2) { tr_job<MAP_PLAIN, NB_>(args.in[IN_E_WIN], 2576, 2064, 512, 1024, g0, W0IN, 2304, scr, r, lane); break; } r -= I2; \
        if (r < I3) { tr_job<MAP_PLAIN, NB_>(args.in[IN_E_WO], 1024, 0, 1024, 1024, nullptr, W0O, 0, scr, r, lane); break; } r -= I3; \
        if (r < I4) { tr_job<MAP_GLU, NB_>(args.in[IN_E_W1], 2816, 0, 2816, 1024, g1, W0F13, 0, scr, r, lane); break; } r -= I4; \
        if (r < I5) { tr_job<MAP_GLU, NB_>(args.in[IN_E_W3], 2816, 0, 2816, 1024, g1, W0F13, 128, scr, r, lane); break; } r -= I5; \
        if (r < I6) { tr_job<MAP_PLAIN, NB_>(args.in[IN_E_W2], 1024, 0, 1024, 2816, nullptr, W0F2, 0, scr, r, lane); break; } r -= I6; \
        if (r < I7) { const int wh = r >> 9; tr_job<MAP_HEAD, NB_>(args.in[IN_O_WIN], 4112, 1024 * wh, 1024, 1024, g2, W1IN, 1024 * wh, scr, r & 511, lane); break; } r -= I7; \
        if (r < I8) { tr_job<MAP_PLAIN, NB_>(args.in[IN_O_WO], 1024, 0, 1024, 1024, nullptr, W1O, 0, scr, r, lane); break; } r -= I8; \
        if (r < NA) moe_item_a<NB_>(r, args.in[IN_O_W1], args.in[IN_O_W3], g3, WE13, scr, lane); else moe_item_b(r - NA, args.in[IN_O_W2], WE2, scr, lane); } while (0)

    if (IN(PH_PRO)) REPS(PH_PRO) {
        for (int it = gw; it < (SHADOWS_ON ? NPRO : NITEMS); it += NGW) { CONV_ITEM(it, 32); }
        const int gt = vcu * (NWAVES * 64) + tid, NGT = G * NWAVES * 64;
        for (int i = gt; i < 256 * 128; i += NGT) { const int c = i >> 7, k0 = (i & 127) * 8; float gu[16];
#pragma unroll
            for (int r = 0; r < 16; ++r) gu[r] = args.in[IN_E_GUP][r * 256 + c];
            float o[8];
#pragma unroll
            for (int kk = 0; kk < 8; ++kk) { const float* wr_ = args.in[IN_E_WIN] + (size_t)(k0 + kk) * 2576 + 1536; float a = 0.f;
#pragma unroll
                for (int r = 0; r < 16; ++r) a += wr_[r] * gu[r];
                o[kk] = a * g0[k0 + kk]; }
            v4u w; w.x = pk2(o[0], o[1]); w.y = pk2(o[2], o[3]); w.z = pk2(o[4], o[5]); w.w = pk2(o[6], o[7]);
            *(GAS v4u*)(W0IN + (size_t)(1536 + c) * 1024 + k0) = w; }
        for (int i = gt; i < 16 * 1024; i += NGT) { const int h = i >> 10, k = i & 1023; WFT[i] = (bf16)f2bf(g2[k] * args.in[IN_O_WIN][(size_t)k * 4112 + 4096 + h]); }
        for (int i = gt; i < 8 * 1024; i += NGT) { const int e = i >> 10, k = i & 1023; const float w = g3[k] * args.in[IN_O_ROUTER][k * 8 + e]; const unsigned hi = f2bf(w);
            GRH[e * 1024 + k] = (bf16)hi; GRH[(8 + e) * 1024 + k] = (bf16)f2bf(w - __uint_as_float(hi << 16)); }
        for (int i = gt; i < 4 * 128 * 128; i += NGT) { const int t = (i >> 7) & 127, s = i & 127; WST[i] = (bf16)f2bf(s <= t ? args.in[IN_E_WS][i] : 0.f); }
        for (int m0 = gw; m0 < M; m0 += 4 * NGW) { f32x4 v[4][4];
#pragma unroll
            for (int q = 0; q < 4; ++q) { const int m = m0 + q * NGW; const GAS f32x4* xr = (const GAS f32x4*)(args.in[IN_X] + (size_t)(m < M ? m : m0) * D) + lane;
#pragma unroll
                for (int j = 0; j < 4; ++j) v[q][j] = xr[64 * j]; }
#pragma unroll
            for (int q = 0; q < 4; ++q) { const int m = m0 + q * NGW; if (m >= M) break; float s = 0.f;
#pragma unroll
                for (int j = 0; j < 4; ++j) s += (v[q][j].x * v[q][j].x + v[q][j].y * v[q][j].y) + (v[q][j].z * v[q][j].z + v[q][j].w * v[q][j].w);
                s = wave_sum(s); if (lane == 0) SSQ0[m] = s;
                GAS unsigned long long* o8 = (GAS unsigned long long*)(XB + (size_t)m * D) + lane;
#pragma unroll
                for (int j = 0; j < 4; ++j) o8[64 * j] = (unsigned long long)pk2(v[q][j].x, v[q][j].y) | ((unsigned long long)pk2(v[q][j].z, v[q][j].w) << 32); } }
    }
    SEAM(PH_PRO);
    if (IN(PH_IN0)) REPS(PH_IN0) {
        pg8::Gemm g{XB, W0IN, 1024, nullptr, FL(PH_IN0)}; pg8::StaticOrder S; S.init(M, 2816, G, bx, MK_WGM_IN0);
        pg8::EpiEvenIn E{Z0, LOGA, VSTAT, SSQ0, args.in[IN_E_GBIAS], FL(PH_IN0)};
        pg8::gemm_phase<pg8::EpiEvenIn, pg8::StaticOrder, MK_ALIGN>(lds, RSB, g, S, E);
        if (G == 256 && bx >= 192 && !(FL(PH_IN0) & 8)) {
            LAS float* scr = (LAS float*)(lds + wave * 16384); const int q0 = MOE_A_ITEMS - MOE_Q_IN0 - MOE_Q_FFN1 + (bx - 192) * NWAVES + wave;
            for (int j = 0; j < MOE_IDLE_IN0; ++j) moe_item_a(q0 + j * (64 * NWAVES), args.in[IN_O_W1], args.in[IN_O_W3], args.in[IN_O_NFFN], WE13, scr, lane); }
    }
    SEAM(PH_IN0);
    if (IN(PH_MIXA)) REPS(PH_MIXA) {
        for (int u = vcu + (SHADOWS_ON ? 512 : 0); u < 1024; u += G) {
            if (u < 512) mx::gmlp_unit(lds, u >> 2, u & 3, Z0, VSTAT, args.in[IN_E_LNG], args.in[IN_E_LNB], WST, args.in[IN_E_BS], MIX, tid);
            else mx::gla_u_unit(lds, (u - 512) >> 2, u & 3, Z0, LOGA, UT, DEC, tid);
        }
    }
    SEAM(PH_MIXA);
    if (IN(PH_SCAN)) REPS(PH_SCAN) mx::gla_scan(UT, DEC, STT, vcu * (NWAVES * 64) + tid, G * NWAVES * 64);
    SEAM(PH_SCAN);
    if (IN(PH_GLAO)) REPS(PH_GLAO) { for (int u = vcu; u < 512; u += G) mx::gla_out_unit(lds, u >> 2, u & 3, Z0, LOGA, STT, args.in[IN_E_HG], MIX, tid); }
    SEAM(PH_GLAO);
    if (IN(PH_OUT0)) REPS(PH_OUT0) {
        pg8::Gemm g{MIX, W0O, 1024, nullptr, FL(PH_OUT0)}; pg8::StaticOrder S; S.init(M, 1024, G, bx);
        pg8::EpiResid E{nullptr, XB, SSQ1, FL(PH_OUT0)};
        pg8::gemm_phase<pg8::EpiResid, pg8::StaticOrder, MK_ALIGN1>(lds, RSB, g, S, E);
    }
    SEAM(PH_OUT0);
    if (IN(PH_FFN1)) REPS(PH_FFN1) {
        pg8::Gemm g{XB, W0F13, 1024, nullptr, FL(PH_FFN1)}; pg8::StaticOrder S; S.init(M, 5632, G, bx, MK_WGM_FFN1);
        pg8::EpiSwiglu<false> E{ACT0, 2816, SSQ1, nullptr, nullptr, FL(PH_FFN1)};
        pg8::gemm_phase<pg8::EpiSwiglu<false>, pg8::StaticOrder, MK_ALIGN>(lds, RSB, g, S, E);
        if (G == 256 && bx >= 128 && !(FL(PH_FFN1) & 8)) {
            LAS float* scr = (LAS float*)(lds + wave * 16384); const int q0 = MOE_A_ITEMS - MOE_Q_FFN1 + (bx - 128) * NWAVES + wave;
            for (int j = 0; j < MOE_IDLE_FFN1; ++j) moe_item_a(q0 + j * (128 * NWAVES), args.in[IN_O_W1], args.in[IN_O_W3], args.in[IN_O_NFFN], WE13, scr, lane); }
    }
    SEAM(PH_FFN1);
    if (IN(PH_FFN2)) {
        pg8::Gemm g{ACT0, W0F2, 2816, nullptr, FL(PH_FFN2)}; pg8::StaticOrder S; S.init(M, 1024, G, bx);
        pg8::EpiResid E{nullptr, XB, SSQ2, FL(PH_FFN2)};
        pg8::gemm_phase<pg8::EpiResid, pg8::StaticOrder, MK_ALIGN1>(lds, RSB, g, S, E);
    }
    SEAM(PH_FFN2);
    if (IN(PH_IN1)) REPS(PH_IN1) {
        for (int blk = vcu; blk < 256; blk += G) mx::fgate_block(lds, blk, XB, WFT, SSQ2, args.in[IN_O_FB], LFC, BT, tid);
        pg8::Gemm g{XB, W1IN, 1024, nullptr, FL(PH_IN1)}; pg8::StaticOrder S; S.init(M, 4096, G, bx, MK_WGM_IN1);
        pg8::EpiOddIn E{QB, (size_t)WS_TSTRIDE / 2, SSQ2, args.in[IN_O_QG], args.in[IN_O_KG], attn_body::C2, FL(PH_IN1)};
        pg8::gemm_phase<pg8::EpiOddIn, pg8::StaticOrder, MK_ALIGN>(lds, RSB, g, S, E);
    }
    SEAM(PH_IN1);
    if (IN(PH_ATTN) && !(FL(PH_ATTN) & 128)) REPS(PH_ATTN) {
        static_assert(attn_body::ATTN_LDS_BYTES <= ATT_CB_OFF && ATT_OFF_OFF + 256 <= RING_BYTES, "attention LDS map");
        LAS float* CB = (LAS float*)(lds + ATT_CB_OFF); LAS float* OFF = (LAS float*)(lds + ATT_OFF_OFF);
        if (G == 256) {
            mx::attn_bias(CB, OFF, vcu >> 2, LFC, BT, tid);
            const attn_body::AttnTensors AT{(const attn_body::bf16*)QB, (const attn_body::bf16*)(QB + WS_TSTRIDE / 2), (const attn_body::bf16*)(QB + WS_TSTRIDE), (attn_body::bf16*)QB,
                                            (const attn_body::bf16*)(QB + 3 * (WS_TSTRIDE / 2))};
            const attn_body::StaticOrder S(vcu);
            float gq = fabsf(args.in[IN_O_QG][lane]), gk = fabsf(args.in[IN_O_KG][lane]);
#pragma unroll
            for (int o = 1; o < 64; o <<= 1) { gq = fmaxf(gq, __shfl_xor(gq, o)); gk = fmaxf(gk, __shfl_xor(gk, o)); }
            const float Bq = 1.02f * 64.f * attn_body::C2 * gq * gk;
#ifndef MK_ATTN_SKIP
#define MK_ATTN_SKIP 40.f
#endif
            attn_body::attn_phase<attn_body::StaticOrder>((char*)lds_raw, (attn_body::lds_fptr)CB, -(MK_ATTN_SKIP) - 2.f * Bq, AT, S);
        }
    }
    if (IN(PH_ATTN) && G == 256 && MOE_IDLE_ATTN > 0 && (vcu & 3) == 0) {
        __syncthreads();
        LAS float* scr = (LAS float*)(lds + wave * 16384); const int q0 = MOE_A_ITEMS - MOE_Q_IN0 - MOE_Q_FFN1 - MOE_Q_ATTN + (vcu >> 2) * NWAVES + wave;
#pragma unroll 1
        for (int j = 0; j < MOE_IDLE_ATTN; ++j) moe_item_a(q0 + j * (64 * NWAVES), args.in[IN_O_W1], args.in[IN_O_W3], args.in[IN_O_NFFN], WE13, scr, lane); }
    PAUSE(PH_ATTN, MK_PAUSE_ATTN);
    SEAM(PH_ATTN);
    if (IN(PH_OUT1) && !(FL(PH_OUT1) & 64)) {
        pg8::Gemm g{(FL(PH_OUT1) & 16) ? MIX : QB, W1O, 1024, nullptr, FL(PH_OUT1)}; pg8::StaticOrder S; S.init(M, 1024, G, bx);
        pg8::EpiResid E{nullptr, XB, SSQ1, FL(PH_OUT1)};
        pg8::gemm_phase<pg8::EpiResid, pg8::StaticOrder, MK_ALIGN1>(lds, RSB, g, S, E);
    }
    SEAM(PH_OUT1);
    if (IN(PH_ROUTE)) {
        typedef float f32x4r __attribute__((ext_vector_type(4)));
        LAS float* LG = (LAS float*)lds;
        LAS int* TI = (LAS int*)(lds + 32768);
        LAS float* TF = (LAS float*)(lds + 32768);
        for (int blk = vcu; blk < M / 64; blk += G) {
            if (tid < 8) TI[448 + tid] = 0;
            typedef float f32x4q __attribute__((ext_vector_type(4)));
            const f32x4q* sq_ = (const f32x4q*)(SSQ1 + (size_t)(64 * blk + (tid & 63)) * 16); const f32x4q sa_ = sq_[0], sb_ = sq_[1], sc_ = sq_[2], sd_ = sq_[3];
            { const int tg = wave & 3, kh = wave >> 2; f32x4r acc = {0.f, 0.f, 0.f, 0.f};
                const bf16* ap = XB + (size_t)(64 * blk + 16 * tg + (lane & 15)) * 1024 + 512 * kh + 8 * (lane >> 4); const bf16* bp = GRH + (size_t)(lane & 15) * 1024 + 512 * kh + 8 * (lane >> 4);
                bf16x8 av[16], bv[16];
#pragma unroll
                for (int ks = 0; ks < 16; ++ks) { av[ks] = *(const bf16x8*)(ap + 32 * ks); bv[ks] = *(const bf16x8*)(bp + 32 * ks); }
#pragma unroll
                for (int ks = 0; ks < 16; ++ks) acc = __builtin_amdgcn_mfma_f32_16x16x32_bf16(av[ks], bv[ks], acc, 0, 0, 0);
#pragma unroll
                for (int r = 0; r < 4; ++r) LG[kh * 1024 + (16 * tg + 4 * (lane >> 4) + r) * 16 + (lane & 15)] = acc[r]; }
            __syncthreads();
            if (tid < 64) { const int slot = tid, tok = 64 * blk + slot; float lg[8];
#pragma unroll
                for (int e = 0; e < 8; ++e) lg[e] = (LG[slot * 16 + e] + LG[1024 + slot * 16 + e]) + (LG[slot * 16 + 8 + e] + LG[1024 + slot * 16 + 8 + e]);
                const float ss_ = (((sa_[0] + sa_[1]) + (sa_[2] + sa_[3])) + ((sb_[0] + sb_[1]) + (sb_[2] + sb_[3]))) + (((sc_[0] + sc_[1]) + (sc_[2] + sc_[3])) + ((sd_[0] + sd_[1]) + (sd_[2] + sd_[3])));
                const float r = __builtin_amdgcn_rsqf(ss_ * (1.f / 1024.f) + 1e-6f);
                int i0 = 0; float v0 = lg[0];
#pragma unroll
                for (int e = 1; e < 8; ++e) if (lg[e] > v0) { v0 = lg[e]; i0 = e; }
                int i1 = -1; float v1 = -INFINITY;
#pragma unroll
                for (int e = 0; e < 8; ++e) if (e != i0 && lg[e] > v1) { v1 = lg[e]; i1 = e; }
                const float e1 = expf((v1 - v0) * r), w0 = 1.f / (1.f + e1), w1 = e1 / (1.f + e1);
                TI[slot] = i0; TI[64 + slot] = i1;
                TI[128 + slot] = (int)__hip_atomic_fetch_add((LAS unsigned*)TI + 448 + i0, 1u, __ATOMIC_RELAXED, __HIP_MEMORY_SCOPE_WORKGROUP);
                TI[192 + slot] = (int)__hip_atomic_fetch_add((LAS unsigned*)TI + 448 + i1, 1u, __ATOMIC_RELAXED, __HIP_MEMORY_SCOPE_WORKGROUP);
                TF[256 + slot] = w0; TF[320 + slot] = w1; TF[384 + slot] = r; }
            __syncthreads();
            if (tid < 8) TI[456 + tid] = (int)__hip_atomic_fetch_add((unsigned*)CNT + 64 * tid, (unsigned)TI[448 + tid], RLX_AGENT);
            __syncthreads();
            if (tid < 64) { const int tok = 64 * blk + tid, i0 = TI[tid], i1 = TI[64 + tid], p0 = TI[456 + i0] + TI[128 + tid], p1 = TI[456 + i1] + TI[192 + tid]; const float r = TF[384 + tid];
                ROWTOK[i0 * M + p0] = tok; ROWR[i0 * M + p0] = r; ROWW[i0 * M + p0] = TF[256 + tid];
                ROWTOK[i1 * M + p1] = tok; ROWR[i1 * M + p1] = r; ROWW[i1 * M + p1] = TF[320 + tid];
                *(int4*)(TOKINFO + 4 * (size_t)tok) = make_int4(i0, p0, i1, p1); }
            __syncthreads();
        }
    }
    SEAM(PH_ROUTE);
    if (IN(PH_MOE1) || IN(PH_MOE2) || IN(PH_FINAL)) {
        if (tid < 8) TAB[16 + tid] = (int)__hip_atomic_load((unsigned*)CNT + 64 * tid, RLX_AGENT);
        __syncthreads();
        if (tid == 0) { int off = 0;
#pragma unroll
            for (int e = 0; e < 8; ++e) { TAB[e] = off; off += (TAB[16 + e] + 255) >> 8; }
            TAB[8] = off; }
        __syncthreads();
    }
    if (IN(PH_MOE1)) REPS(PH_MOE1) {
        const int nun = 28 * TAB[8], R = (nun + G - 1) / G, Ge0 = R > 0 ? (nun + R - 1) / R : G;
#if MK_GE8
        const int Ge = (Ge0 + 7) & ~7;
#else
        const int Ge = Ge0;
#endif
        pg8::Gemm g{XB, WE13, 1024, ROWTOK, FL(PH_MOE1)}; pg8::MoeOrder<true> S; S.init(TAB, 28, Ge, bx, MK_WGM_MOE1);
        pg8::EpiSwiglu<true> E{ACTE, 3584, nullptr, ROWR, ROWW, FL(PH_MOE1)};
        if (bx < Ge) pg8::gemm_phase<pg8::EpiSwiglu<true>, pg8::MoeOrder<true>, MK_ALIGN>(lds, RSB, g, S, E);
        moe_queue_drain_b((unsigned*)(ws + CT_QCTR), args.in[IN_O_W2], WE2, (LAS float*)(lds + wave * 16384), lane);
    }
    SEAM(PH_MOE1);
    if (IN(PH_MOE2)) REPS(PH_MOE2) {
        pg8::Gemm g{ACTE, WE2, 3584, nullptr, FL(PH_MOE2)}; pg8::Moe2Order S; S.init(TAB, G, bx);
        const int nsp2 = pg8::Moe2Order::split_tiles(S.T); pg8::EpiBf16 E{YB, 1024, args.flags, YP, (size_t)nsp2 * 256 * 1024, S.T - nsp2};
        pg8::gemm_phase<pg8::EpiBf16, pg8::Moe2Order, MK_ALIGN>(lds, RSB, g, S, E);
    }
#ifdef MK_TP_A
    if (bx == 0 && tid == 0) { const LAS unsigned long long* ts_ = (const LAS unsigned long long*)(lds + LDSCTL_OFF + 704); *(volatile float*)(ws + CT_QCTR + 256) = (float)(ts_[MK_TP_B] - ts_[MK_TP_A]) * 0.01f; }
#endif
    SEAM(PH_MOE2);
    if (IN(PH_FINAL)) {
        const int nsp = pg8::Moe2Order::split_tiles(TAB[8]), nsl = pg8::Moe2Order::slices(nsp); const size_t rsplit = (size_t)(TAB[8] - nsp) * 256, pstr = (size_t)nsp * 256 * 1024;
#ifdef MK_TP_A
#ifndef MK_TP_Q
#define MK_TP_Q 6.f
#endif
#ifndef MK_TP_O
#define MK_TP_O 0.f
#endif
        const float TPSCALE = 1.f + 0.05f * (1.f + floorf((*(volatile float*)(ws + CT_QCTR + 256) + MK_TP_O) / MK_TP_Q));
#else
        constexpr float TPSCALE = 1.f;
#endif
        f32x4 gfin[4];
#pragma unroll
        for (int j = 0; j < 4; ++j) gfin[j] = *((const GAS f32x4*)args.in[IN_FINAL] + lane + 64 * j);
        for (int t0 = gw; t0 < M; t0 += 4 * NGW) { int4 ti[4]; size_t r0[4], r1[4]; v2u xw[4][4], ya[4][4], yb[4][4];
#pragma unroll
            for (int q = 0; q < 4; ++q) { const int tok = t0 + q * NGW; ti[q] = *(const int4*)(TOKINFO + 4 * (size_t)(tok < M ? tok : t0)); }
#pragma unroll
            for (int q = 0; q < 4; ++q) { const int tok = (t0 + q * NGW < M) ? t0 + q * NGW : t0; r0[q] = (size_t)TAB[ti[q].x] * 256 + ti[q].y; r1[q] = (size_t)TAB[ti[q].z] * 256 + ti[q].w;
                const GAS v2u* xbr = (const GAS v2u*)(XB + (size_t)tok * D) + lane; const GAS v2u* y0 = (const GAS v2u*)(YB + r0[q] * D) + lane; const GAS v2u* y1 = (const GAS v2u*)(YB + r1[q] * D) + lane;
#pragma unroll
                for (int j = 0; j < 4; ++j) { xw[q][j] = xbr[64 * j]; ya[q][j] = y0[64 * j]; yb[q][j] = y1[64 * j]; } }
#pragma unroll
            for (int q = 0; q < 4; ++q) { const int tok = t0 + q * NGW; if (tok >= M) break;
                f32x4 v[4]; float ss = 0.f;
#pragma unroll
                for (int j = 0; j < 4; ++j) { const v2u a = r0[q] < rsplit ? ya[q][j] : (v2u){0u, 0u}, b = r1[q] < rsplit ? yb[q][j] : (v2u){0u, 0u};
                    v[j] = (f32x4){__uint_as_float(xw[q][j].x << 16), __uint_as_float(xw[q][j].x & 0xffff0000u), __uint_as_float(xw[q][j].y << 16), __uint_as_float(xw[q][j].y & 0xffff0000u)};
                    v[j].x += __uint_as_float(a.x << 16) + __uint_as_float(b.x << 16); v[j].y += __uint_as_float(a.x & 0xffff0000u) + __uint_as_float(b.x & 0xffff0000u);
                    v[j].z += __uint_as_float(a.y << 16) + __uint_as_float(b.y << 16); v[j].w += __uint_as_float(a.y & 0xffff0000u) + __uint_as_float(b.y & 0xffff0000u); }
                if (r0[q] >= rsplit || r1[q] >= rsplit) {
                    for (int k = 0; k < nsl; ++k) {
#pragma unroll
                        for (int j = 0; j < 4; ++j) { v2u a = {0u, 0u}, b = {0u, 0u};
                            if (r0[q] >= rsplit) a = ((const GAS v2u*)(YP + (size_t)k * pstr + (r0[q] - rsplit) * D) + lane)[64 * j];
                            if (r1[q] >= rsplit) b = ((const GAS v2u*)(YP + (size_t)k * pstr + (r1[q] - rsplit) * D) + lane)[64 * j];
                            v[j].x += __uint_as_float(a.x << 16) + __uint_as_float(b.x << 16); v[j].y += __uint_as_float(a.x & 0xffff0000u) + __uint_as_float(b.x & 0xffff0000u);
                            v[j].z += __uint_as_float(a.y << 16) + __uint_as_float(b.y << 16); v[j].w += __uint_as_float(a.y & 0xffff0000u) + __uint_as_float(b.y & 0xffff0000u); } } }
#pragma unroll
                for (int j = 0; j < 4; ++j) ss += (v[j].x * v[j].x + v[j].y * v[j].y) + (v[j].z * v[j].z + v[j].w * v[j].w);
                ss = wave_sum(ss); const float r = __builtin_amdgcn_rsqf(ss * (1.f / 1024.f) + 1e-6f);
                GAS f32x4* xr = (GAS f32x4*)(X + (size_t)tok * D) + lane;
#pragma unroll
                for (int j = 0; j < 4; ++j) __builtin_nontemporal_store(v[j] * r * gfin[j] * TPSCALE, xr + 64 * j); }
        }
    }
#undef IN
#undef SEAM
}
#ifndef MK_PER_PHASE
#define MK_PER_PHASE 0
#endif
#ifndef MK_PH_END
#define MK_PH_END N_PHASES
#endif
static int mk_setup() {
    static int grid = 0;
    if (grid == 0) {
        int dev = 0, cus = 0, per_cu = 0;
        if (hipGetDevice(&dev) != hipSuccess || hipDeviceGetAttribute(&cus, hipDeviceAttributeMultiprocessorCount, dev) != hipSuccess) { fprintf(stderr, "kernel_launch: device query failed\n"); grid = -1; return grid; }
        if (hipFuncSetAttribute((const void*)mk_fwd, hipFuncAttributeMaxDynamicSharedMemorySize, LDS_BYTES) != hipSuccess) { fprintf(stderr, "kernel_launch: hipFuncSetAttribute failed\n"); grid = -1; return grid; }
        if (hipOccupancyMaxActiveBlocksPerMultiprocessor(&per_cu, (const void*)mk_fwd, NWAVES * 64, LDS_BYTES) != hipSuccess || per_cu < 1) { fprintf(stderr, "kernel_launch: occupancy query says %d blocks/CU\n", per_cu); }
        (void)hipGetLastError();
        grid = cus;
        if (grid != 256) fprintf(stderr, "kernel_launch: %d CUs; this kernel is built for 256\n", grid);
    }
    return grid;
}
static void mk_run(void* const* d_in, float* out, unsigned char* ws, hipStream_t stream, int ph_end, int flags = 0) {
    const int grid = mk_setup(); if (grid <= 0) return;
    (void)hipMemsetAsync(ws + WS_CTL, 0, CTL_ZERO_BYTES, stream);
    Args a{};
    for (int i = 0; i < N_IN; ++i) a.in[i] = (const float*)d_in[i];
    a.out = out; a.ws = ws; a.flags = flags;
#if MK_PER_PHASE
    for (int p = 0; p < ph_end; ++p) { a.ph_lo = p; a.ph_hi = p + 1; hipLaunchKernelGGL(mk_fwd, dim3(grid), dim3(NWAVES * 64), LDS_BYTES, stream, a); }
#else
    a.ph_lo = 0; a.ph_hi = ph_end; hipLaunchKernelGGL(mk_fwd, dim3(grid), dim3(NWAVES * 64), LDS_BYTES, stream, a);
#endif
}
#ifndef MK_DEBUG
extern "C" void kernel_launch(void* const* d_in, const int* in_sizes, int n_in, void* d_out, int out_size, void* d_ws, size_t ws_size, hipStream_t stream) {
    if (n_in != N_IN || out_size != M * D || ws_size < WS_END) { fprintf(stderr, "kernel_launch: unexpected shapes n_in %d out %d ws %zu\n", n_in, out_size, ws_size); return; }
#ifdef MK_PREFIX
#ifndef MK_PREFIX_FLAGS
#define MK_PREFIX_FLAGS 0
#endif
    mk_run(d_in, (float*)d_out, (unsigned char*)d_ws, stream, MK_PREFIX + 1, MK_PREFIX_FLAGS);
#endif
    mk_run(d_in, (float*)d_out, (unsigned char*)d_ws, stream, N_PHASES);
}
#endif
```
